# Optimizing an MI355X kernel written in HIP

```python
import jax
import jax.numpy as jnp
from jax import lax
import numpy as np

D_MODEL = 1024
BATCH = 4
SEQ = 8192
DEPTH = 2

GRID_W = 64
CTX_LEN = 256
HEAD_DIM = 64
ROPE_THETA = 10000.0
EPS = 1e-6
NEG_INF = -1e30
Q_BLOCK = 128
POOL_GROUPS = 4
POOL_GROUP_DIM = 64
POOL_DIM = POOL_GROUPS * POOL_GROUP_DIM
POOL_WINDOWS = (2, 4, 8, 16)
B_Q_HEADS = 12
B_KV_HEADS = 4
D_IN_EVEN = POOL_DIM + (B_Q_HEADS + 2 * B_KV_HEADS) * HEAD_DIM
D_MIX_EVEN = POOL_DIM + B_Q_HEADS * HEAD_DIM
C_Q_HEADS = 16
C_KV_HEADS = 4
WINDOW = 128
D_IN_ODD = (C_Q_HEADS + 2 * C_KV_HEADS) * HEAD_DIM
D_MIX_ODD = C_Q_HEADS * HEAD_DIM
PEER_HEADS = 8
PEER_NKEYS = 128
PEER_N_EXPERTS = PEER_NKEYS * PEER_NKEYS
PEER_DKEY = 256
PEER_TOPK = 16
PEER_CHUNK = 128

N_EVEN = (DEPTH + 1) // 2
N_ODD = DEPTH // 2

kernel_name = "hybrid_pool_gqa_swa_peer_dit"


def rmsnorm(x, g):
    x32 = x.astype(jnp.float32)
    y = x32 * lax.rsqrt(jnp.mean(x32 * x32, axis=-1, keepdims=True) + EPS)
    return (y * g.astype(jnp.float32)).astype(x.dtype)


def modulate(h, shift, scale):
    return h * (1.0 + scale) + shift


def rope_2d_tables(rows):
    row = jnp.repeat(jnp.arange(rows, dtype=jnp.int32), GRID_W).astype(jnp.float32)
    col = jnp.tile(jnp.arange(GRID_W, dtype=jnp.int32), rows).astype(jnp.float32)
    half = HEAD_DIM // 2
    inv = 1.0 / (ROPE_THETA ** (jnp.arange(0, half, 2, dtype=jnp.float32) / half))
    ang_r = row[:, None] * inv[None, :]
    ang_c = col[:, None] * inv[None, :]
    return (jnp.cos(ang_r), jnp.sin(ang_r), jnp.cos(ang_c), jnp.sin(ang_c))


def _rotate(x, cos, sin):
    m = cos.shape[-1]
    x1, x2 = x[..., :m], x[..., m:]
    cs = cos[:, None, :].astype(x.dtype)
    sn = sin[:, None, :].astype(x.dtype)
    return jnp.concatenate([x1 * cs - x2 * sn, x1 * sn + x2 * cs], axis=-1)


def apply_rope_2d(x, rope):
    cr, sr, cc, sc = rope
    h = HEAD_DIM // 2
    return jnp.concatenate([_rotate(x[..., :h], cr, sr), _rotate(x[..., h:], cc, sc)], axis=-1)


def split_gqa(q, n_kv):
    B, L, H, D = q.shape
    return q.reshape(B, L, n_kv, H // n_kv, D)


def softmax_sink(s, sink):
    if sink is None:
        return jax.nn.softmax(s, axis=-1)
    sk = sink.astype(jnp.float32)[None, :, :, None, None]
    m = jnp.maximum(jnp.max(s, axis=-1, keepdims=True), sk)
    e = jnp.exp(s - m)
    return e / (jnp.sum(e, axis=-1, keepdims=True) + jnp.exp(sk - m))


def dense_gqa(q, k, v, sink=None):
    s = jnp.einsum('bqkgd,blkd->bkgql', q, k).astype(jnp.float32) * (HEAD_DIM ** -0.5)
    p = softmax_sink(s, sink)
    return jnp.einsum('bkgql,blkd->bqkgd', p.astype(v.dtype), v)


def global_attn_latent(q_lat, k_all, v_all):
    B, S = q_lat.shape[:2]
    nblk = S // Q_BLOCK
    qb = q_lat.reshape(B, nblk, Q_BLOCK, *q_lat.shape[2:]).swapaxes(0, 1)
    out = lax.map(lambda qi: dense_gqa(qi, k_all, v_all), qb)
    return out.swapaxes(0, 1).reshape(B, S, -1)


def window_attn_latent(q_lat, k_lat, v_lat, k_ctx, v_ctx, sink):
    B, S = q_lat.shape[:2]
    n_ctx = k_ctx.shape[1]
    nblk = S // Q_BLOCK
    band = Q_BLOCK + 2 * WINDOW
    pad = ((0, 0), (WINDOW, WINDOW), (0, 0), (0, 0))
    k_pad = jnp.pad(k_lat, pad)
    v_pad = jnp.pad(v_lat, pad)
    qb = q_lat.reshape(B, nblk, Q_BLOCK, *q_lat.shape[2:]).swapaxes(0, 1)
    scale = HEAD_DIM ** -0.5

    def blk(args):
        i, qi = args
        start = i * Q_BLOCK
        kb = lax.dynamic_slice_in_dim(k_pad, start, band, axis=1)
        vb = lax.dynamic_slice_in_dim(v_pad, start, band, axis=1)
        qpos = start + jnp.arange(Q_BLOCK, dtype=jnp.int32)
        kpos = start - WINDOW + jnp.arange(band, dtype=jnp.int32)
        valid = ((kpos[None, :] >= 0) & (kpos[None, :] < S)
                 & (jnp.abs(qpos[:, None] - kpos[None, :]) <= WINDOW))
        s_band = jnp.einsum('bqkgd,blkd->bkgql', qi, kb).astype(jnp.float32) * scale
        s_band = jnp.where(valid, s_band, NEG_INF)
        s_ctx = jnp.einsum('bqkgd,blkd->bkgql', qi, k_ctx).astype(jnp.float32) * scale
        p = softmax_sink(jnp.concatenate([s_ctx, s_band], axis=-1), sink)
        pc = p[..., :n_ctx].astype(v_ctx.dtype)
        pb = p[..., n_ctx:].astype(vb.dtype)
        return (jnp.einsum('bkgql,blkd->bqkgd', pc, v_ctx)
                + jnp.einsum('bkgql,blkd->bqkgd', pb, vb))

    out = lax.map(blk, (jnp.arange(nblk, dtype=jnp.int32), qb))
    return out.swapaxes(0, 1).reshape(B, S, -1)


def pool_mixer(u, pool_w, pool_scale):
    B, L, _ = u.shape
    ug = u.reshape(B, L, POOL_GROUPS, POOL_GROUP_DIM)
    csum = jnp.pad(jnp.cumsum(ug.astype(jnp.float32), axis=1), ((0, 0), (1, 0), (0, 0), (0, 0)))
    t = jnp.arange(L, dtype=jnp.int32)
    means = []
    for g, w in enumerate(POOL_WINDOWS):
        lo = jnp.clip(t - w // 2, 0, L)
        hi = jnp.clip(t + w - w // 2, 0, L)
        cg = csum[:, :, g]
        ssum = jnp.take(cg, hi, axis=1) - jnp.take(cg, lo, axis=1)
        means.append(ssum / (hi - lo).astype(jnp.float32)[None, :, None])
    pooled = jnp.stack(means, axis=2).astype(u.dtype) - ug
    mixed = jnp.einsum('blgc,gcd->blgd', pooled, pool_w).reshape(B, L, POOL_DIM)
    return mixed * pool_scale


def even_mixer(h_lat, h_ctx, w_in, q_g, k_g, pool_w, pool_scale, w_out, rope, need_ctx):
    splits = [POOL_DIM, POOL_DIM + B_Q_HEADS * HEAD_DIM, POOL_DIM + (B_Q_HEADS + B_KV_HEADS) * HEAD_DIM]

    def project(h):
        B, L, _ = h.shape
        u, q, k, v = jnp.split(h @ w_in, splits, axis=-1)
        q = rmsnorm(q.reshape(B, L, B_Q_HEADS, HEAD_DIM), q_g)
        k = rmsnorm(k.reshape(B, L, B_KV_HEADS, HEAD_DIM), k_g)
        v = v.reshape(B, L, B_KV_HEADS, HEAD_DIM)
        return u, q, k, v

    u_l, q_l, k_l, v_l = project(h_lat)
    u_c, q_c, k_c, v_c = project(h_ctx)
    q_l = apply_rope_2d(q_l, rope)
    k_l = apply_rope_2d(k_l, rope)
    k_all = jnp.concatenate([k_c, k_l], axis=1)
    v_all = jnp.concatenate([v_c, v_l], axis=1)
    a_l = global_attn_latent(split_gqa(q_l, B_KV_HEADS), k_all, v_all)
    y_lat = jnp.concatenate([pool_mixer(u_l, pool_w, pool_scale), a_l], axis=-1) @ w_out
    y_ctx = None
    if need_ctx:
        B, Lc = h_ctx.shape[:2]
        a_c = dense_gqa(split_gqa(q_c, B_KV_HEADS), k_c, v_c).reshape(B, Lc, -1)
        y_ctx = jnp.concatenate([pool_mixer(u_c, pool_w, pool_scale), a_c], axis=-1) @ w_out
    return y_lat, y_ctx


def odd_mixer(h_lat, h_ctx, w_in, sink, w_out, rope, need_ctx):
    splits = [C_Q_HEADS * HEAD_DIM, (C_Q_HEADS + C_KV_HEADS) * HEAD_DIM]

    def project(h):
        B, L, _ = h.shape
        q, k, v = jnp.split(h @ w_in, splits, axis=-1)
        return (q.reshape(B, L, C_Q_HEADS, HEAD_DIM), k.reshape(B, L, C_KV_HEADS, HEAD_DIM),
                v.reshape(B, L, C_KV_HEADS, HEAD_DIM))

    q_l, k_l, v_l = project(h_lat)
    q_c, k_c, v_c = project(h_ctx)
    q_l = apply_rope_2d(q_l, rope)
    k_l = apply_rope_2d(k_l, rope)
    sink_g = sink.reshape(C_KV_HEADS, C_Q_HEADS // C_KV_HEADS)
    a_l = window_attn_latent(split_gqa(q_l, C_KV_HEADS), k_l, v_l, k_c, v_c, sink_g)
    y_lat = a_l @ w_out
    y_ctx = None
    if need_ctx:
        B, Lc = h_ctx.shape[:2]
        y_ctx = dense_gqa(split_gqa(q_c, C_KV_HEADS), k_c, v_c, sink_g).reshape(B, Lc, -1) @ w_out
    return y_lat, y_ctx


def peer(h, w_q, keys1, keys2, u_tab, v_tab):
    T, D = h.shape
    half = PEER_DKEY // 2
    hc = h.reshape(T // PEER_CHUNK, PEER_CHUNK, D)

    def chunk(xc):
        q = (xc @ w_q).reshape(PEER_CHUNK, PEER_HEADS, PEER_DKEY).astype(jnp.float32)
        s1 = jnp.einsum('chd,nd->chn', q[..., :half], keys1.astype(jnp.float32))
        s2 = jnp.einsum('chd,nd->chn', q[..., half:], keys2.astype(jnp.float32))
        v1, i1 = lax.top_k(s1, PEER_TOPK)
        v2, i2 = lax.top_k(s2, PEER_TOPK)
        cand = (v1[..., :, None] + v2[..., None, :]).reshape(PEER_CHUNK, PEER_HEADS, PEER_TOPK * PEER_TOPK)
        sv, si = lax.top_k(cand, PEER_TOPK)
        e1 = jnp.take_along_axis(i1, si // PEER_TOPK, axis=-1)
        e2 = jnp.take_along_axis(i2, si % PEER_TOPK, axis=-1)
        idx = e1 * PEER_NKEYS + e2
        g = jax.nn.softmax(sv, axis=-1)
        u = u_tab[idx]
        a = jax.nn.gelu(jnp.einsum('chkd,cd->chk', u, xc).astype(jnp.float32), approximate=False)
        w = (g * a).astype(xc.dtype)
        return jnp.einsum('chk,chkd->cd', w, v_tab[idx])

    return lax.map(chunk, hc).reshape(T, D)


def setup_inputs(seed: int = 0) -> dict:
    key = jax.random.key(seed)
    ks = jax.random.split(key, 24)
    D = D_MODEL
    nrm = jax.random.normal
    f32 = jnp.float32
    return {
        "x": nrm(ks[0], (BATCH, SEQ, D), f32),
        "c": nrm(ks[1], (BATCH, D), f32),
        "ctx": nrm(ks[2], (BATCH, CTX_LEN, D), f32),
        "c_ctx": nrm(ks[3], (D,), f32),
        "ada_w": nrm(ks[4], (DEPTH, D, 6 * D), f32) * (0.5 * D ** -0.5),
        "ada_b": nrm(ks[5], (DEPTH, 6 * D), f32) * 0.02,
        "norm1_g": 1.0 + 0.05 * nrm(ks[6], (DEPTH, D), f32),
        "norm2_g": 1.0 + 0.05 * nrm(ks[7], (DEPTH, D), f32),
        "final_g": 1.0 + 0.05 * nrm(ks[8], (D,), f32),
        "e_w_in": nrm(ks[9], (N_EVEN, D, D_IN_EVEN), f32) * D ** -0.5,
        "e_q_norm_g": 1.0 + 0.05 * nrm(ks[10], (N_EVEN, HEAD_DIM), f32),
        "e_k_norm_g": 1.0 + 0.05 * nrm(ks[11], (N_EVEN, HEAD_DIM), f32),
        "e_pool_w": nrm(ks[12], (N_EVEN, POOL_GROUPS, POOL_GROUP_DIM, POOL_GROUP_DIM), f32) * POOL_GROUP_DIM ** -0.5,
        "e_pool_scale": 1.0 + 0.1 * nrm(ks[13], (N_EVEN, POOL_DIM), f32),
        "e_w_out": nrm(ks[14], (N_EVEN, D_MIX_EVEN, D), f32) * D_MIX_EVEN ** -0.5,
        "o_w_in": nrm(ks[15], (N_ODD, D, D_IN_ODD), f32) * D ** -0.5,
        "o_sink": nrm(ks[16], (N_ODD, C_Q_HEADS), f32) * 0.5,
        "o_w_out": nrm(ks[17], (N_ODD, D_MIX_ODD, D), f32) * D_MIX_ODD ** -0.5,
        "p_w_q": nrm(ks[18], (DEPTH, D, PEER_HEADS * PEER_DKEY), f32) * D ** -0.5,
        "p_keys1": nrm(ks[19], (DEPTH, PEER_NKEYS, PEER_DKEY // 2), f32) * (PEER_DKEY // 2) ** -0.5,
        "p_keys2": nrm(ks[20], (DEPTH, PEER_NKEYS, PEER_DKEY // 2), f32) * (PEER_DKEY // 2) ** -0.5,
        "p_u": nrm(ks[21], (DEPTH, PEER_N_EXPERTS, D), f32) * D ** -0.5,
        "p_v": nrm(ks[22], (DEPTH, PEER_N_EXPERTS, D), f32),
    }


def reference(x, c, ctx, c_ctx, ada_w, ada_b, norm1_g, norm2_g, final_g,
              e_w_in, e_q_norm_g, e_k_norm_g, e_pool_w, e_pool_scale, e_w_out,
              o_w_in, o_sink, o_w_out,
              p_w_q, p_keys1, p_keys2, p_u, p_v):
    B, S, D = x.shape
    ROWS = S // GRID_W
    rope = rope_2d_tables(ROWS)
    silu_c = jax.nn.silu(c)
    silu_cc = jax.nn.silu(c_ctx)
    for i in range(DEPTH):
        need_ctx = i < DEPTH - 1
        mod = silu_c @ ada_w[i] + ada_b[i]
        mod_c = silu_cc @ ada_w[i] + ada_b[i]
        sh1, sc1, g1, sh2, sc2, g2 = jnp.split(mod[:, None, :], 6, axis=-1)
        csh1, csc1, cg1, csh2, csc2, cg2 = jnp.split(mod_c, 6, axis=-1)

        h_lat = modulate(rmsnorm(x, norm1_g[i]), sh1, sc1)
        h_ctx = modulate(rmsnorm(ctx, norm1_g[i]), csh1, csc1)
        if i % 2 == 0:
            j = i // 2
            y_lat, y_ctx = even_mixer(h_lat, h_ctx, e_w_in[j], e_q_norm_g[j], e_k_norm_g[j],
                                      e_pool_w[j], e_pool_scale[j], e_w_out[j], rope, need_ctx)
        else:
            j = i // 2
            y_lat, y_ctx = odd_mixer(h_lat, h_ctx, o_w_in[j], o_sink[j], o_w_out[j], rope, need_ctx)
        x = x + g1 * y_lat
        h2 = modulate(rmsnorm(x, norm2_g[i]), sh2, sc2)
        if need_ctx:
            ctx = ctx + cg1 * y_ctx
            h2c = modulate(rmsnorm(ctx, norm2_g[i]), csh2, csc2)
            tokens = jnp.concatenate([h2.reshape(-1, D), h2c.reshape(-1, D)], axis=0)
            out = peer(tokens, p_w_q[i], p_keys1[i], p_keys2[i], p_u[i], p_v[i])
            x = x + g2 * out[:B * S].reshape(B, S, D)
            ctx = ctx + cg2 * out[B * S:].reshape(B, -1, D)
        else:
            out = peer(h2.reshape(-1, D), p_w_q[i], p_keys1[i], p_keys2[i], p_u[i], p_v[i])
            x = x + g2 * out.reshape(B, S, D)
    return rmsnorm(x, final_g)
```

```cpp
#include <hip/hip_runtime.h>
#include <hip/hip_cooperative_groups.h>
#include <cstdio>
#include <cstdint>
namespace cg = cooperative_groups;

#ifndef MK_ONE_LAUNCH
#define MK_ONE_LAUNCH 0
#endif

#define LAS __attribute__((address_space(3)))
typedef unsigned short bf16;
typedef short bf16x8 __attribute__((ext_vector_type(8)));
typedef float f32x4 __attribute__((ext_vector_type(4)));
typedef unsigned u32x4 __attribute__((ext_vector_type(4)));
typedef unsigned u32x2 __attribute__((ext_vector_type(2)));

constexpr int NB = 4, SEQ = 8192, DM = 1024, CTXL = 256, RB = SEQ + CTXL, NR = NB * RB;
constexpr int DIN = 1536, DPQ = 2048, NEXP = 16384;
constexpr int MODW = 6 * DM;
constexpr float EPS = 1e-6f;
constexpr float C2 = 0.125f * 1.4426950408889634f;
constexpr float LOG2E = 1.4426950408889634f;
constexpr int NWAVES = 8, NTHR = 512;
constexpr int LDS_BYTES = 147456;

constexpr size_t MiB = 1u << 20;
constexpr size_t WS_CTL = 0, WS_MOD = 1 * MiB, WS_XCTX = 2 * MiB, WS_WINT = 6 * MiB, WS_WOUTT = 12 * MiB, WS_WQT = 16 * MiB, WS_KEYS = 24 * MiB;
constexpr size_t WS_XN = 26 * MiB, WS_QKVU = 92 * MiB, WS_MIX = 191 * MiB, WS_PQ = 92 * MiB  ;
constexpr size_t WS_IDX = 257 * MiB, WS_GW = 274 * MiB, WS_TABU = 291 * MiB, WS_TABV = 355 * MiB, WS_END = 419 * MiB;
static_assert(WS_XN + (size_t)NR * DM * 2 <= WS_QKVU && WS_QKVU + (size_t)NR * DIN * 2 <= WS_MIX && WS_MIX + (size_t)NR * DM * 2 <= WS_IDX, "ws map");
static_assert(WS_PQ + (size_t)NR * DPQ * 2 <= WS_IDX && WS_IDX + (size_t)NR * 128 * 4 <= WS_GW && WS_GW + (size_t)NR * 128 * 4 <= WS_TABU, "ws map 2");
static_assert(WS_TABU + (size_t)2 * NEXP * DM * 2 <= WS_TABV && WS_TABV + (size_t)2 * NEXP * DM * 2 <= WS_END, "ws map 3");

enum { I_X = 0, I_C, I_CTX, I_CCTX, I_ADAW, I_ADAB, I_N1G, I_N2G, I_FING, I_EWIN, I_EQG, I_EKG, I_EPW, I_EPS, I_EWOUT, I_OWIN, I_OSINK, I_OWOUT, I_PWQ, I_PK1, I_PK2, I_PU, I_PV, N_IN };

struct Args { const float* in[N_IN]; float* out; unsigned char* ws; int ph_lo, ph_hi; };

struct Frame {
    const float* const* in;
    float* out; unsigned char* ws;
    LAS unsigned char* lds;
    int tid, lane, wave, gw, ngw, gtid, ngt;
};
#define F_mod   ((float*)(F.ws + WS_MOD))
#define F_xctx  ((float*)(F.ws + WS_XCTX))
#define F_winT  ((bf16*)(F.ws + WS_WINT))
#define F_woutT ((bf16*)(F.ws + WS_WOUTT))
#define F_wqT   ((bf16*)(F.ws + WS_WQT))
#define F_keys  ((bf16*)(F.ws + WS_KEYS))
#define F_xn    ((bf16*)(F.ws + WS_XN))
#define F_qkvu  ((bf16*)(F.ws + WS_QKVU))
#define F_mix   ((bf16*)(F.ws + WS_MIX))
#define F_pq    ((bf16*)(F.ws + WS_PQ))
#define F_idx   ((int*)(F.ws + WS_IDX))
#define F_gwt   ((float*)(F.ws + WS_GW))
#define F_tabu  ((bf16*)(F.ws + WS_TABU))
#define F_tabv  ((bf16*)(F.ws + WS_TABV))

__device__ __forceinline__ float bf2f(unsigned v) { return __uint_as_float(v << 16); }
__device__ __forceinline__ float bflo(unsigned w) { return __uint_as_float(w << 16); }
__device__ __forceinline__ float bfhi(unsigned w) { return __uint_as_float(w & 0xffff0000u); }
__device__ __forceinline__ unsigned f2bf(float f) { unsigned u = __float_as_uint(f); return (u + 0x7fffu + ((u >> 16) & 1u)) >> 16; }
__device__ __forceinline__ unsigned pk2(float lo, float hi) { return f2bf(lo) | (f2bf(hi) << 16); }
__device__ __forceinline__ float wave_sum(float v) {
#pragma unroll
    for (int o = 1; o < 64; o <<= 1) v += __shfl_xor(v, o);
    return v;
}
__device__ __forceinline__ void row_info(int r, int& b, int& j) { b = r / RB; j = r - b * RB; }
__device__ __forceinline__ float* xs_row(const Frame& F, int b, int j) { return j < CTXL ? F_xctx + (size_t)(b * CTXL + j) * DM : F.out + (size_t)(b * SEQ + (j - CTXL)) * DM; }
__device__ __forceinline__ const float* in_row(const Frame& F, int b, int j) { return j < CTXL ? F.in[I_CTX] + (size_t)(b * CTXL + j) * DM : F.in[I_X] + (size_t)(b * SEQ + (j - CTXL)) * DM; }
__device__ __forceinline__ float silu_f(float x) { return x / (1.f + __expf(-x)); }
__device__ __forceinline__ float gelu_erf(float x) { return 0.5f * x * (1.f + erff(x * 0.70710678118654752f)); }

__device__ __forceinline__ void transpose_item(const float* W, int K, int N, bf16* WT, LAS float* scr, int item, int lane) {
    const int nblk = N / 32, kb = item / nblk, nb = item % nblk, k0 = 64 * kb, n0 = 32 * nb;
#pragma unroll 8
    for (int i = 0; i < 32; ++i) { const int kk = 2 * i + (lane >> 5); scr[kk * 33 + (lane & 31)] = W[(size_t)(k0 + kk) * N + n0 + (lane & 31)]; }
    asm volatile("s_waitcnt lgkmcnt(0)" ::: "memory");
    const int c = lane & 7;
#pragma unroll
    for (int j = 0; j < 4; ++j) { const int n = (lane >> 3) + 8 * j; const LAS float* s = scr + (8 * c) * 33 + n;
        u32x4 o; o.x = pk2(s[0 * 33], s[1 * 33]); o.y = pk2(s[2 * 33], s[3 * 33]); o.z = pk2(s[4 * 33], s[5 * 33]); o.w = pk2(s[6 * 33], s[7 * 33]);
        *(u32x4*)(WT + (size_t)(n0 + n) * K + k0 + 8 * c) = o; }
    asm volatile("s_waitcnt lgkmcnt(0)" ::: "memory");
}
__device__ __forceinline__ void cvt_stream(const float* src, bf16* dst, size_t n, size_t gt, size_t ngt) {
    for (size_t i = gt * 8; i < n; i += ngt * 8) { const f32x4 a = *(const f32x4*)(src + i), b = *(const f32x4*)(src + i + 4);
        u32x4 o; o.x = pk2(a.x, a.y); o.y = pk2(a.z, a.w); o.z = pk2(b.x, b.y); o.w = pk2(b.z, b.w); *(u32x4*)(dst + i) = o; }
}
__device__ __forceinline__ void prep_phase(Frame& F) {
    LAS float* sl = (LAS float*)F.lds;
    if (blockIdx.x < 24) {
        for (int i = F.tid; i < 5 * DM; i += NTHR) { const int m = i / DM, k = i % DM; const float v = m < 4 ? F.in[I_C][m * DM + k] : F.in[I_CCTX][k]; sl[i] = silu_f(v); }
        __syncthreads();
        const int o = blockIdx.x * NTHR + F.tid, l = o / MODW, col = o % MODW;
        const float* w = F.in[I_ADAW] + (size_t)l * DM * MODW + col;
        float a0 = 0.f, a1 = 0.f, a2 = 0.f, a3 = 0.f, a4 = 0.f;
#pragma unroll 8
        for (int k = 0; k < DM; ++k) { const float wv = w[(size_t)k * MODW]; a0 += sl[k] * wv; a1 += sl[DM + k] * wv; a2 += sl[2 * DM + k] * wv; a3 += sl[3 * DM + k] * wv; a4 += sl[4 * DM + k] * wv; }
        const float bb = F.in[I_ADAB][l * MODW + col]; float* mo = F_mod + (size_t)l * 5 * MODW + col;
        mo[0] = a0 + bb; mo[MODW] = a1 + bb; mo[2 * MODW] = a2 + bb; mo[3 * MODW] = a3 + bb; mo[4 * MODW] = a4 + bb;
        __syncthreads();
    }
    LAS float* scr = (LAS float*)(F.lds + 32768 + F.wave * 12288);
    constexpr int I_IN = 16 * (DIN / 32), I_OUT = 16 * (DM / 32), I_Q = 16 * (DPQ / 32), I_L = I_IN + I_OUT + I_Q;
    for (int it = F.gw; it < 2 * I_L; it += F.ngw) {
        const int l = it / I_L; int r = it % I_L;
        if (r < I_IN) { transpose_item(l == 0 ? F.in[I_EWIN] : F.in[I_OWIN], DM, DIN, F_winT + (size_t)l * DIN * DM, scr, r, F.lane); continue; } r -= I_IN;
        if (r < I_OUT) { transpose_item(l == 0 ? F.in[I_EWOUT] : F.in[I_OWOUT], DM, DM, F_woutT + (size_t)l * DM * DM, scr, r, F.lane); continue; } r -= I_OUT;
        transpose_item(F.in[I_PWQ] + (size_t)l * DM * DPQ, DM, DPQ, F_wqT + (size_t)l * DPQ * DM, scr, r, F.lane);
    }
    cvt_stream(F.in[I_PU], F_tabu, (size_t)2 * NEXP * DM, F.gtid, F.ngt);
    cvt_stream(F.in[I_PV], F_tabv, (size_t)2 * NEXP * DM, F.gtid, F.ngt);
    for (int l = 0; l < 2; ++l) { cvt_stream(F.in[I_PK1] + l * 16384, F_keys + (l * 2 + 0) * 16384, 16384, F.gtid, F.ngt); cvt_stream(F.in[I_PK2] + l * 16384, F_keys + (l * 2 + 1) * 16384, 16384, F.gtid, F.ngt); }
}

template <int WHICH> __device__ __forceinline__ void norm_phase(Frame& F, int layer, bool from_input, bool skip_ctx) {
    const float* gam = F.in[WHICH == 0 ? I_N1G : I_N2G] + layer * DM;
    for (int r = F.gw; r < NR; r += F.ngw) {
        int b, j; row_info(r, b, j); if (skip_ctx && j < CTXL) continue;
        const float* xr = from_input ? in_row(F, b, j) : xs_row(F, b, j);
        const float* sh = F_mod + ((size_t)layer * 5 + (j < CTXL ? 4 : b)) * MODW + (WHICH ? 3 * DM : 0); const float* sc = sh + DM;
        f32x4 v[4]; float ss = 0.f;
#pragma unroll
        for (int q = 0; q < 4; ++q) { v[q] = *(const f32x4*)(xr + 4 * F.lane + 256 * q); ss += (v[q].x * v[q].x + v[q].y * v[q].y) + (v[q].z * v[q].z + v[q].w * v[q].w); }
        const float rstd = rsqrtf(wave_sum(ss) * (1.f / DM) + EPS);
        bf16* orow = F_xn + (size_t)r * DM;
#pragma unroll
        for (int q = 0; q < 4; ++q) { const int c = 4 * F.lane + 256 * q; const f32x4 g = *(const f32x4*)(gam + c), s1 = *(const f32x4*)(sc + c), s0 = *(const f32x4*)(sh + c);
            const f32x4 y = (v[q] * rstd * g) * (s1 + 1.f) + s0; u32x2 o; o.x = pk2(y.x, y.y); o.y = pk2(y.z, y.w); *(u32x2*)(orow + c) = o; }
    }
}

template <class Epi> __device__ __forceinline__ void gemm_simple(Frame& F, const bf16* A, int lda, const bf16* Bt, int M, int N, int K, bool skip_ctx, const Epi E) {
    const int ntn = N / 64, nt = (M / 32) * ntn, fr = F.lane & 15, fq = F.lane >> 4;
    for (int t = F.gw; t < nt; t += F.ngw) {
        const int m0 = (t / ntn) * 32, n0 = (t % ntn) * 64;
        if (skip_ctx && (m0 % RB) < CTXL) continue;
        f32x4 acc[2][4];
#pragma unroll
        for (int a = 0; a < 2; ++a)
#pragma unroll
            for (int b = 0; b < 4; ++b) acc[a][b] = (f32x4){0.f, 0.f, 0.f, 0.f};
        const bf16* ap = A + (size_t)(m0 + fr) * lda + 8 * fq; const bf16* bp = Bt + (size_t)(n0 + fr) * K + 8 * fq;
        for (int k0 = 0; k0 < K; k0 += 32) {
            bf16x8 av[2], bv[4];
#pragma unroll
            for (int a = 0; a < 2; ++a) av[a] = *(const bf16x8*)(ap + (size_t)(16 * a) * lda + k0);
#pragma unroll
            for (int b = 0; b < 4; ++b) bv[b] = *(const bf16x8*)(bp + (size_t)(16 * b) * K + k0);
#pragma unroll
            for (int a = 0; a < 2; ++a)
#pragma unroll
                for (int b = 0; b < 4; ++b) acc[a][b] = __builtin_amdgcn_mfma_f32_16x16x32_bf16(av[a], bv[b], acc[a][b], 0, 0, 0);
        }
#pragma unroll
        for (int a = 0; a < 2; ++a)
#pragma unroll
            for (int b = 0; b < 4; ++b)
#pragma unroll
                for (int i = 0; i < 4; ++i) E(m0 + 16 * a + 4 * fq + i, n0 + 16 * b + fr, acc[a][b][i]);
    }
}
struct EpiStoreBf16 { bf16* O; int ldc; __device__ __forceinline__ void operator()(int r, int c, float v) const { O[(size_t)r * ldc + c] = (bf16)f2bf(v); } };
struct EpiResid {
    const float* x_in; const float* ctx_in; float* out; float* xctx; const float* gate; int from_input;
    __device__ __forceinline__ void operator()(int r, int c, float v) const {
        const int b = r / RB, j = r - b * RB; const bool isc = j < CTXL;
        const size_t off = isc ? (size_t)(b * CTXL + j) * DM + c : (size_t)(b * SEQ + (j - CTXL)) * DM + c;
        float* dst = isc ? xctx + off : out + off;
        const float base = from_input ? (isc ? ctx_in[off] : x_in[off]) : *dst;
        *dst = base + gate[(size_t)(isc ? 4 : b) * MODW + c] * v;
    }
};

__device__ __forceinline__ void qkrope_phase(Frame& F, int layer) {
    const int nh = layer == 0 ? 16 : 20, nq = layer == 0 ? 12 : 16, qcol0 = layer == 0 ? 256 : 0;
    const long total = (long)NR * nh;
    for (long i = F.gtid; i < total; i += F.ngt) {
        const int r = (int)(i / nh), hh = (int)(i % nh); int b, j; row_info(r, b, j);
        const bool isq = hh < nq; const int col = isq ? qcol0 + hh * 64 : 1024 + (hh - nq) * 64;
        bf16* p = F_qkvu + (size_t)r * DIN + col;
        float x[64];
#pragma unroll
        for (int c = 0; c < 8; ++c) { const u32x4 w = *(const u32x4*)(p + 8 * c); x[8 * c] = bflo(w.x); x[8 * c + 1] = bfhi(w.x); x[8 * c + 2] = bflo(w.y); x[8 * c + 3] = bfhi(w.y); x[8 * c + 4] = bflo(w.z); x[8 * c + 5] = bfhi(w.z); x[8 * c + 6] = bflo(w.w); x[8 * c + 7] = bfhi(w.w); }
        if (layer == 0) {
            const float* g = isq ? F.in[I_EQG] : F.in[I_EKG]; float ss = 0.f;
#pragma unroll
            for (int c = 0; c < 64; ++c) ss += x[c] * x[c];
            const float rs = rsqrtf(ss * (1.f / 64.f) + EPS);
#pragma unroll
            for (int c = 0; c < 64; ++c) x[c] = x[c] * rs * g[c];
        }
        if (j >= CTXL) {
            const int t = j - CTXL; const float pr = (float)(t >> 6), pc = (float)(t & 63);
#pragma unroll
            for (int c = 0; c < 16; ++c) {
                const float inv = exp2f(-(float)c * (13.287712379549449f / 16.f));
                float rr = pr * inv * 0.15915494309189535f, rc = pc * inv * 0.15915494309189535f; rr -= floorf(rr); rc -= floorf(rc);
                const float sr = __builtin_amdgcn_sinf(rr), cr = __builtin_amdgcn_cosf(rr), sc_ = __builtin_amdgcn_sinf(rc), cc = __builtin_amdgcn_cosf(rc);
                const float a1 = x[c], a2 = x[16 + c]; x[c] = a1 * cr - a2 * sr; x[16 + c] = a1 * sr + a2 * cr;
                const float b1 = x[32 + c], b2 = x[48 + c]; x[32 + c] = b1 * cc - b2 * sc_; x[48 + c] = b1 * sc_ + b2 * cc;
            }
        }
        const float s = isq ? C2 : 1.f;
#pragma unroll
        for (int c = 0; c < 8; ++c) { u32x4 w; w.x = pk2(x[8 * c] * s, x[8 * c + 1] * s); w.y = pk2(x[8 * c + 2] * s, x[8 * c + 3] * s); w.z = pk2(x[8 * c + 4] * s, x[8 * c + 5] * s); w.w = pk2(x[8 * c + 6] * s, x[8 * c + 7] * s); *(u32x4*)(p + 8 * c) = w; }
    }
}

__device__ __forceinline__ void attn_key(const bf16* kp, const bf16* vp, const float (&q)[64], float (&o)[64], float& m, float& l) {
    float s = 0.f;
#pragma unroll
    for (int c = 0; c < 8; ++c) { const u32x4 w = *(const u32x4*)(kp + 8 * c);
        s += q[8 * c] * bflo(w.x) + q[8 * c + 1] * bfhi(w.x) + q[8 * c + 2] * bflo(w.y) + q[8 * c + 3] * bfhi(w.y) + q[8 * c + 4] * bflo(w.z) + q[8 * c + 5] * bfhi(w.z) + q[8 * c + 6] * bflo(w.w) + q[8 * c + 7] * bfhi(w.w); }
    if (s > m) { const float al = exp2f(m - s); l *= al;
#pragma unroll
        for (int c = 0; c < 64; ++c) o[c] *= al;
        m = s; }
    const float p = exp2f(s - m); l += p;
#pragma unroll
    for (int c = 0; c < 8; ++c) { const u32x4 w = *(const u32x4*)(vp + 8 * c);
        o[8 * c] += p * bflo(w.x); o[8 * c + 1] += p * bfhi(w.x); o[8 * c + 2] += p * bflo(w.y); o[8 * c + 3] += p * bfhi(w.y); o[8 * c + 4] += p * bflo(w.z); o[8 * c + 5] += p * bfhi(w.z); o[8 * c + 6] += p * bflo(w.w); o[8 * c + 7] += p * bfhi(w.w); }
}
__device__ __forceinline__ void attn_simple_phase(Frame& F, int layer) {
    const int nq = layer == 0 ? 12 : 16, G = layer == 0 ? 3 : 4, qcol0 = layer == 0 ? 256 : 0, ocol0 = layer == 0 ? 256 : 0;
    const int nunits = NB * nq * 33, hb = blockIdx.x * 2 + (F.tid >> 8), nhb = gridDim.x * 2;
    for (int u = hb; u < nunits; u += nhb) {
        const int ch = u % 33, h = (u / 33) % nq, b = u / (33 * nq);
        if (layer == 1 && ch == 0) continue;
        const int j = ch * 256 + (F.tid & 255), r = b * RB + j, kvh = h / G;
        const bf16* qp = F_qkvu + (size_t)r * DIN + qcol0 + h * 64;
        float q[64], o[64];
#pragma unroll
        for (int c = 0; c < 8; ++c) { const u32x4 w = *(const u32x4*)(qp + 8 * c); q[8 * c] = bflo(w.x); q[8 * c + 1] = bfhi(w.x); q[8 * c + 2] = bflo(w.y); q[8 * c + 3] = bfhi(w.y); q[8 * c + 4] = bflo(w.z); q[8 * c + 5] = bfhi(w.z); q[8 * c + 6] = bflo(w.w); q[8 * c + 7] = bfhi(w.w); }
#pragma unroll
        for (int c = 0; c < 64; ++c) o[c] = 0.f;
        float m = -INFINITY, l = 0.f;
        const bf16* kb = F_qkvu + (size_t)b * RB * DIN + 1024 + kvh * 64; const bf16* vb = kb + 256;
        if (layer == 0) {
            const int nk = ch == 0 ? CTXL : RB;
            for (int k = 0; k < nk; ++k) attn_key(kb + (size_t)k * DIN, vb + (size_t)k * DIN, q, o, m, l);
        } else {
            for (int k = 0; k < CTXL; ++k) attn_key(kb + (size_t)k * DIN, vb + (size_t)k * DIN, q, o, m, l);
            const int t = j - CTXL; int lo = t - 128; if (lo < 0) lo = 0; int hi = t + 128; if (hi > SEQ - 1) hi = SEQ - 1;
            for (int k = lo; k <= hi; ++k) attn_key(kb + (size_t)(CTXL + k) * DIN, vb + (size_t)(CTXL + k) * DIN, q, o, m, l);
            const float sk = F.in[I_OSINK][h] * LOG2E;
            if (sk > m) { const float al = exp2f(m - sk); l *= al;
#pragma unroll
                for (int c = 0; c < 64; ++c) o[c] *= al;
                m = sk; }
            l += exp2f(sk - m);
        }
        const float rl = 1.f / l; bf16* op = F_mix + (size_t)r * DM + ocol0 + h * 64;
#pragma unroll
        for (int c = 0; c < 8; ++c) { u32x4 w; w.x = pk2(o[8 * c] * rl, o[8 * c + 1] * rl); w.y = pk2(o[8 * c + 2] * rl, o[8 * c + 3] * rl); w.z = pk2(o[8 * c + 4] * rl, o[8 * c + 5] * rl); w.w = pk2(o[8 * c + 6] * rl, o[8 * c + 7] * rl); *(u32x4*)(op + 8 * c) = w; }
    }
}

__device__ __forceinline__ void pool_phase(Frame& F) {
    LAS float* pl = (LAS float*)(F.lds + 8192) + F.wave * 256;
    const float* pw = F.in[I_EPW]; const float* ps = F.in[I_EPS];
    for (int r = F.gw; r < NR; r += F.ngw) {
        int b, j; row_info(r, b, j);
        const int L = j < CTXL ? CTXL : SEQ, t = j < CTXL ? j : j - CTXL, r0 = r - t;
#pragma unroll
        for (int g = 0; g < 4; ++g) {
            const int w = 2 << g; int lo = t - w / 2; if (lo < 0) lo = 0; int hi = t + w - w / 2; if (hi > L) hi = L;
            float s = 0.f;
            for (int p = lo; p < hi; ++p) s += bf2f(F_qkvu[(size_t)(r0 + p) * DIN + g * 64 + F.lane]);
            pl[g * 64 + F.lane] = s / (float)(hi - lo) - bf2f(F_qkvu[(size_t)r * DIN + g * 64 + F.lane]);
        }
        asm volatile("s_waitcnt lgkmcnt(0)" ::: "memory");
#pragma unroll
        for (int g = 0; g < 4; ++g) {
            float a = 0.f;
#pragma unroll 8
            for (int c = 0; c < 64; ++c) a += pl[g * 64 + c] * pw[(g * 64 + c) * 64 + F.lane];
            F_mix[(size_t)r * DM + g * 64 + F.lane] = (bf16)f2bf(a * ps[g * 64 + F.lane]);
        }
        asm volatile("s_waitcnt lgkmcnt(0)" ::: "memory");
    }
}

__device__ __forceinline__ void wave_argmax(float& best, int& bi) {
#pragma unroll
    for (int o = 32; o >= 1; o >>= 1) { const float ov = __shfl_xor(best, o); const int oi = __shfl_xor(bi, o); if (ov > best || (ov == best && oi < bi)) { best = ov; bi = oi; } }
}
__device__ __forceinline__ void route_phase(Frame& F, int layer, bool skip_ctx) {
    const float* k1 = F.in[I_PK1] + layer * 16384; const float* k2 = F.in[I_PK2] + layer * 16384;
    const long total = (long)NR * 8; const int lane = F.lane;
    for (long it = F.gw; it < total; it += F.ngw) {
        const int r = (int)(it >> 3), h = (int)(it & 7);
        if (skip_ctx && (r % RB) < CTXL) continue;
        const bf16* q = F_pq + (size_t)r * DPQ + h * 256;
        float s1a = 0.f, s1b = 0.f, s2a = 0.f, s2b = 0.f;
        for (int d = 0; d < 128; d += 4) {
            const u32x2 qa = *(const u32x2*)(q + d), qb = *(const u32x2*)(q + 128 + d);
            const float a0 = bflo(qa.x), a1 = bfhi(qa.x), a2 = bflo(qa.y), a3 = bfhi(qa.y), b0 = bflo(qb.x), b1 = bfhi(qb.x), b2 = bflo(qb.y), b3 = bfhi(qb.y);
            const f32x4 ka = *(const f32x4*)(k1 + lane * 128 + d), kb = *(const f32x4*)(k1 + (lane + 64) * 128 + d), kc = *(const f32x4*)(k2 + lane * 128 + d), kd = *(const f32x4*)(k2 + (lane + 64) * 128 + d);
            s1a += a0 * ka.x + a1 * ka.y + a2 * ka.z + a3 * ka.w; s1b += a0 * kb.x + a1 * kb.y + a2 * kb.z + a3 * kb.w;
            s2a += b0 * kc.x + b1 * kc.y + b2 * kc.z + b3 * kc.w; s2b += b0 * kd.x + b1 * kd.y + b2 * kd.z + b3 * kd.w;
        }
        float v1 = 0.f, v2 = 0.f; int i1 = 0, i2 = 0;
        for (int rd = 0; rd < 16; ++rd) {
            float best = fmaxf(s1a, s1b); int bi = (s1a >= s1b) ? lane : lane + 64; wave_argmax(best, bi);
            if (lane == rd) { v1 = best; i1 = bi; }
            if (bi == lane) s1a = -INFINITY; else if (bi == lane + 64) s1b = -INFINITY;
        }
        for (int rd = 0; rd < 16; ++rd) {
            float best = fmaxf(s2a, s2b); int bi = (s2a >= s2b) ? lane : lane + 64; wave_argmax(best, bi);
            if (lane == rd) { v2 = best; i2 = bi; }
            if (bi == lane) s2a = -INFINITY; else if (bi == lane + 64) s2b = -INFINITY;
        }
        const float vi = __shfl(v1, lane >> 2);
        float c0 = vi + __shfl(v2, (lane & 3) * 4 + 0), c1 = vi + __shfl(v2, (lane & 3) * 4 + 1), c2 = vi + __shfl(v2, (lane & 3) * 4 + 2), c3 = vi + __shfl(v2, (lane & 3) * 4 + 3);
        float sv = 0.f; int si = 0;
        for (int rd = 0; rd < 16; ++rd) {
            float best = c0; int bi = 4 * lane;
            if (c1 > best) { best = c1; bi = 4 * lane + 1; } if (c2 > best) { best = c2; bi = 4 * lane + 2; } if (c3 > best) { best = c3; bi = 4 * lane + 3; }
            wave_argmax(best, bi);
            if (lane == rd) { sv = best; si = bi; }
            if ((bi >> 2) == lane) { const int w = bi & 3; if (w == 0) c0 = -INFINITY; else if (w == 1) c1 = -INFINITY; else if (w == 2) c2 = -INFINITY; else c3 = -INFINITY; }
        }
        const int e1 = __shfl(i1, (si >> 4) & 15), e2 = __shfl(i2, si & 15);
        const float mx = __shfl(sv, 0); float e = (lane < 16) ? __expf(sv - mx) : 0.f; float sum = e;
#pragma unroll
        for (int o = 8; o >= 1; o >>= 1) sum += __shfl_xor(sum, o);
        if (lane < 16) { F_idx[(size_t)it * 16 + lane] = e1 * 128 + e2; F_gwt[(size_t)it * 16 + lane] = e / sum; }
    }
}

__device__ __forceinline__ void gather_phase(Frame& F, int layer, bool skip_ctx, bool last) {
    const bf16* tu = F_tabu + (size_t)layer * NEXP * DM; const bf16* tv = F_tabv + (size_t)layer * NEXP * DM;
    const int lane = F.lane;
    for (int r = F.gw; r < NR; r += F.ngw) {
        int b, j; row_info(r, b, j); if (skip_ctx && j < CTXL) continue;
        float x[16], acc[16];
        const bf16* xr = F_xn + (size_t)r * DM;
#pragma unroll
        for (int q = 0; q < 4; ++q) { const u32x2 w = *(const u32x2*)(xr + 4 * lane + 256 * q); x[4 * q] = bflo(w.x); x[4 * q + 1] = bfhi(w.x); x[4 * q + 2] = bflo(w.y); x[4 * q + 3] = bfhi(w.y); acc[4 * q] = 0.f; acc[4 * q + 1] = 0.f; acc[4 * q + 2] = 0.f; acc[4 * q + 3] = 0.f; }
        const int* ip = F_idx + (size_t)r * 128; const float* gp = F_gwt + (size_t)r * 128;
        for (int e = 0; e < 128; ++e) {
            const int id = __builtin_amdgcn_readfirstlane(ip[e]); const float g = gp[e];
            const bf16* ur = tu + (size_t)id * DM + 4 * lane; const bf16* vr = tv + (size_t)id * DM + 4 * lane;
            float d = 0.f;
#pragma unroll
            for (int q = 0; q < 4; ++q) { const u32x2 w = *(const u32x2*)(ur + 256 * q); d += x[4 * q] * bflo(w.x) + x[4 * q + 1] * bfhi(w.x) + x[4 * q + 2] * bflo(w.y) + x[4 * q + 3] * bfhi(w.y); }
            const float wgt = g * gelu_erf(wave_sum(d));
#pragma unroll
            for (int q = 0; q < 4; ++q) { const u32x2 w = *(const u32x2*)(vr + 256 * q); acc[4 * q] += wgt * bflo(w.x); acc[4 * q + 1] += wgt * bfhi(w.x); acc[4 * q + 2] += wgt * bflo(w.y); acc[4 * q + 3] += wgt * bfhi(w.y); }
        }
        float* xs = xs_row(F, b, j); const float* g2 = F_mod + ((size_t)layer * 5 + (j < CTXL ? 4 : b)) * MODW + 5 * DM;
        f32x4 y[4]; float ss = 0.f;
#pragma unroll
        for (int q = 0; q < 4; ++q) { const int c = 4 * lane + 256 * q; const f32x4 xv = *(const f32x4*)(xs + c), gv = *(const f32x4*)(g2 + c);
            y[q] = xv + gv * (f32x4){acc[4 * q], acc[4 * q + 1], acc[4 * q + 2], acc[4 * q + 3]}; ss += (y[q].x * y[q].x + y[q].y * y[q].y) + (y[q].z * y[q].z + y[q].w * y[q].w); }
        if (last) {
            const float rstd = rsqrtf(wave_sum(ss) * (1.f / DM) + EPS);
#pragma unroll
            for (int q = 0; q < 4; ++q) { const int c = 4 * lane + 256 * q; *(f32x4*)(xs + c) = y[q] * rstd * *(const f32x4*)(F.in[I_FING] + c); }
        } else {
#pragma unroll
            for (int q = 0; q < 4; ++q) *(f32x4*)(xs + 4 * lane + 256 * q) = y[q];
        }
    }
}

#define IN(k) (lo <= (k) && (k) < hi)
#define SEAM(k) do { if (IN(k) && IN((k) + 1)) grid.sync(); } while (0)
template <int LAYER> __device__ __forceinline__ void layer_phases(Frame& F, const int lo, const int hi, cg::grid_group& grid) {
    constexpr int P = 1 + 9 * LAYER; constexpr bool lastl = LAYER == 1;
    if (IN(P + 0)) norm_phase<0>(F, LAYER, LAYER == 0, false);
    SEAM(P + 0);
    if (IN(P + 1)) { const EpiStoreBf16 E{F_qkvu, DIN}; gemm_simple(F, F_xn, DM, F_winT + (size_t)LAYER * DIN * DM, NR, DIN, DM, false, E); }
    SEAM(P + 1);
    if (IN(P + 2)) qkrope_phase(F, LAYER);
    SEAM(P + 2);
    if (IN(P + 3)) { attn_simple_phase(F, LAYER); if (LAYER == 0) pool_phase(F); }
    SEAM(P + 3);
    if (IN(P + 4)) { const EpiResid E{F.in[I_X], F.in[I_CTX], F.out, F_xctx, F_mod + (size_t)LAYER * 5 * MODW + 2 * DM, LAYER == 0 ? 1 : 0}; gemm_simple(F, F_mix, DM, F_woutT + (size_t)LAYER * DM * DM, NR, DM, DM, lastl, E); }
    SEAM(P + 4);
    if (IN(P + 5)) norm_phase<1>(F, LAYER, false, lastl);
    SEAM(P + 5);
    if (IN(P + 6)) { const EpiStoreBf16 E{F_pq, DPQ}; gemm_simple(F, F_xn, DM, F_wqT + (size_t)LAYER * DPQ * DM, NR, DPQ, DM, lastl, E); }
    SEAM(P + 6);
    if (IN(P + 7)) route_phase(F, LAYER, lastl);
    SEAM(P + 7);
    if (IN(P + 8)) gather_phase(F, LAYER, lastl, lastl);
}
#undef IN
#undef SEAM

constexpr int PH_PER_LAYER = 9, N_PHASES = 1 + 2 * PH_PER_LAYER;
__global__ void __launch_bounds__(NTHR, 2) mk_fwd(Args args) {
    extern __shared__ __attribute__((aligned(16))) unsigned char lds_raw[];
    Frame F;
    F.in = args.in; F.out = args.out; F.ws = args.ws; F.lds = (LAS unsigned char*)lds_raw;
    F.tid = threadIdx.x; F.lane = F.tid & 63; F.wave = __builtin_amdgcn_readfirstlane(F.tid >> 6);
    F.gw = blockIdx.x * NWAVES + F.wave; F.ngw = gridDim.x * NWAVES; F.gtid = blockIdx.x * NTHR + F.tid; F.ngt = gridDim.x * NTHR;
    cg::grid_group grid = cg::this_grid();
    const int lo = args.ph_lo, hi = args.ph_hi;
#define IN(k) (lo <= (k) && (k) < hi)
#define SEAM(k) do { if (IN(k) && IN((k) + 1)) grid.sync(); } while (0)
    if (IN(0)) prep_phase(F);
    SEAM(0);
    layer_phases<0>(F, lo, hi, grid);
    SEAM(PH_PER_LAYER);
    layer_phases<1>(F, lo, hi, grid);
}

extern "C" void kernel_launch(void* const* d_in, const int* in_sizes, int n_in, void* d_out, int out_size, void* d_ws, size_t ws_size, hipStream_t stream) {
    static int grid = 0;
    if (grid == 0) {
        if (n_in != N_IN || out_size != NB * SEQ * DM || ws_size < WS_END) { fprintf(stderr, "kernel_launch: unexpected problem (n_in %d out %d ws %zu)\n", n_in, out_size, ws_size); grid = -1; return; }
        int dev = 0, cus = 0, per_cu = 0;
        hipGetDevice(&dev); hipDeviceGetAttribute(&cus, hipDeviceAttributeMultiprocessorCount, dev);
        hipFuncSetAttribute((const void*)mk_fwd, hipFuncAttributeMaxDynamicSharedMemorySize, LDS_BYTES);
        hipOccupancyMaxActiveBlocksPerMultiprocessor(&per_cu, (const void*)mk_fwd, NTHR, LDS_BYTES);
        if (per_cu < 1) { fprintf(stderr, "kernel_launch: occupancy query says %d blocks per CU\n", per_cu); per_cu = 1; }
        if (per_cu > 1) per_cu = 1;
        grid = cus * per_cu;
        (void)hipGetLastError();
    }
    if (grid < 0) return;
    hipMemsetAsync((char*)d_ws + WS_CTL, 0, 1 * MiB, stream);
    Args a{};
    for (int i = 0; i < N_IN; ++i) a.in[i] = (const float*)d_in[i];
    a.out = (float*)d_out; a.ws = (unsigned char*)d_ws;
#if MK_ONE_LAUNCH
    a.ph_lo = 0; a.ph_hi = N_PHASES;
    void* kargs[] = {&a};
    hipError_t e = hipLaunchCooperativeKernel((const void*)mk_fwd, dim3(grid), dim3(NTHR), kargs, LDS_BYTES, stream);
    if (e != hipSuccess) fprintf(stderr, "cooperative launch failed: %s (grid %d)\n", hipGetErrorString(e), grid);
#else
    for (int ph = 0; ph < N_PHASES; ++ph) { a.ph_lo = ph; a.ph_hi = ph + 1; hipLaunchKernelGGL(mk_fwd, dim3(grid), dim3(NTHR), LDS_BYTES, stream, a); }
#endif
}
```

```cpp
#include <hip/hip_runtime.h>
#include <hip/hip_cooperative_groups.h>
#include <cstdio>
#include <cstdint>
namespace cg = cooperative_groups;

#ifndef MK_ONE_LAUNCH
#define MK_ONE_LAUNCH 1
#endif

#define LAS __attribute__((address_space(3)))
typedef unsigned short bf16;
typedef short bf16x8 __attribute__((ext_vector_type(8)));
typedef float f32x4 __attribute__((ext_vector_type(4)));
typedef unsigned u32x4 __attribute__((ext_vector_type(4)));
typedef unsigned u32x2 __attribute__((ext_vector_type(2)));

constexpr int NB = 4, SEQ = 8192, DM = 1024, CTXL = 256, RB = SEQ + CTXL, NR = NB * RB;
constexpr int DIN = 1536, DPQ = 2048, NEXP = 16384;
constexpr int MODW = 6 * DM;
constexpr float EPS = 1e-6f;
constexpr float C2 = 0.125f * 1.4426950408889634f;
constexpr float LOG2E = 1.4426950408889634f;
constexpr int NWAVES = 8, NTHR = 512;
constexpr int LDS_BYTES = 147456;

constexpr size_t MiB = 1u << 20;
constexpr size_t WS_CTL = 0, WS_MOD = 1 * MiB, WS_XCTX = 2 * MiB, WS_WINT = 6 * MiB, WS_WOUTT = 12 * MiB, WS_WQT = 16 * MiB, WS_KEYS = 24 * MiB;
constexpr size_t WS_XN = 26 * MiB, WS_QKVU = 92 * MiB, WS_MIX = 191 * MiB, WS_PQ = 92 * MiB  ;
constexpr size_t WS_IDX = 257 * MiB, WS_GW = 274 * MiB, WS_TABU = 291 * MiB, WS_TABV = 323 * MiB, WS_SCL = 355 * MiB, WS_XS = 357 * MiB, WS_WQB = 423 * MiB, WS_PQAUX = 463 * MiB, WS_SSP = 464 * MiB, WS_US = 467 * MiB, WS_END = 485 * MiB;
static_assert(WS_XN + (size_t)NR * DM * 2 <= WS_QKVU && WS_QKVU + (size_t)NR * DIN * 2 <= WS_MIX && WS_MIX + (size_t)NR * DM * 2 <= WS_IDX, "ws map");
static_assert(WS_PQ + (size_t)NR * DPQ * 2 <= WS_IDX && WS_IDX + (size_t)NR * 128 * 8 <= WS_TABU, "ws map 2");
static_assert(WS_TABU + (size_t)2 * NEXP * DM <= WS_TABV && WS_TABV + (size_t)2 * NEXP * DM <= WS_SCL && WS_SCL + (size_t)4 * NEXP * 4 <= WS_END, "ws map 3");

enum { I_X = 0, I_C, I_CTX, I_CCTX, I_ADAW, I_ADAB, I_N1G, I_N2G, I_FING, I_EWIN, I_EQG, I_EKG, I_EPW, I_EPS, I_EWOUT, I_OWIN, I_OSINK, I_OWOUT, I_PWQ, I_PK1, I_PK2, I_PU, I_PV, N_IN };

struct Args { const float* in[N_IN]; float* out; unsigned char* ws; int ph_lo, ph_hi; };

struct Frame {
    const float* const* in;
    float* out; unsigned char* ws;
    LAS unsigned char* lds;
    int tid, lane, wave, gw, ngw, gtid, ngt;
};
#define F_mod   ((float*)(F.ws + WS_MOD))
#define F_wqb   ((bf16*)(F.ws + WS_WQB))
#define F_pqbias ((float*)(F.ws + WS_PQAUX))
#define F_gbs   ((bf16*)(F.ws + WS_PQAUX + 131072))
#define F_g2b   ((bf16*)(F.ws + WS_PQAUX + 196608))
#define F_n1b   ((bf16*)(F.ws + WS_PQAUX + 229376))
#define F_ssp   ((float*)(F.ws + WS_SSP))
#define F_xs    ((bf16*)(F.ws + WS_XS))
#define F_winT  ((bf16*)(F.ws + WS_WINT))
#define F_woutT ((bf16*)(F.ws + WS_WOUTT))
#define F_wqT   ((bf16*)(F.ws + WS_WQT))
#define F_keys  ((bf16*)(F.ws + WS_KEYS))
#define F_xn    ((bf16*)(F.ws + WS_XN))
#define F_qkvu  ((bf16*)(F.ws + WS_QKVU))
#define F_mix   ((bf16*)(F.ws + WS_MIX))
#define F_pq    ((bf16*)(F.ws + WS_PQ))
#define F_idx   ((int*)(F.ws + WS_IDX))
#define F_rt    ((u32x2*)(F.ws + WS_IDX))
#define F_gwt   ((float*)(F.ws + WS_GW))
#define F_ust   ((float*)(F.ws + WS_US))
#define F_tabu  ((unsigned char*)(F.ws + WS_TABU))
#define F_tabv  ((unsigned char*)(F.ws + WS_TABV))
#define F_scl   ((float*)(F.ws + WS_SCL))
#define F_part  ((float*)(F.ws + WS_IDX))
#define F_pwT   ((bf16*)(F.ws + WS_KEYS + 131072))

__device__ __forceinline__ float bf2f(unsigned v) { return __uint_as_float(v << 16); }
__device__ __forceinline__ float bflo(unsigned w) { return __uint_as_float(w << 16); }
__device__ __forceinline__ float bfhi(unsigned w) { return __uint_as_float(w & 0xffff0000u); }
__device__ __forceinline__ unsigned f2bf(float f) { unsigned u = __float_as_uint(f); return (u + 0x7fffu + ((u >> 16) & 1u)) >> 16; }
__device__ __forceinline__ unsigned pk2(float lo, float hi) { unsigned r; asm("v_cvt_pk_bf16_f32 %0, %1, %2" : "=v"(r) : "v"(lo), "v"(hi)); return r; }
__device__ __forceinline__ float xrow_sum(float v) {
    { const auto rr = __builtin_amdgcn_permlane16_swap(__float_as_uint(v), __float_as_uint(v), false, false); v = __uint_as_float(rr[0]) + __uint_as_float(rr[1]); }
    { const auto rr = __builtin_amdgcn_permlane32_swap(__float_as_uint(v), __float_as_uint(v), false, false); v = __uint_as_float(rr[0]) + __uint_as_float(rr[1]); }
    return v;
}
__device__ __forceinline__ float wave_max(float v) {
#define ROR_(x, c) __int_as_float(__builtin_amdgcn_update_dpp(0, __float_as_int(x), (c), 0xf, 0xf, true))
    v = fmaxf(v, ROR_(v, 0x128)); v = fmaxf(v, ROR_(v, 0x124)); v = fmaxf(v, ROR_(v, 0x122)); v = fmaxf(v, ROR_(v, 0x121));
#undef ROR_
    { const auto rr = __builtin_amdgcn_permlane16_swap(__float_as_uint(v), __float_as_uint(v), false, false); v = fmaxf(__uint_as_float(rr[0]), __uint_as_float(rr[1])); }
    { const auto rr = __builtin_amdgcn_permlane32_swap(__float_as_uint(v), __float_as_uint(v), false, false); v = fmaxf(__uint_as_float(rr[0]), __uint_as_float(rr[1])); }
    return v;
}
__device__ __forceinline__ int wave_sum_i(int d) {
    d += __builtin_amdgcn_update_dpp(0, d, 0x128, 0xf, 0xf, true); d += __builtin_amdgcn_update_dpp(0, d, 0x124, 0xf, 0xf, true); d += __builtin_amdgcn_update_dpp(0, d, 0x122, 0xf, 0xf, true); d += __builtin_amdgcn_update_dpp(0, d, 0x121, 0xf, 0xf, true);
    { const auto rr = __builtin_amdgcn_permlane16_swap((unsigned)d, (unsigned)d, false, false); d = (int)rr[0] + (int)rr[1]; }
    { const auto rr = __builtin_amdgcn_permlane32_swap((unsigned)d, (unsigned)d, false, false); d = (int)rr[0] + (int)rr[1]; }
    return d;
}
__device__ __forceinline__ float wave_sum(float v) {
#define ROR_(x, c) __int_as_float(__builtin_amdgcn_update_dpp(0, __float_as_int(x), (c), 0xf, 0xf, true))
    v += ROR_(v, 0x128); v += ROR_(v, 0x124); v += ROR_(v, 0x122); v += ROR_(v, 0x121);
#undef ROR_
    return xrow_sum(v);
}
__device__ __forceinline__ void row_info(int r, int& b, int& j) { b = r / RB; j = r - b * RB; }
__device__ __forceinline__ const float* in_row(const Frame& F, int b, int j) { return j < CTXL ? F.in[I_CTX] + (size_t)(b * CTXL + j) * DM : F.in[I_X] + (size_t)(b * SEQ + (j - CTXL)) * DM; }
__device__ __forceinline__ float silu_f(float x) { return x / (1.f + __expf(-x)); }
__device__ __forceinline__ float gelu_erf(float v) {
    const float t = __builtin_amdgcn_rcpf(fabsf(v) * 0.2316418882f + 1.0f);
    float q = t * 0.5307027145f + (-0.7265760135f); q = q * t + 0.7107068705f; q = q * t + (-0.142248368f); q = q * t + 0.127414796f; q = q * t;
    const float m = v * (q * __builtin_amdgcn_exp2f((v * v) * (-0.72134752044f)));
    return v < 0.f ? m : v - m;
}

constexpr int TICKET_OFF = 145408;
__device__ __forceinline__ void ticket_reset(Frame& F) { __syncthreads(); if (F.tid == 0) *(LAS int*)(F.lds + TICKET_OFF) = 0; __syncthreads(); }
__device__ __forceinline__ int ticket_next(Frame& F) { int k = 0; if (F.lane == 0) k = __hip_atomic_fetch_add((LAS int*)(F.lds + TICKET_OFF), 1, __ATOMIC_RELAXED, __HIP_MEMORY_SCOPE_WORKGROUP); return __builtin_amdgcn_readfirstlane(k); }
__device__ __forceinline__ void transpose_item(const float* W, int K, int N, bf16* WT, LAS float* scr, int item, int lane) {
    const int nblk = N / 32, kb = item / nblk, nb = item % nblk, k0 = 64 * kb, n0 = 32 * nb;
    f32x4 t[8];
#pragma unroll
    for (int i = 0; i < 8; ++i) t[i] = *(const f32x4*)(W + (size_t)(k0 + (lane >> 3) + 8 * i) * N + n0 + 4 * (lane & 7));
#pragma unroll
    for (int i = 0; i < 8; ++i) { LAS float* d = scr + ((lane >> 3) + 8 * i) * 33 + 4 * (lane & 7); d[0] = t[i].x; d[1] = t[i].y; d[2] = t[i].z; d[3] = t[i].w; }
    asm volatile("s_waitcnt lgkmcnt(0)" ::: "memory");
    const int c = lane & 7;
#pragma unroll
    for (int j = 0; j < 4; ++j) { const int n = (lane >> 3) + 8 * j; const LAS float* s = scr + (8 * c) * 33 + n;
        u32x4 o; o.x = pk2(s[0 * 33], s[1 * 33]); o.y = pk2(s[2 * 33], s[3 * 33]); o.z = pk2(s[4 * 33], s[5 * 33]); o.w = pk2(s[6 * 33], s[7 * 33]);
        *(u32x4*)(WT + (size_t)(n0 + n) * K + k0 + 8 * c) = o; }
    asm volatile("s_waitcnt lgkmcnt(0)" ::: "memory");
}
__device__ __forceinline__ void cvt_stream(const float* src, bf16* dst, size_t n, size_t gt, size_t ngt) {
    for (size_t i = gt * 8; i < n; i += ngt * 8) { const f32x4 a = *(const f32x4*)(src + i), b = *(const f32x4*)(src + i + 4);
        u32x4 o; o.x = pk2(a.x, a.y); o.y = pk2(a.z, a.w); o.z = pk2(b.x, b.y); o.w = pk2(b.z, b.w); *(u32x4*)(dst + i) = o; }
}
__device__ __forceinline__ void tab_row(Frame& F, int it, const f32x4 (&v)[4]) {
    const int tbl = it / (2 * NEXP), rr = it % (2 * NEXP);
    float ss = 0.f;
#pragma unroll
    for (int q = 0; q < 4; ++q) ss += (v[q].x * v[q].x + v[q].y * v[q].y) + (v[q].z * v[q].z + v[q].w * v[q].w);
    const float step = 0.3352f * sqrtf(wave_sum(ss) * (1.f / DM)), inv = step > 0.f ? 1.f / step : 0.f;
    unsigned nb[16];
#pragma unroll
    for (int q = 0; q < 4; ++q) {
        const int n0 = (int)floorf(v[q].x * inv), n1 = (int)floorf(v[q].y * inv), n2 = (int)floorf(v[q].z * inv), n3 = (int)floorf(v[q].w * inv);
        const int ob = tbl == 1 ? 8 : 0;
        nb[4 * q] = (unsigned)((n0 < -8 ? -8 : n0 > 7 ? 7 : n0) + ob) & 15u; nb[4 * q + 1] = (unsigned)((n1 < -8 ? -8 : n1 > 7 ? 7 : n1) + ob) & 15u; nb[4 * q + 2] = (unsigned)((n2 < -8 ? -8 : n2 > 7 ? 7 : n2) + ob) & 15u; nb[4 * q + 3] = (unsigned)((n3 < -8 ? -8 : n3 > 7 ? 7 : n3) + ob) & 15u; }
    u32x2 o2;
#pragma unroll
    for (int d = 0; d < 2; ++d) { unsigned w = 0;
#pragma unroll
        for (int jj = 0; jj < 4; ++jj) w |= (nb[8 * d + jj] | (nb[8 * d + 4 + jj] << 4)) << (8 * jj);
        o2[d] = w; }
    *(u32x2*)((tbl == 0 ? F_tabu : F_tabv) + (size_t)rr * (DM / 2) + 8 * F.lane) = o2;
    if (F.lane == 0) F_scl[(size_t)rr * 2 + tbl] = step;
}
struct TailSlots { int idle[3], total, rps; };
__device__ __forceinline__ TailSlots tail_slots(int G) {
    TailSlots t; const int nw[3] = {132 * (DIN / 256), 132 * (DM / 256), 132 * (DPQ / 256)}; t.total = 0;
#pragma unroll
    for (int k = 0; k < 3; ++k) { const int rem = nw[k] % G; t.idle[k] = (rem != 0 && nw[k] > G) ? G - rem : 0; t.total += t.idle[k]; }
    t.rps = t.total > 0 ? (((4 * NEXP + t.total - 1) / t.total + 7) / 8) * 8 : 0;
    return t;
}
__device__ __forceinline__ void tables_rows(Frame& F, int r0, int r1) {
    for (int base = r0 + F.wave * 6; base < r1; base += 48) {
        f32x4 v[6][4];
#pragma unroll
        for (int k = 0; k < 6; ++k) { const int it = base + k < r1 ? base + k : r1 - 1; const float* src = F.in[it < 2 * NEXP ? I_PU : I_PV] + (size_t)(it % (2 * NEXP)) * DM + 16 * F.lane;
#pragma unroll
            for (int q = 0; q < 4; ++q) v[k][q] = *(const f32x4*)(src + 4 * q); }
#pragma unroll
        for (int k = 0; k < 6; ++k) if (base + k < r1) tab_row(F, base + k, v[k]);
    }
}
__device__ __forceinline__ void tables_tail(Frame& F, int k) {
    const TailSlots t = tail_slots((int)gridDim.x);
    if (t.total == 0) { if (k == 0) for (int c = blockIdx.x; c < 4 * NEXP / 256; c += gridDim.x) tables_rows(F, c * 256, c * 256 + 256); return; }
    if (t.idle[k] == 0) return;
    const int first_idle = (int)gridDim.x - t.idle[k]; if ((int)blockIdx.x < first_idle) return;
    int s = (int)blockIdx.x - first_idle; for (int j = 0; j < k; ++j) s += t.idle[j];
    const int r0 = s * t.rps, r1 = r0 + t.rps < 4 * NEXP ? r0 + t.rps : 4 * NEXP;
    if (r0 < r1) tables_rows(F, r0, r1);
}
__device__ __forceinline__ void prep_phase(Frame& F) {
    if (F.wave < 3) {
        for (int item = blockIdx.x * 3 + F.wave; item < 768; item += gridDim.x * 3) {
            const int l = item / 384, rem = item % 384, cc = rem / 16, kc = rem % 16, col = cc * 256 + 4 * F.lane, k = kc * 64 + F.lane;
            float sv[5];
#pragma unroll
            for (int m = 0; m < 5; ++m) sv[m] = silu_f(m < 4 ? F.in[I_C][m * DM + k] : F.in[I_CCTX][k]);
            const float* w = F.in[I_ADAW] + ((size_t)l * DM + kc * 64) * MODW + col;
            f32x4 acc[5];
#pragma unroll
            for (int m = 0; m < 5; ++m) acc[m] = (f32x4){0.f, 0.f, 0.f, 0.f};
#pragma unroll 8
            for (int kk = 0; kk < 64; ++kk) { const f32x4 wv = *(const f32x4*)(w + (size_t)kk * MODW);
#pragma unroll
                for (int m = 0; m < 5; ++m) acc[m] += wv * __uint_as_float(__builtin_amdgcn_readlane(__float_as_uint(sv[m]), kk)); }
#pragma unroll
            for (int m = 0; m < 5; ++m) *(f32x4*)(F_part + ((size_t)(kc * 2 + l) * 5 + m) * MODW + col) = acc[m];
        }
    }
    for (int i = F.gtid; i < 4 * 64 * 64; i += F.ngt) { const int g = i >> 12, d = (i >> 6) & 63, c = i & 63; F_pwT[i] = (bf16)f2bf(F.in[I_EPW][(g * 64 + c) * 64 + d]); }
    LAS float* scr = (LAS float*)(F.lds + 32768 + F.wave * 12288);
    constexpr int I_IN = 16 * (DIN / 32), I_OUT = 16 * (DM / 32), I_Q = 16 * (DPQ / 32), I_L = I_IN + I_OUT + I_Q;
    for (int it = F.gw; it < 2 * I_L; it += F.ngw) {
        const int l = it / I_L; int r = it % I_L;
        if (r < I_IN) { transpose_item(l == 0 ? F.in[I_EWIN] : F.in[I_OWIN], DM, DIN, F_winT + (size_t)l * DIN * DM, scr, r, F.lane); continue; } r -= I_IN;
        if (r < I_OUT) { transpose_item(l == 0 ? F.in[I_EWOUT] : F.in[I_OWOUT], DM, DM, F_woutT + (size_t)l * DM * DM, scr, r, F.lane); continue; } r -= I_OUT;
        transpose_item(F.in[I_PWQ] + (size_t)l * DM * DPQ, DM, DPQ, F_wqT + (size_t)l * DPQ * DM, scr, r, F.lane);
    }
    for (int l = 0; l < 2; ++l) { cvt_stream(F.in[I_PK1] + l * 16384, F_keys + (l * 2 + 0) * 16384, 16384, F.gtid, F.ngt); cvt_stream(F.in[I_PK2] + l * 16384, F_keys + (l * 2 + 1) * 16384, 16384, F.gtid, F.ngt); }
}

__device__ __forceinline__ void fold_norm2(Frame& F) {
    for (int it = F.gw; it < 2 * DPQ; it += F.ngw) {
        const int l = it / DPQ, n = it % DPQ; const bf16* wr = F_wqT + ((size_t)l * DPQ + n) * DM; const float* gam = F.in[I_N2G] + l * DM;
        float wg[2][8], w[2][8];
#pragma unroll
        for (int q = 0; q < 2; ++q) { const int c = 8 * F.lane + 512 * q; const u32x4 ww = *(const u32x4*)(wr + c); const f32x4 g0 = *(const f32x4*)(gam + c), g1 = *(const f32x4*)(gam + c + 4);
            w[q][0] = bflo(ww.x); w[q][1] = bfhi(ww.x); w[q][2] = bflo(ww.y); w[q][3] = bfhi(ww.y); w[q][4] = bflo(ww.z); w[q][5] = bfhi(ww.z); w[q][6] = bflo(ww.w); w[q][7] = bfhi(ww.w);
#pragma unroll
            for (int k = 0; k < 4; ++k) { wg[q][k] = w[q][k] * g0[k]; wg[q][4 + k] = w[q][4 + k] * g1[k]; } }
#pragma unroll
        for (int m = 0; m < 5; ++m) { const float* sh = F_mod + ((size_t)l * 5 + m) * MODW + 3 * DM; const float* sc = sh + DM; float bs = 0.f;
#pragma unroll
            for (int q = 0; q < 2; ++q) { const int c = 8 * F.lane + 512 * q; const f32x4 s0a = *(const f32x4*)(sh + c), s0b = *(const f32x4*)(sh + c + 4), s1a = *(const f32x4*)(sc + c) + 1.f, s1b = *(const f32x4*)(sc + c + 4) + 1.f;
                u32x4 o; o.x = pk2(wg[q][0] * s1a[0], wg[q][1] * s1a[1]); o.y = pk2(wg[q][2] * s1a[2], wg[q][3] * s1a[3]); o.z = pk2(wg[q][4] * s1b[0], wg[q][5] * s1b[1]); o.w = pk2(wg[q][6] * s1b[2], wg[q][7] * s1b[3]);
                *(u32x4*)(F_wqb + (((size_t)l * 5 + m) * DPQ + n) * DM + c) = o;
#pragma unroll
                for (int k = 0; k < 4; ++k) bs += w[q][k] * s0a[k] + w[q][4 + k] * s0b[k]; }
            bs = wave_sum(bs);
            if (F.lane == 0) F_pqbias[((size_t)l * 5 + m) * DPQ + n] = bs; }
    }
    for (int i = F.gtid; i < 2 * 5 * (DM / 8); i += F.ngt) {
        const int lm = i / (DM / 8), c = (i % (DM / 8)) * 8, l = lm / 5; const float* gam = F.in[I_N2G] + l * DM + c; const float* sh = F_mod + (size_t)lm * MODW + 3 * DM + c; const float* sc = sh + DM;
        const f32x4 g0 = *(const f32x4*)gam, g1 = *(const f32x4*)(gam + 4), a0 = *(const f32x4*)sc + 1.f, a1 = *(const f32x4*)(sc + 4) + 1.f, h0 = *(const f32x4*)sh, h1 = *(const f32x4*)(sh + 4);
        u32x4 og, oh; og.x = pk2(g0[0] * a0[0], g0[1] * a0[1]); og.y = pk2(g0[2] * a0[2], g0[3] * a0[3]); og.z = pk2(g1[0] * a1[0], g1[1] * a1[1]); og.w = pk2(g1[2] * a1[2], g1[3] * a1[3]);
        oh.x = pk2(h0[0], h0[1]); oh.y = pk2(h0[2], h0[3]); oh.z = pk2(h1[0], h1[1]); oh.w = pk2(h1[2], h1[3]);
        *(u32x4*)(F_gbs + (size_t)lm * 2 * DM + c) = og; *(u32x4*)(F_gbs + (size_t)lm * 2 * DM + DM + c) = oh;
        { const float* gt = F_mod + (size_t)lm * MODW + 5 * DM + c; const f32x4 t0 = *(const f32x4*)gt, t1 = *(const f32x4*)(gt + 4);
          u32x4 o; o.x = pk2(t0[0], t0[1]); o.y = pk2(t0[2], t0[3]); o.z = pk2(t1[0], t1[1]); o.w = pk2(t1[2], t1[3]); *(u32x4*)(F_g2b + (size_t)lm * DM + c) = o; }
        if (l == 1) { const int m = lm - 5; const float* g1 = F.in[I_N1G] + DM + c; const float* s0 = F_mod + (size_t)lm * MODW + c; const float* s1 = s0 + DM;
          const f32x4 p0 = *(const f32x4*)g1 * (*(const f32x4*)s1 + 1.f), p1 = *(const f32x4*)(g1 + 4) * (*(const f32x4*)(s1 + 4) + 1.f), q0 = *(const f32x4*)s0, q1 = *(const f32x4*)(s0 + 4);
          u32x4 o; o.x = pk2(p0[0], p0[1]); o.y = pk2(p0[2], p0[3]); o.z = pk2(p1[0], p1[1]); o.w = pk2(p1[2], p1[3]); *(u32x4*)(F_n1b + (size_t)m * 2 * DM + c) = o;
          o.x = pk2(q0[0], q0[1]); o.y = pk2(q0[2], q0[3]); o.z = pk2(q1[0], q1[1]); o.w = pk2(q1[2], q1[3]); *(u32x4*)(F_n1b + (size_t)m * 2 * DM + DM + c) = o; } }
}

template <int WHICH> __device__ __forceinline__ void norm_phase(Frame& F, int layer, bool from_input, bool skip_ctx, bool finalize_mod) {
    const float* gam = F.in[WHICH == 0 ? I_N1G : I_N2G] + layer * DM;
    LAS float* lmod = (LAS float*)F.lds;
    if (finalize_mod) {
        for (int i = F.tid * 4; i < 5 * 2048; i += NTHR * 4) { const int m = i >> 11, c = i & 2047; f32x4 a = *(const f32x4*)(F.in[I_ADAB] + c);
#pragma unroll
            for (int kc = 0; kc < 16; ++kc) a += *(const f32x4*)(F_part + ((size_t)(kc * 2) * 5 + m) * MODW + c);
            *(LAS f32x4*)(lmod + i) = a; }
        for (int o = F.gtid * 4; o < 2 * 5 * MODW; o += F.ngt * 4) { const int l = o / (5 * MODW), rem = o % (5 * MODW); f32x4 a = *(const f32x4*)(F.in[I_ADAB] + l * MODW + rem % MODW);
#pragma unroll
            for (int kc = 0; kc < 16; ++kc) a += *(const f32x4*)(F_part + (size_t)(kc * 2 + l) * 5 * MODW + rem);
            *(f32x4*)(F_mod + o) = a; }
        __syncthreads();
    }
    f32x4 gin[2][2] = {};
    if (from_input) {
#pragma unroll
        for (int q = 0; q < 2; ++q)
#pragma unroll
            for (int h = 0; h < 2; ++h) gin[q][h] = *(const f32x4*)(gam + 8 * F.lane + 512 * q + 4 * h); }
    if (from_input && finalize_mod && !skip_ctx) {
        ticket_reset(F);
        int r = (int)blockIdx.x + ticket_next(F) * (int)gridDim.x; f32x4 v[2][2] = {};
        if (r < NR) { int b, j; row_info(r, b, j); const float* xr = in_row(F, b, j);
#pragma unroll
            for (int q = 0; q < 2; ++q)
#pragma unroll
                for (int h = 0; h < 2; ++h) v[q][h] = *(const f32x4*)(xr + 8 * F.lane + 512 * q + 4 * h); }
        while (r < NR) {
            const int rn = (int)blockIdx.x + ticket_next(F) * (int)gridDim.x; f32x4 vn[2][2] = {};
            if (rn < NR) { int bn, jn; row_info(rn, bn, jn); const float* xr = in_row(F, bn, jn);
#pragma unroll
                for (int q = 0; q < 2; ++q)
#pragma unroll
                    for (int h = 0; h < 2; ++h) vn[q][h] = *(const f32x4*)(xr + 8 * F.lane + 512 * q + 4 * h); }
            int b, j; row_info(r, b, j); const int mi = j < CTXL ? 4 : b; bf16* orow = F_xn + (size_t)r * DM; float ss = 0.f;
#pragma unroll
            for (int q = 0; q < 2; ++q)
#pragma unroll
                for (int h = 0; h < 2; ++h) ss += (v[q][h].x * v[q][h].x + v[q][h].y * v[q][h].y) + (v[q][h].z * v[q][h].z + v[q][h].w * v[q][h].w);
            const float rstd = rsqrtf(wave_sum(ss) * (1.f / DM) + EPS);
#pragma unroll
            for (int q = 0; q < 2; ++q) { u32x4 o;
#pragma unroll
                for (int h = 0; h < 2; ++h) { const int c = 8 * F.lane + 512 * q + 4 * h; const f32x4 s0 = *(const LAS f32x4*)(lmod + mi * 2048 + c), s1 = *(const LAS f32x4*)(lmod + mi * 2048 + DM + c);
                    const f32x4 y = (v[q][h] * rstd * gin[q][h]) * (s1 + 1.f) + s0; o[2 * h] = pk2(y.x, y.y); o[2 * h + 1] = pk2(y.z, y.w); }
                *(u32x4*)(orow + 8 * F.lane + 512 * q) = o; }
            r = rn;
#pragma unroll
            for (int q = 0; q < 2; ++q)
#pragma unroll
                for (int h = 0; h < 2; ++h) v[q][h] = vn[q][h];
        }
        return;
    }
    ticket_reset(F);
    for (;;) {
        const int r = (int)blockIdx.x + ticket_next(F) * (int)gridDim.x; if (r >= NR) break;
        int b, j; row_info(r, b, j); if (skip_ctx && j < CTXL) continue;
        const int mi = j < CTXL ? 4 : b;
        const float* sh = F_mod + ((size_t)layer * 5 + mi) * MODW + (WHICH ? 3 * DM : 0); const float* sc = sh + DM;
        bf16* orow = F_xn + (size_t)r * DM;
        if (from_input) {
            const float* xr = in_row(F, b, j);
            f32x4 v[2][2]; float ss = 0.f;
#pragma unroll
            for (int q = 0; q < 2; ++q)
#pragma unroll
                for (int h = 0; h < 2; ++h) { v[q][h] = *(const f32x4*)(xr + 8 * F.lane + 512 * q + 4 * h); ss += (v[q][h].x * v[q][h].x + v[q][h].y * v[q][h].y) + (v[q][h].z * v[q][h].z + v[q][h].w * v[q][h].w); }
            const float rstd = rsqrtf(wave_sum(ss) * (1.f / DM) + EPS);
#pragma unroll
            for (int q = 0; q < 2; ++q) { u32x4 o;
#pragma unroll
                for (int h = 0; h < 2; ++h) { const int c = 8 * F.lane + 512 * q + 4 * h; f32x4 s1, s0;
                    if (finalize_mod) { s0 = *(const LAS f32x4*)(lmod + mi * 2048 + c); s1 = *(const LAS f32x4*)(lmod + mi * 2048 + DM + c); }
                    else { s1 = *(const f32x4*)(sc + c); s0 = *(const f32x4*)(sh + c); }
                    const f32x4 y = (v[q][h] * rstd * gin[q][h]) * (s1 + 1.f) + s0; o[2 * h] = pk2(y.x, y.y); o[2 * h + 1] = pk2(y.z, y.w); }
                *(u32x4*)(orow + 8 * F.lane + 512 * q) = o; }
        } else {
            const bf16* xr = F_xs + (size_t)r * DM;
            float v[2][8]; float ss = 0.f;
#pragma unroll
            for (int q = 0; q < 2; ++q) { const u32x4 w = *(const u32x4*)(xr + 8 * F.lane + 512 * q);
                v[q][0] = bflo(w.x); v[q][1] = bfhi(w.x); v[q][2] = bflo(w.y); v[q][3] = bfhi(w.y); v[q][4] = bflo(w.z); v[q][5] = bfhi(w.z); v[q][6] = bflo(w.w); v[q][7] = bfhi(w.w);
#pragma unroll
                for (int k = 0; k < 8; ++k) ss += v[q][k] * v[q][k]; }
            const float rstd = rsqrtf(wave_sum(ss) * (1.f / DM) + EPS);
#pragma unroll
            for (int q = 0; q < 2; ++q) { const int c = 8 * F.lane + 512 * q; u32x4 o;
#pragma unroll
                for (int hh = 0; hh < 2; ++hh) { const f32x4 g = *(const f32x4*)(gam + c + 4 * hh), s1 = *(const f32x4*)(sc + c + 4 * hh), s0 = *(const f32x4*)(sh + c + 4 * hh);
                    const f32x4 x4 = (f32x4){v[q][4 * hh], v[q][4 * hh + 1], v[q][4 * hh + 2], v[q][4 * hh + 3]}; const f32x4 y = (x4 * rstd * g) * (s1 + 1.f) + s0;
                    o[2 * hh] = pk2(y.x, y.y); o[2 * hh + 1] = pk2(y.z, y.w); }
                *(u32x4*)(orow + c) = o; }
        }
    }
}

__device__ __forceinline__ void khead_finish(bf16* p, const float* g, int t) {
    float x[64];
#pragma unroll
    for (int c = 0; c < 8; ++c) { const u32x4 w = *(const u32x4*)(p + 8 * c); x[8 * c] = bflo(w.x); x[8 * c + 1] = bfhi(w.x); x[8 * c + 2] = bflo(w.y); x[8 * c + 3] = bfhi(w.y); x[8 * c + 4] = bflo(w.z); x[8 * c + 5] = bfhi(w.z); x[8 * c + 6] = bflo(w.w); x[8 * c + 7] = bfhi(w.w); }
    if (g) { float ss = 0.f;
#pragma unroll
        for (int c = 0; c < 64; ++c) ss += x[c] * x[c];
        const float rs = rsqrtf(ss * (1.f / 64.f) + EPS);
#pragma unroll
        for (int c = 0; c < 64; ++c) x[c] = x[c] * rs * g[c]; }
    if (t >= 0) { const float pr = (float)(t >> 6), pc = (float)(t & 63);
#pragma unroll
        for (int c = 0; c < 16; ++c) {
            const float inv = exp2f(-(float)c * (13.287712379549449f / 16.f)) * 0.15915494309189535f;
            float rr = pr * inv, rc = pc * inv; rr -= floorf(rr); rc -= floorf(rc);
            const float sr = __builtin_amdgcn_sinf(rr), cr = __builtin_amdgcn_cosf(rr), sc_ = __builtin_amdgcn_sinf(rc), cc = __builtin_amdgcn_cosf(rc);
            const float a1 = x[c], a2 = x[16 + c]; x[c] = a1 * cr - a2 * sr; x[16 + c] = a1 * sr + a2 * cr;
            const float b1 = x[32 + c], b2 = x[48 + c]; x[32 + c] = b1 * cc - b2 * sc_; x[48 + c] = b1 * sc_ + b2 * cc; } }
#pragma unroll
    for (int c = 0; c < 8; ++c) { u32x4 w; w.x = pk2(x[8 * c], x[8 * c + 1]); w.y = pk2(x[8 * c + 2], x[8 * c + 3]); w.z = pk2(x[8 * c + 4], x[8 * c + 5]); w.w = pk2(x[8 * c + 6], x[8 * c + 7]); *(u32x4*)(p + 8 * c) = w; }
}
namespace pg8 {
#define PG8_LAS __attribute__((address_space(3)))
typedef unsigned short bf16_t;
constexpr int BM = 256, BK = 64, HALF = 128, HTB = HALF * BK * 2, STAGE_BYTES = 8 * HTB, NXCD = 8, WGM = 8;
__host__ __device__ __forceinline__ int lds_byte(int r, int c) { const int st = (r >> 4) * 2 + (c >> 5), rr = r & 15, cc = c & 31, ob = rr * 64 + cc * 2; return st * 1024 + (ob ^ (((ob >> 9) & 1) << 5)); }
__host__ __device__ __forceinline__ void stage_rc(int b, int& R, int& C) { const int st = b / 1024, sb = b % 1024, swz = sb ^ (((sb >> 9) & 1) << 5); R = (st >> 1) * 16 + swz / 64; C = (st & 1) * 32 + (swz % 64) / 2; }
__host__ __device__ __forceinline__ int perm32(int rho) { const int n = rho >> 4, i = rho & 15; return 8 * (i >> 2) + 4 * n + (i & 3); }
struct Unit { int pm, pn; };
struct Gemm { const bf16_t* A; const bf16_t* Bt; int M, N, K; size_t bstride; };
__device__ __forceinline__ size_t bvar(const Gemm& g, int pm) { return g.bstride ? (size_t)(pm % 33 == 0 ? 4 : pm / 33) * g.bstride : (size_t)0; }
struct Order {
    int nM, nN, nwg, G, c, skip; bf16_t* kfix; const float* kg;
    __device__ void init(int nM_, int N, int G_, int c_, int skip_) { nM = nM_; nN = N / BM; nwg = nM * nN; G = G_; c = c_; skip = skip_; kfix = nullptr; kg = nullptr; }
    __device__ bool next(int i, Unit& u) const {
        const long L = (long)i * G + c; if (L >= nwg) return false;
        int wgid = (int)L; { const int q = nwg / NXCD, r = nwg % NXCD, xcd = wgid % NXCD, off = wgid / NXCD; wgid = (xcd < r ? xcd * (q + 1) : r * (q + 1) + (xcd - r) * q) + off; }
        const int nig = WGM * nN, gid = wgid / nig, fm = gid * WGM, gsz = (nM - fm) < WGM ? (nM - fm) : WGM;
        u.pm = fm + ((wgid % nig) % gsz); u.pn = (wgid % nig) / gsz;
        if (skip) u.pm += u.pm / 32 + 1;
        return true;
    }
    __device__ __forceinline__ void a_ready(const Unit&) const {}
    __device__ __forceinline__ void done(const Unit& u) const {
        if (kfix == nullptr || u.pn != 4) return;
        asm volatile("s_waitcnt vmcnt(0)" ::: "memory"); __builtin_amdgcn_s_barrier(); asm volatile("" ::: "memory");
        const int jt = u.pm % 33;
#pragma unroll 1
        for (int it = threadIdx.x; it < 1024; it += 512) { const int rl = it >> 2, hh = it & 3; khead_finish(kfix + (size_t)(u.pm * BM + rl) * DIN + 1024 + hh * 64, kg, jt == 0 ? -1 : (jt - 1) * 256 + rl); }
    }
};
__device__ __forceinline__ unsigned cvt_pk_bf16(float lo, float hi) { unsigned r; asm volatile("v_cvt_pk_bf16_f32 %0, %1, %2" : "=v"(r) : "v"(lo), "v"(hi)); return r; }
__device__ __forceinline__ void line_pair(const u32x4& w0, const u32x4& w1, u32x4& lo8, u32x4& hi8) {
#pragma unroll
    for (int k = 0; k < 4; ++k) { lo8[k] = (unsigned)__builtin_amdgcn_update_dpp((int)w0[k], (int)w1[k], 0x128, 0xf, 0xc, false);
                                  hi8[k] = (unsigned)__builtin_amdgcn_update_dpp((int)w1[k], (int)w0[k], 0x128, 0xf, 0x3, false); }
}
struct EpiBf16 {
    static constexpr bool PERM = true, AFTER_DRAIN = false;
    bf16_t* O; int ldc;
    __device__ __forceinline__ void operator()(const f32x4 (&acc)[2][2][4][2], const Unit& u, int wr, int wc, int fr, int fq) const {
        const int rowA = u.pm * BM + wr * 64 + (fr & 7), colx = u.pn * BM + wc * 64 + 32 * (fr >> 3) + 8 * fq;
#pragma unroll
        for (int ai = 0; ai < 2; ++ai)
#pragma unroll
            for (int m = 0; m < 4; ++m) { u32x4 w[2];
#pragma unroll
                for (int bj = 0; bj < 2; ++bj) { const f32x4 v0 = acc[ai][bj][m][0], v1 = acc[ai][bj][m][1];
                    w[bj].x = cvt_pk_bf16(v0[0], v0[1]); w[bj].y = cvt_pk_bf16(v0[2], v0[3]); w[bj].z = cvt_pk_bf16(v1[0], v1[1]); w[bj].w = cvt_pk_bf16(v1[2], v1[3]); }
                u32x4 lo8, hi8; line_pair(w[0], w[1], lo8, hi8);
                bf16_t* rowp = O + (size_t)(rowA + ai * HALF + m * 16) * ldc + colx;
                *(u32x4*)rowp = lo8; *(u32x4*)(rowp + (size_t)8 * ldc) = hi8; }
    }
};
template <bool FROM_INPUT> struct EpiResid16T {
    static constexpr bool PERM = true, AFTER_DRAIN = false;
    const float* x_in; const float* ctx_in; bf16_t* xs; const float* gate; float* ssp;
    __device__ __forceinline__ void operator()(const f32x4 (&acc)[2][2][4][2], const Unit& u, int wr, int wc, int fr, int fq) const {
        const int b = u.pm / 33, jt = u.pm - b * 33; const bool isc = jt == 0;
        const float* g = gate + (size_t)(isc ? 4 : b) * MODW; const int col0 = u.pn * BM + wc * 64 + 8 * fq;
        const float* srcb = isc ? ctx_in + (size_t)b * CTXL * DM : x_in + ((size_t)b * SEQ + (size_t)(jt - 1) * 256) * DM;
        f32x4 gv[2][2];
#pragma unroll
        for (int bj = 0; bj < 2; ++bj)
#pragma unroll
            for (int n = 0; n < 2; ++n) gv[bj][n] = *(const f32x4*)(g + col0 + bj * 32 + 4 * n);
        constexpr int RD = 3;
        f32x4 nf[RD][2][2]; u32x4 nw[RD][2];
#define RESID_LOAD(blk) RESID_LOAD_DYN(blk)
#define RESID_LOAD_DYN(blk) do { const int _s = (blk) % RD; const int _rl = ((blk) >> 2) * HALF + wr * 64 + ((blk) & 3) * 16 + fr; \
            if (FROM_INPUT) { const float* _sp = srcb + (size_t)_rl * DM + col0; nf[_s][0][0] = *(const f32x4*)_sp; nf[_s][0][1] = *(const f32x4*)(_sp + 4); nf[_s][1][0] = *(const f32x4*)(_sp + 32); nf[_s][1][1] = *(const f32x4*)(_sp + 36); } \
            else { const bf16_t* _xp = xs + ((size_t)u.pm * BM + _rl) * DM + col0; nw[_s][0] = *(const u32x4*)_xp; nw[_s][1] = *(const u32x4*)(_xp + 32); } } while (0)
        RESID_LOAD(0); RESID_LOAD(1); RESID_LOAD(2);
#pragma unroll
        for (int blk = 0; blk < 8; ++blk) { const int ai = blk >> 2, m = blk & 3; float ssq = 0.f; u32x4 ow[2];
            f32x4 cf[2][2]; u32x4 cw[2];
#pragma unroll
            for (int bj = 0; bj < 2; ++bj) { cf[bj][0] = nf[blk % RD][bj][0]; cf[bj][1] = nf[blk % RD][bj][1]; cw[bj] = nw[blk % RD][bj]; }
            if (blk + RD < 8) RESID_LOAD_DYN(blk + RD);
#pragma unroll
            for (int bj = 0; bj < 2; ++bj) { f32x4 b0, b1;
                if (FROM_INPUT) { b0 = cf[bj][0]; b1 = cf[bj][1]; }
                else { const u32x4 w = cw[bj]; b0 = (f32x4){__uint_as_float(w.x << 16), __uint_as_float(w.x & 0xffff0000u), __uint_as_float(w.y << 16), __uint_as_float(w.y & 0xffff0000u)};
                    b1 = (f32x4){__uint_as_float(w.z << 16), __uint_as_float(w.z & 0xffff0000u), __uint_as_float(w.w << 16), __uint_as_float(w.w & 0xffff0000u)}; }
                const f32x4 v0 = b0 + gv[bj][0] * acc[ai][bj][m][0], v1 = b1 + gv[bj][1] * acc[ai][bj][m][1];
                u32x4 o; o.x = cvt_pk_bf16(v0[0], v0[1]); o.y = cvt_pk_bf16(v0[2], v0[3]); o.z = cvt_pk_bf16(v1[0], v1[1]); o.w = cvt_pk_bf16(v1[2], v1[3]);
                ow[bj] = o;
                const f32x4 r0 = (f32x4){__uint_as_float(o.x << 16), __uint_as_float(o.x & 0xffff0000u), __uint_as_float(o.y << 16), __uint_as_float(o.y & 0xffff0000u)}, r1 = (f32x4){__uint_as_float(o.z << 16), __uint_as_float(o.z & 0xffff0000u), __uint_as_float(o.w << 16), __uint_as_float(o.w & 0xffff0000u)};
                ssq += ((r0[0] * r0[0] + r0[1] * r0[1]) + (r0[2] * r0[2] + r0[3] * r0[3])) + ((r1[0] * r1[0] + r1[1] * r1[1]) + (r1[2] * r1[2] + r1[3] * r1[3])); }
            { u32x4 lo8, hi8; line_pair(ow[0], ow[1], lo8, hi8);
              bf16_t* sp8 = xs + ((size_t)u.pm * BM + ai * HALF + wr * 64 + m * 16 + (fr & 7)) * DM + col0 + 32 * (fr >> 3); *(u32x4*)sp8 = lo8; *(u32x4*)(sp8 + (size_t)8 * DM) = hi8; }
            ssq = xrow_sum(ssq);
            if (fq == 0) *(float*)((char*)ssp + ((unsigned)(((u.pm * BM + wr * 64 + fr) * 16 + 4 * u.pn + wc) * 4) + (unsigned)((ai * HALF + m * 16) * 64))) = ssq; }
#undef RESID_LOAD
#undef RESID_LOAD_DYN
    }
};
struct EpiPQ {
    static constexpr bool PERM = true, AFTER_DRAIN = false;
    bf16_t* O; int ldc; const float* ssp; const float* bias; PG8_LAS float* rl;
    __device__ __forceinline__ void operator()(const f32x4 (&acc)[2][2][4][2], const Unit& u, int wr, int wc, int fr, int fq) const {
        const int b = u.pm / 33, jt = u.pm - b * 33; const float* bb = bias + (size_t)(jt == 0 ? 4 : b) * 2048 + u.pn * BM + wc * 64 + 8 * fq;
        const int tid = threadIdx.x;
        if (tid < BM) { const float* sp = ssp + ((size_t)u.pm * BM + tid) * 16;
            const f32x4 s0 = *(const f32x4*)sp, s1 = *(const f32x4*)(sp + 4), s2 = *(const f32x4*)(sp + 8), s3 = *(const f32x4*)(sp + 12);
            const float ss = (((s0[0] + s0[1]) + (s0[2] + s0[3])) + ((s1[0] + s1[1]) + (s1[2] + s1[3]))) + (((s2[0] + s2[1]) + (s2[2] + s2[3])) + ((s3[0] + s3[1]) + (s3[2] + s3[3])));
            rl[tid] = rsqrtf(ss * (1.f / DM) + EPS); }
        f32x4 bv[2][2];
#pragma unroll
        for (int bj = 0; bj < 2; ++bj) { bv[bj][0] = *(const f32x4*)(bb + bj * 32); bv[bj][1] = *(const f32x4*)(bb + bj * 32 + 4); }
        asm volatile("s_waitcnt lgkmcnt(0)" ::: "memory"); __builtin_amdgcn_s_barrier(); asm volatile("" ::: "memory");
        const int rowA = u.pm * BM + wr * 64 + (fr & 7), colx = u.pn * BM + wc * 64 + 32 * (fr >> 3) + 8 * fq;
#pragma unroll
        for (int ai = 0; ai < 2; ++ai)
#pragma unroll
            for (int m = 0; m < 4; ++m) { const int rloc = wr * 64 + fr + ai * HALF + m * 16; const float rstd = rl[rloc]; bf16_t* rowp = O + (size_t)(rowA + ai * HALF + m * 16) * ldc + colx; u32x4 ww[2];
#pragma unroll
                for (int bj = 0; bj < 2; ++bj) { const f32x4 v0 = acc[ai][bj][m][0] * rstd + bv[bj][0], v1 = acc[ai][bj][m][1] * rstd + bv[bj][1];
                    u32x4 w; w.x = cvt_pk_bf16(v0[0], v0[1]); w.y = cvt_pk_bf16(v0[2], v0[3]); w.z = cvt_pk_bf16(v1[0], v1[1]); w.w = cvt_pk_bf16(v1[2], v1[3]);
                    ww[bj] = w; }
                u32x4 lo8, hi8; line_pair(ww[0], ww[1], lo8, hi8); *(u32x4*)rowp = lo8; *(u32x4*)(rowp + (size_t)8 * ldc) = hi8; }
    }
};
template <class Epi, class Sched, bool ALIGN_EPI = false, bool SP2 = false>
__device__ __forceinline__ void gemm_phase(PG8_LAS unsigned char* lds, const Gemm g, const Sched& S, const Epi& E) {
    const int tid = threadIdx.x, wid = __builtin_amdgcn_readfirstlane(tid >> 6), lane = tid & 63, wr = wid >> 2, wc = wid & 3, fr = lane & 15, fq = lane >> 4;
    const int K = g.K, nt = K / BK;
    unsigned voffA[2], voffB[2];
#pragma unroll
    for (int i = 0; i < 2; ++i) { int R, C; stage_rc(tid * 16 + i * 8192, R, C); const int Rb = Epi::PERM ? (64 * (R >> 5) + perm32(R & 31)) : R;
        voffA[i] = (unsigned)(R * K + C) * 2u; voffB[i] = (unsigned)(Rb * K + C) * 2u; }
    const size_t kstep = (size_t)(BK * 2);
    const size_t hstep = (size_t)HALF * K * 2;
    const size_t tstep = 2 * hstep;
    const size_t hstepB = Epi::PERM ? (size_t)32 * K * 2 : hstep;
    const unsigned ldsw = (unsigned)wid * 1024u;
    const int aoff = lds_byte(wr * 64 + fr, fq * 8), boff = lds_byte(wc * 32 + fr, fq * 8);
#define PG8_SA(b, h) (((b) * 2 + (h)) * HTB)
#define PG8_SB(b, h) ((4 + (b) * 2 + (h)) * HTB)
#define PG8_STAGE(bufoff, gbase, voff) do { _Pragma("unroll") for (int _i = 0; _i < 2; ++_i) \
        __builtin_amdgcn_global_load_lds((const unsigned*)((const char*)(gbase) + (voff)[_i]), (PG8_LAS unsigned*)(lds + (bufoff) + ldsw + _i * 8192), 16, 0, 0); } while (0)
#define PG8_LDA(dst, b, h) do { _Pragma("unroll") for (int m = 0; m < 4; ++m) _Pragma("unroll") for (int k = 0; k < 2; ++k) dst[m][k] = *(const PG8_LAS bf16x8*)(lds + PG8_SA(b, h) + aoff + m * 2048 + k * 1024); } while (0)
#define PG8_LDB(dst, b, h) do { _Pragma("unroll") for (int n = 0; n < 2; ++n) _Pragma("unroll") for (int k = 0; k < 2; ++k) dst[n][k] = *(const PG8_LAS bf16x8*)(lds + PG8_SB(b, h) + boff + n * 2048 + k * 1024); } while (0)
#define PG8_MMA(ai, bj, At, Bt) do { __builtin_amdgcn_s_setprio(1); _Pragma("unroll") for (int m = 0; m < 4; ++m) _Pragma("unroll") for (int n = 0; n < 2; ++n) _Pragma("unroll") for (int k = 0; k < 2; ++k) \
        acc[ai][bj][m][n] = __builtin_amdgcn_mfma_f32_16x16x32_bf16(Bt[n][k], At[m][k], acc[ai][bj][m][n], 0, 0, 0); __builtin_amdgcn_s_setprio(0); } while (0)
#define PG8_WAIT_V(n) asm volatile("s_waitcnt vmcnt(" #n ")" ::: "memory")
#define PG8_WAIT_L(n) asm volatile("s_waitcnt lgkmcnt(" #n ")" ::: "memory")
#define PG8_BAR __builtin_amdgcn_s_barrier()
#define PG8_SCHED __builtin_amdgcn_sched_barrier(0)
    Unit cur, nxt; int ui = 0;
    if (!S.next(0, cur)) return;
    f32x4 acc[2][2][4][2];
#pragma unroll
    for (int a = 0; a < 2; ++a)
#pragma unroll
        for (int b = 0; b < 2; ++b)
#pragma unroll
            for (int m = 0; m < 4; ++m)
#pragma unroll
                for (int n = 0; n < 2; ++n) acc[a][b][m][n] = (f32x4){0.f, 0.f, 0.f, 0.f};
    bf16x8 At[4][2], B0[2][2], B1[2][2];
    const char* cA = (const char*)g.A + (size_t)cur.pm * tstep; const char* cB = (const char*)g.Bt + (size_t)cur.pn * tstep + bvar(g, cur.pm);
    S.a_ready(cur);
    if constexpr (SP2) {
        PG8_STAGE(PG8_SB(0, 0), cB, voffB); PG8_STAGE(PG8_SB(0, 1), cB + hstepB, voffB); PG8_STAGE(PG8_SA(0, 0), cA, voffA); PG8_STAGE(PG8_SA(0, 1), cA + hstep, voffA);
        if (wr == 1) PG8_BAR;
        PG8_WAIT_V(2); PG8_BAR;
        PG8_STAGE(PG8_SB(1, 0), cB + kstep, voffB); PG8_STAGE(PG8_SA(1, 0), cA + kstep, voffA); PG8_STAGE(PG8_SB(1, 1), cB + hstepB + kstep, voffB);
        PG8_WAIT_V(6); PG8_BAR;
    } else {
        PG8_STAGE(PG8_SB(0, 0), cB, voffB); PG8_STAGE(PG8_SA(0, 0), cA, voffA); PG8_STAGE(PG8_SB(0, 1), cB + hstepB, voffB); PG8_STAGE(PG8_SA(0, 1), cA + hstep, voffA);
        if (wr == 1) PG8_BAR;
        PG8_WAIT_V(4); PG8_BAR;
        PG8_STAGE(PG8_SB(1, 0), cB + kstep, voffB); PG8_STAGE(PG8_SA(1, 0), cA + kstep, voffA); PG8_STAGE(PG8_SB(1, 1), cB + hstepB + kstep, voffB);
        PG8_WAIT_V(6); PG8_BAR;
    }
    for (;;) {
        const bool has_next = S.next(ui + 1, nxt);
        const char* nA = has_next ? (const char*)g.A + (size_t)nxt.pm * tstep : cA; const char* nB = has_next ? (const char*)g.Bt + (size_t)nxt.pn * tstep + bvar(g, nxt.pm) : cB;
        for (int t = 0; t < nt; t += 2) {
            const bool last = (t == nt - 2);
            const char* a1 = cA + (size_t)(t + 1) * kstep;
            const char* a2 = last ? nA : cA + (size_t)(t + 2) * kstep; const char* b2 = last ? nB : cB + (size_t)(t + 2) * kstep;
            const char* a3 = a2 + kstep; const char* b3 = b2 + kstep;
            if (last && has_next) S.a_ready(nxt);
            if constexpr (SP2) {
            PG8_LDB(B0, 0, 0); PG8_LDB(B1, 0, 1); PG8_SCHED; PG8_LDA(At, 0, 0); PG8_STAGE(PG8_SA(1, 1), a1 + hstep, voffA);
            PG8_WAIT_V(8); PG8_WAIT_L(0); PG8_BAR; PG8_MMA(0, 0, At, B0); PG8_MMA(0, 1, At, B1); PG8_BAR; PG8_SCHED;
            PG8_LDA(At, 0, 1); PG8_STAGE(PG8_SB(0, 0), b2, voffB); PG8_STAGE(PG8_SB(0, 1), b2 + hstepB, voffB); PG8_STAGE(PG8_SA(0, 0), a2, voffA);
            PG8_WAIT_V(8); PG8_WAIT_L(0); PG8_BAR; PG8_MMA(1, 0, At, B0); PG8_MMA(1, 1, At, B1); PG8_BAR; PG8_SCHED;
            PG8_LDB(B0, 1, 0); PG8_LDB(B1, 1, 1); PG8_SCHED; PG8_LDA(At, 1, 0); PG8_STAGE(PG8_SA(0, 1), a2 + hstep, voffA);
            PG8_WAIT_V(8); PG8_WAIT_L(0); PG8_BAR; PG8_MMA(0, 0, At, B0); PG8_MMA(0, 1, At, B1); PG8_BAR; PG8_SCHED;
            PG8_LDA(At, 1, 1); PG8_STAGE(PG8_SB(1, 0), b3, voffB); PG8_STAGE(PG8_SB(1, 1), b3 + hstepB, voffB); PG8_STAGE(PG8_SA(1, 0), a3, voffA);
            PG8_WAIT_V(8); PG8_WAIT_L(0); PG8_BAR; PG8_MMA(1, 0, At, B0); PG8_MMA(1, 1, At, B1); PG8_BAR; PG8_SCHED;
            } else {
            PG8_LDB(B0, 0, 0); PG8_SCHED; PG8_LDA(At, 0, 0); PG8_STAGE(PG8_SA(1, 1), a1 + hstep, voffA);
            PG8_WAIT_L(8); PG8_BAR; PG8_WAIT_L(0); PG8_MMA(0, 0, At, B0); PG8_BAR; PG8_SCHED;
            PG8_LDB(B1, 0, 1); PG8_STAGE(PG8_SB(0, 0), b2, voffB);
            PG8_BAR; PG8_WAIT_L(0); PG8_MMA(0, 1, At, B1); PG8_BAR;
            PG8_LDA(At, 0, 1); PG8_STAGE(PG8_SA(0, 0), a2, voffA);
            PG8_BAR; PG8_WAIT_L(0); PG8_MMA(1, 0, At, B0); PG8_BAR; PG8_SCHED;
            PG8_STAGE(PG8_SB(0, 1), b2 + hstepB, voffB);
            PG8_WAIT_V(6); PG8_BAR; PG8_MMA(1, 1, At, B1); PG8_BAR;
            PG8_LDB(B0, 1, 0); PG8_SCHED; PG8_LDA(At, 1, 0); PG8_STAGE(PG8_SA(0, 1), a2 + hstep, voffA);
            PG8_WAIT_L(8); PG8_BAR; PG8_WAIT_L(0); PG8_MMA(0, 0, At, B0); PG8_BAR; PG8_SCHED;
            PG8_LDB(B1, 1, 1); PG8_STAGE(PG8_SB(1, 0), b3, voffB);
            PG8_BAR; PG8_WAIT_L(0); PG8_MMA(0, 1, At, B1); PG8_BAR;
            PG8_LDA(At, 1, 1); PG8_STAGE(PG8_SA(1, 0), a3, voffA);
            PG8_BAR; PG8_WAIT_L(0); PG8_MMA(1, 0, At, B0); PG8_BAR; PG8_SCHED;
            PG8_STAGE(PG8_SB(1, 1), b3 + hstepB, voffB);
            PG8_WAIT_V(6); PG8_BAR; PG8_MMA(1, 1, At, B1); PG8_BAR;
            }
        }
        if constexpr (ALIGN_EPI) { if (wr == 0) PG8_BAR; }
        if constexpr (!Epi::AFTER_DRAIN) { E(acc, cur, wr, wc, fr, fq); S.done(cur); }
        if (!has_next) break;
#pragma unroll
        for (int a = 0; a < 2; ++a)
#pragma unroll
            for (int b = 0; b < 2; ++b)
#pragma unroll
                for (int m = 0; m < 4; ++m)
#pragma unroll
                    for (int n = 0; n < 2; ++n) acc[a][b][m][n] = (f32x4){0.f, 0.f, 0.f, 0.f};
        cur = nxt; cA = nA; cB = nB; ++ui;
        if constexpr (ALIGN_EPI) { if (wr == 1) PG8_BAR; }
    }
    PG8_WAIT_V(0);
    if constexpr (!ALIGN_EPI) { if (wr == 0) PG8_BAR; }
    PG8_BAR;
    if constexpr (Epi::AFTER_DRAIN) { E.fused(acc, cur, wr, wc, fr, fq, lds, wid, lane); S.done(cur); }
#undef PG8_SA
#undef PG8_SB
#undef PG8_STAGE
#undef PG8_LDA
#undef PG8_LDB
#undef PG8_MMA
#undef PG8_WAIT_V
#undef PG8_WAIT_L
#undef PG8_BAR
#undef PG8_SCHED
}
}

#include <hip/hip_bf16.h>
#include <cmath>
namespace attn_body {
using bf16=__hip_bfloat16;
using bf16x8=__attribute__((ext_vector_type(8)))short;
using s16x4=__attribute__((ext_vector_type(4)))short;
using f32x16=__attribute__((ext_vector_type(16)))float;
using u32x4=__attribute__((ext_vector_type(4)))unsigned;
constexpr int D=64,PQKV=1536,PO=1024;
constexpr int NW=8,QBLK=32,QB=QBLK*NW,KVBLK=64;
__device__ __forceinline__ int crow(int r,int hi){return (r&3)+8*(r>>2)+4*hi;}
#define SBAR() __builtin_amdgcn_sched_barrier(0)
__device__ __forceinline__ void wmask(f32x16&p0,f32x16&p1,int dq,int hi){
  const float NEG=-INFINITY; const int d0=dq+4*hi;
  #pragma unroll
  for(int r=0;r<16;++r){const int d=d0+(r&3)+8*(r>>2); if(d>128||d<-128)p0[r]=NEG; if(d+32>128||d+32<-128)p1[r]=NEG;}
}

constexpr int NSLOT=3, SLOTB=8192;
constexpr int LDS_K=0, LDS_V=NSLOT*SLOTB, LDS_WS=2*NSLOT*SLOTB, LDS_OST=LDS_WS+NW*64*4, LDS_BYTES=LDS_OST+NW*4096;
constexpr float C2=0.125f*1.4426950408889634f;
__device__ __forceinline__ void glds16(const void*gsrc,unsigned lds_dst){unsigned keep;
  asm volatile("s_mov_b32 %0, m0\n\ts_mov_b32 m0, %2\n\ts_nop 0\n\tglobal_load_lds_dwordx4 %1, off\n\ts_mov_b32 m0, %0":"=&s"(keep):"v"(gsrc),"s"(lds_dst):"memory");}
__device__ __forceinline__ float max3f(float a,float b,float c){float r;asm("v_max3_f32 %0, %1, %2, %3":"=v"(r):"v"(a),"v"(b),"v"(c));return r;}
__device__ __forceinline__ float max2f(float a,float b){float r;asm("v_max_f32_e32 %0, %1, %2":"=v"(r):"v"(a),"v"(b));return r;}
__device__ __forceinline__ float fadd_s(float a,float b){float r;asm("v_add_f32_e32 %0, %1, %2":"=v"(r):"v"(a),"v"(b));return r;}
__device__ __forceinline__ float fsub_s(float a,float b){float r;asm("v_sub_f32_e32 %0, %1, %2":"=v"(r):"v"(a),"v"(b));return r;}
typedef float f32x2_t __attribute__((ext_vector_type(2))); typedef __bf16 bf16x2_t __attribute__((ext_vector_type(2)));
__device__ __forceinline__ unsigned cvtpk_s(float lo,float hi){f32x2_t v={lo,hi};bf16x2_t b=__builtin_convertvector(v,bf16x2_t);return __builtin_bit_cast(unsigned,b);}
#define WAIT_BAR(N) asm volatile("s_waitcnt vmcnt(" #N ") lgkmcnt(0)\n\ts_barrier":::"memory")

__device__ __forceinline__ void qkt(f32x16&p0,f32x16&p1,const char*Kslot,const bf16x8*qr,const f32x16&negm,int r32,int hi){
  const char*kb=Kslot+r32*128; const int sw=r32&7;
  #pragma unroll
  for(int d0=0;d0<4;++d0){
    const int off=((2*d0+hi)^sw)<<4;
    const bf16x8 b0=*reinterpret_cast<const bf16x8*>(kb+off);
    const bf16x8 b1=*reinterpret_cast<const bf16x8*>(kb+off+4096);
    if(d0==0){p0=__builtin_amdgcn_mfma_f32_32x32x16_bf16(b0,qr[0],negm,0,0,0);p1=__builtin_amdgcn_mfma_f32_32x32x16_bf16(b1,qr[0],negm,0,0,0);}
    else{p0=__builtin_amdgcn_mfma_f32_32x32x16_bf16(b0,qr[d0],p0,0,0,0);p1=__builtin_amdgcn_mfma_f32_32x32x16_bf16(b1,qr[d0],p1,0,0,0);}}
}
typedef __attribute__((address_space(3))) const char* lds_cptr;
typedef short v4i16_t __attribute__((ext_vector_type(4)));
__device__ __forceinline__ void kload2(bf16x8*kf,lds_cptr kp,const int*koff,int j){ kf[2*j]=*(const __attribute__((address_space(3))) bf16x8*)(kp+koff[j]); kf[2*j+1]=*(const __attribute__((address_space(3))) bf16x8*)(kp+koff[j]+4096); }
__device__ __forceinline__ void kload8(bf16x8*kf,lds_cptr kp,const int*koff){ kload2(kf,kp,koff,0); kload2(kf,kp,koff,1); kload2(kf,kp,koff,2); kload2(kf,kp,koff,3); }
__device__ __forceinline__ s16x4 vtr(lds_cptr p){ return __builtin_bit_cast(s16x4,__builtin_amdgcn_ds_read_tr16_b64_v4i16((__attribute__((address_space(3))) v4i16_t*)p)); }
__device__ __forceinline__ float rowmax(const f32x16&p0,const f32x16&p1){
  float a=max3f(p0[0],p0[1],p1[0]),b=max3f(p0[2],p0[3],p1[1]);a=max3f(a,p1[2],p1[3]);
  #pragma unroll
  for(int r=4;r<16;r+=4){a=max3f(a,p0[r],p0[r+1]);b=max3f(b,p0[r+2],p0[r+3]);a=max3f(a,p1[r],p1[r+1]);b=max3f(b,p1[r+2],p1[r+3]);}
  const float m=max2f(a,b);
  auto rr=__builtin_amdgcn_permlane32_swap(__float_as_uint(m),__float_as_uint(m),false,false);
  return max2f(__uint_as_float(rr[0]),__uint_as_float(rr[1]));
}
__device__ __forceinline__ void pv(f32x16*o,int vbA,int vbB,bf16x8 pa0,bf16x8 pa1,bf16x8 pa2,bf16x8 pa3){
  #pragma unroll
  for(int d0=0;d0<2;++d0){s16x4 lo[4],hi[4]; const int vb=d0?vbB:vbA;
    #pragma unroll
    for(int ks=0;ks<4;++ks){
      asm volatile("ds_read_b64_tr_b16 %0,%1 offset:%c2":"=&v"(lo[ks]):"v"(vb),"i"(ks*2048):"memory");
      asm volatile("ds_read_b64_tr_b16 %0,%1 offset:%c2":"=&v"(hi[ks]):"v"(vb),"i"(ks*2048+1024):"memory");}
    asm volatile("s_waitcnt lgkmcnt(0)":::"memory");SBAR();
    #define PK(k) (bf16x8){lo[k][0],lo[k][1],lo[k][2],lo[k][3],hi[k][0],hi[k][1],hi[k][2],hi[k][3]}
    o[d0]=__builtin_amdgcn_mfma_f32_32x32x16_bf16(pa0,PK(0),o[d0],0,0,0);
    o[d0]=__builtin_amdgcn_mfma_f32_32x32x16_bf16(pa1,PK(1),o[d0],0,0,0);
    o[d0]=__builtin_amdgcn_mfma_f32_32x32x16_bf16(pa2,PK(2),o[d0],0,0,0);
    o[d0]=__builtin_amdgcn_mfma_f32_32x32x16_bf16(pa3,PK(3),o[d0],0,0,0);
    #undef PK
  }
}

#ifndef ATTN_STORE16
#define ATTN_STORE16(p,v) (*(u32x4*)(p)=(v))
#endif
template<int THRL,bool WIN,int QMODE,bool FAST=false,bool GQ4=false> __device__ __forceinline__ void attn_unit(const bf16*Qu,const bf16*__restrict__ Kh,const bf16*__restrict__ Vh,bf16*Ou,const int NT,const int jump,const int qpos0,float sink2,const float*qg,const bool qrope,char*shm,const float*sinks=nullptr,const bf16*Knext=nullptr,const bool kpre=false){
  const int tid=threadIdx.x,lane=tid&63,r32=lane&31,hi=lane>>5; const int wid=__builtin_amdgcn_readfirstlane(tid>>6);
  const int qb_=GQ4?(wid&1):wid, hoff_=GQ4?(wid>>1)*64:0;
  if(GQ4)sink2=sinks[wid>>1]*1.4426950408889634f;
  const bf16*Qw=Qu+(long)(qb_*QBLK)*PQKV+hoff_;
  const unsigned lds0=(unsigned)(uintptr_t)shm;
  float*wsf=(float*)(shm+LDS_WS)+wid*64;
  const int krow_=8*wid+(lane>>3); const bf16*ksrc=Kh+(long)krow_*PQKV+(((lane&7)^(krow_&7))*8);
  const bf16*vsrc=Vh+(long)krow_*PQKV+(((lane&7)^(krow_&7))*8);
  const unsigned kdst=lds0+LDS_K+wid*1024, vdst=lds0+LDS_V+wid*1024;
  #define KROW(t) ((long)(t)*KVBLK+((t)>=4?jump:0))
  #define DMA_K(t,slot) glds16(ksrc+KROW(t)*PQKV,(unsigned)__builtin_amdgcn_readfirstlane(kdst+(slot)))
  #define DMA_V(t,slot) glds16(vsrc+KROW(t)*PQKV,(unsigned)__builtin_amdgcn_readfirstlane(vdst+(slot)))
  const int vrs_=4*hi+((lane&15)>>2), vch_=((lane>>4)&1)*2+((lane&3)>>1);
  const int voffA_=vrs_*128+(((vch_)^vrs_)<<4)+(lane&1)*8, voffB_=vrs_*128+(((4+vch_)^vrs_)<<4)+(lane&1)*8;
  const int vb0A=(int)(lds0+LDS_V)+voffA_, vb0B=(int)(lds0+LDS_V)+voffB_;
  const char*Kbase=shm+LDS_K; bf16x8 kf[8];
  const lds_cptr shm3=(lds_cptr)shm; const lds_cptr kp0=shm3+LDS_K+r32*128; const int koff[4]={((0+hi)^(r32&7))<<4,((2+hi)^(r32&7))<<4,((4+hi)^(r32&7))<<4,((6+hi)^(r32&7))<<4}; const lds_cptr vp0A=shm3+LDS_V+voffA_, vp0B=shm3+LDS_V+voffB_;
  if(!kpre){DMA_K(0,0);} DMA_V(0,0); if(!kpre){DMA_K(1,SLOTB);}
  bf16x8 qr[4];
  #pragma unroll
  for(int d0=0;d0<4;++d0)qr[d0]=*reinterpret_cast<const bf16x8*>(&Qw[(long)r32*PQKV+d0*16+hi*8]);
  if(!kpre){DMA_K(2,2*SLOTB);}
  if(QMODE){ float x[32];
    #pragma unroll
    for(int d0=0;d0<4;++d0){
      #pragma unroll
      for(int j=0;j<8;++j)x[8*d0+j]=__uint_as_float(((unsigned)(unsigned short)qr[d0][j])<<16);}
    if(QMODE==2){ float ss=0.f;
      #pragma unroll
      for(int i=0;i<32;++i)ss+=x[i]*x[i];
      ss+=__shfl_xor(ss,32); const float rs=rsqrtf(ss*(1.f/64.f)+1e-6f);
      #pragma unroll
      for(int d0=0;d0<4;++d0){
        #pragma unroll
        for(int j=0;j<8;++j)x[8*d0+j]*=rs*qg[16*d0+8*hi+j];} }
    if(qrope){ const int t=qpos0+qb_*QBLK+r32; const float pr=(float)(t>>6),pc=(float)(t&63);
      #pragma unroll
      for(int j=0;j<8;++j){ const float inv=exp2f(-(float)(8*hi+j)*(13.287712379549449f/16.f))*0.15915494309189535f;
        float rr=pr*inv,rc=pc*inv; rr-=floorf(rr); rc-=floorf(rc);
        const float sr=__builtin_amdgcn_sinf(rr),cr=__builtin_amdgcn_cosf(rr),sc=__builtin_amdgcn_sinf(rc),cc=__builtin_amdgcn_cosf(rc);
        const float a1=x[j],a2=x[8+j]; x[j]=a1*cr-a2*sr; x[8+j]=a1*sr+a2*cr;
        const float b1=x[16+j],b2=x[24+j]; x[16+j]=b1*cc-b2*sc; x[24+j]=b1*sc+b2*cc; } }
    #pragma unroll
    for(int d0=0;d0<4;++d0){ u32x4 w; w.x=cvtpk_s(x[8*d0]*C2,x[8*d0+1]*C2); w.y=cvtpk_s(x[8*d0+2]*C2,x[8*d0+3]*C2); w.z=cvtpk_s(x[8*d0+4]*C2,x[8*d0+5]*C2); w.w=cvtpk_s(x[8*d0+6]*C2,x[8*d0+7]*C2); qr[d0]=__builtin_bit_cast(bf16x8,w); } }
  float mhat=0.f,l_reg=0.f;f32x16 o[2];o[0]=f32x16{};o[1]=f32x16{};f32x16 negm=f32x16{};if(!WIN&&!FAST)asm volatile("":"+v"(negm)); f32x16 o2=f32x16{}; const bf16x8 ones8=(bf16x8){(short)0x3F80,(short)0x3F80,(short)0x3F80,(short)0x3F80,(short)0x3F80,(short)0x3F80,(short)0x3F80,(short)0x3F80};
  const int qrel=qpos0+qb_*QBLK+r32;
  #define CMASK(P0,P1,t) do{ if(WIN){ if((t)>=4) wmask(P0,P1,(int)KROW(t)-256-qrel,hi); } }while(0)
  bool resc=false;
  #define START(P0,P1) do{ resc=false; if(!FAST){ const float rm=rowmax(P0,P1); \
    { const float dl=rm; mhat=fadd_s(mhat,dl); \
      _Pragma("unroll") for(int r=0;r<16;++r){P0[r]=fsub_s(P0[r],dl);P1[r]=fsub_s(P1[r],dl);} \
      if(!WIN){ _Pragma("unroll") for(int r=0;r<16;++r)negm[r]=-mhat; asm volatile("":"+v"(negm)); } } } \
    _Pragma("unroll") for(int r=0;r<16;++r)P0[r]=__builtin_amdgcn_exp2f(P0[r]); }while(0)
  #define RESC() do{ if(resc){ asm volatile("s_waitcnt lgkmcnt(0)":::"memory"); \
      _Pragma("unroll") for(int d_=0;d_<2;++d_) _Pragma("unroll") for(int r=0;r<16;++r)o[d_][r]*=wsf[crow(r,hi)]; } }while(0)
  f32x16 pA0,pA1,pB0,pB1;
  int sl_prev=0,sl_cur=0,sl_next=SLOTB;
  #define ROT() do{sl_prev=sl_cur;sl_cur=sl_next;sl_next=(sl_next==(NSLOT-1)*SLOTB)?0:sl_next+SLOTB;}while(0)
  WAIT_BAR(3);
  qkt(pA0,pA1,Kbase,qr,negm,r32,hi);asm volatile("s_nop 15\n\ts_nop 7":"+v"(pA0),"+v"(pA1));CMASK(pA0,pA1,0);
  START(pA0,pA1);
  _Pragma("unroll") for(int r=0;r<16;++r)pA1[r]=__builtin_amdgcn_exp2f(pA1[r]);
  WAIT_BAR(0);
  DMA_K(3,0);DMA_V(1,SLOTB);
  ROT();
  kload8(kf,kp0+sl_cur,koff);
  WAIT_BAR(2);
  s16x4 vlo[8],vhi[8]; u32x4 pw0,pw1,pw2,pw3;
  #define PKW(P,B) cvtpk_s(P[B],P[B+1])
  #define PAF(k) __builtin_bit_cast(bf16x8,pw##k)
  #define VFR(i) (bf16x8){vlo[i][0],vlo[i][1],vlo[i][2],vlo[i][3],vhi[i][0],vhi[i][1],vhi[i][2],vhi[i][3]}
  #define PIN(x) asm volatile("":"+v"(x))
  #define MX3(a,b,c) __builtin_fmaxf(__builtin_fmaxf((a),(b)),(c))
  #define GAPA(MF,A0,A1,A2,A3,W0,W1,PW) do{ MF; if(!FAST){ sacc+=A0; sacc+=A1; sacc+=A2; sacc+=A3; PIN(sacc); } W0; W1; PIN(PW); SBAR(); }while(0)
  #define EX(v) __builtin_amdgcn_exp2f(v)
  #define GAPB(MF,X,B) do{ MF; X[B]=EX(X[B]); X[B+1]=EX(X[B+1]); X[B+2]=EX(X[B+2]); X[B+3]=EX(X[B+3]); PIN(X); SBAR(); }while(0)
  #define VRD(i) do{ vlo[i]=vtr((((i)>>2)?vpB_:vpA_)+((i)&3)*2048); vhi[i]=vtr((((i)>>2)?vpB_:vpA_)+((i)&3)*2048+1024); }while(0)
  #define ONESMF(k) do{ if(FAST){ o2=__builtin_amdgcn_mfma_f32_32x32x16_bf16(PAF(k),ones8,o2,0,0,0); SBAR(); } }while(0)
  #define KRD(G,j) do{ if(G){ kload2(kf,kp0+sl_next,koff,j); SBAR(); } }while(0)
  #define STEP(C0,C1,P0,P1,t,GK,GV,GL) do{ SBAR(); \
    const lds_cptr vpA_=vp0A+sl_prev, vpB_=vp0B+sl_prev; \
    VRD(0); SBAR(); float sacc=FAST?0.f:(P0[0]+P0[1]); \
    GAPA(C0=__builtin_amdgcn_mfma_f32_32x32x16_bf16(kf[0],qr[0],negm,0,0,0), P0[2],P0[3],P0[4],P0[5],     pw0[0]=PKW(P0,0), pw0[1]=PKW(P0,2), pw0); \
    VRD(4); SBAR(); GAPA(C1=__builtin_amdgcn_mfma_f32_32x32x16_bf16(kf[1],qr[0],negm,0,0,0), P0[6],P0[7],P0[8],P0[9],     pw0[2]=PKW(P0,4), pw0[3]=PKW(P0,6), pw0); \
    VRD(1); SBAR(); GAPA(C0=__builtin_amdgcn_mfma_f32_32x32x16_bf16(kf[2],qr[1],C0,0,0,0),   P0[10],P0[11],P0[12],P0[13], pw1[0]=PKW(P0,8), pw1[1]=PKW(P0,10), pw1); \
    VRD(5); SBAR(); GAPA(C1=__builtin_amdgcn_mfma_f32_32x32x16_bf16(kf[3],qr[1],C1,0,0,0),   P0[14],P0[15],P1[0],P1[1],   pw1[2]=PKW(P0,12),pw1[3]=PKW(P0,14), pw1); \
    VRD(2); SBAR(); GAPA(C0=__builtin_amdgcn_mfma_f32_32x32x16_bf16(kf[4],qr[2],C0,0,0,0),   P1[2],P1[3],P1[4],P1[5],     pw2[0]=PKW(P1,0), pw2[1]=PKW(P1,2), pw2); \
    VRD(6); SBAR(); GAPA(C1=__builtin_amdgcn_mfma_f32_32x32x16_bf16(kf[5],qr[2],C1,0,0,0),   P1[6],P1[7],P1[8],P1[9],     pw2[2]=PKW(P1,4), pw2[3]=PKW(P1,6), pw2); \
    VRD(3); SBAR(); GAPA(C0=__builtin_amdgcn_mfma_f32_32x32x16_bf16(kf[6],qr[3],C0,0,0,0),   P1[10],P1[11],P1[12],P1[13], pw3[0]=PKW(P1,8), pw3[1]=PKW(P1,10), pw3); \
    VRD(7); SBAR(); GAPA(C1=__builtin_amdgcn_mfma_f32_32x32x16_bf16(kf[7],qr[3],C1,0,0,0),   P1[14],P1[15],0.f,0.f,       pw3[2]=PKW(P1,12),pw3[3]=PKW(P1,14), pw3); \
    if(!FAST)l_reg+=sacc; \
    if(GK){DMA_K((t)+3,sl_cur);} if(GV){DMA_V((t)+1,sl_next);} \
    if(WIN){ _Pragma("unroll") for(int r=0;r<16;++r){C0[r]-=mhat;C1[r]-=mhat;} } \
    CMASK(C0,C1,t); \
    if(!FAST){ float a=MX3(C0[0],C0[1],C1[0]),b=MX3(C0[2],C0[3],C1[1]); a=MX3(a,C1[2],C1[3]); \
      _Pragma("unroll") for(int r=4;r<16;r+=4){a=MX3(a,C0[r],C0[r+1]);b=MX3(b,C0[r+2],C0[r+3]);a=MX3(a,C1[r],C1[r+1]);b=MX3(b,C1[r+2],C1[r+3]);} \
      float rm=__builtin_fmaxf(a,b); { auto rr=__builtin_amdgcn_permlane32_swap(__float_as_uint(rm),__float_as_uint(rm),false,false); rm=__builtin_fmaxf(__uint_as_float(rr[0]),__uint_as_float(rr[1])); } \
      resc=false; \
      if(__builtin_expect(__any(rm>(float)THRL),0)){ const float dl=__builtin_fmaxf(rm,0.f); mhat+=dl; \
        _Pragma("unroll") for(int r=0;r<16;++r){C0[r]-=dl;C1[r]-=dl;} \
        if(!WIN){ _Pragma("unroll") for(int r=0;r<16;++r)negm[r]=-mhat; asm volatile("":"+v"(negm)); } \
        const float f=__builtin_amdgcn_exp2f(-dl); l_reg*=f; if(hi==0)wsf[r32]=f; resc=true; } } \
    SBAR(); \
    GAPB(o[0]=__builtin_amdgcn_mfma_f32_32x32x16_bf16(PAF(0),VFR(0),o[0],0,0,0), C0,0); \
    GAPB(o[1]=__builtin_amdgcn_mfma_f32_32x32x16_bf16(PAF(0),VFR(4),o[1],0,0,0), C0,4); ONESMF(0); \
    KRD(GL,0); GAPB(o[0]=__builtin_amdgcn_mfma_f32_32x32x16_bf16(PAF(1),VFR(1),o[0],0,0,0), C0,8); \
    KRD(GL,1); GAPB(o[1]=__builtin_amdgcn_mfma_f32_32x32x16_bf16(PAF(1),VFR(5),o[1],0,0,0), C0,12); ONESMF(1); \
    KRD(GL,2); GAPB(o[0]=__builtin_amdgcn_mfma_f32_32x32x16_bf16(PAF(2),VFR(2),o[0],0,0,0), C1,0); \
    KRD(GL,3); GAPB(o[1]=__builtin_amdgcn_mfma_f32_32x32x16_bf16(PAF(2),VFR(6),o[1],0,0,0), C1,4); ONESMF(2); \
    GAPB(o[0]=__builtin_amdgcn_mfma_f32_32x32x16_bf16(PAF(3),VFR(3),o[0],0,0,0), C1,8); \
    GAPB(o[1]=__builtin_amdgcn_mfma_f32_32x32x16_bf16(PAF(3),VFR(7),o[1],0,0,0), C1,12); ONESMF(3); \
    }while(0)
  int t=1;
  for(;t+5<NT;t+=2){
    STEP(pB0,pB1,pA0,pA1,t,true,true,true);     WAIT_BAR(2); RESC(); ROT();
    STEP(pA0,pA1,pB0,pB1,t+1,true,true,true);   WAIT_BAR(2); RESC(); ROT();
  }
  #define ENDW(tt) do{ if((tt)+3<NT){WAIT_BAR(2);} else if((tt)+2<NT){WAIT_BAR(1);} else {WAIT_BAR(0);} }while(0)
  for(;t+1<NT;t+=2){
    STEP(pB0,pB1,pA0,pA1,t,(t+3<NT),(t+1<NT),(t+1<NT));       ENDW(t);   RESC(); ROT();
    STEP(pA0,pA1,pB0,pB1,t+1,(t+4<NT),(t+2<NT),(t+2<NT));     ENDW(t+1); RESC(); ROT();
  }
  if(Knext){ const bf16*kn=Knext+(long)krow_*PQKV+(((lane&7)^(krow_&7))*8); glds16(kn,(unsigned)__builtin_amdgcn_readfirstlane(kdst)); glds16(kn+(long)KVBLK*PQKV,(unsigned)__builtin_amdgcn_readfirstlane(kdst+SLOTB)); glds16(kn+(long)2*KVBLK*PQKV,(unsigned)__builtin_amdgcn_readfirstlane(kdst+2*SLOTB)); }
  STEP(pB0,pB1,pA0,pA1,NT-1,false,false,false); RESC();
  { if(!FAST){ float sacc=pB0[0]+pB0[1]; _Pragma("unroll") for(int r=2;r<16;++r)sacc+=pB0[r]; _Pragma("unroll") for(int r=0;r<16;++r)sacc+=pB1[r]; l_reg+=sacc; }
    pw0=(u32x4){PKW(pB0,0),PKW(pB0,2),PKW(pB0,4),PKW(pB0,6)};pw1=(u32x4){PKW(pB0,8),PKW(pB0,10),PKW(pB0,12),PKW(pB0,14)};pw2=(u32x4){PKW(pB1,0),PKW(pB1,2),PKW(pB1,4),PKW(pB1,6)};pw3=(u32x4){PKW(pB1,8),PKW(pB1,10),PKW(pB1,12),PKW(pB1,14)};
    SBAR(); pv(o,vb0A+sl_cur,vb0B+sl_cur,PAF(0),PAF(1),PAF(2),PAF(3)); ONESMF(0); ONESMF(1); ONESMF(2); ONESMF(3); }
  #undef PKW
  #undef PAF
  #undef VFR
  #undef PIN
  #undef MX3
  #undef GAPA
  #undef GAPB
  #undef EX
  #undef VRD
  #undef KRD
  #undef ONESMF
  #undef STEP
  #undef ENDW
  float rli[16];
  if(FAST){
    #pragma unroll
    for(int r=0;r<16;++r)rli[r]=__builtin_amdgcn_rcpf(o2[r]);
  } else {
  {auto rr=__builtin_amdgcn_permlane32_swap(__float_as_uint(l_reg),__float_as_uint(l_reg),false,false);l_reg=__uint_as_float(rr[0])+__uint_as_float(rr[1]);}
  if(WIN)l_reg+=__builtin_amdgcn_exp2f(sink2-mhat);
  if(hi==0)wsf[32+r32]=l_reg;asm volatile("s_waitcnt lgkmcnt(0)":::"memory");
  #pragma unroll
  for(int r=0;r<16;++r)rli[r]=__builtin_amdgcn_rcpf(wsf[32+crow(r,hi)]);
  }
  bf16*Ow=Ou+(long)(qb_*QBLK)*PO+hoff_;
  { bf16*stg=(bf16*)(shm+LDS_OST)+wid*2048;
    #pragma unroll
    for(int r=0;r<16;++r){const int orow=crow(r,hi);
      #pragma unroll
      for(int d0=0;d0<2;++d0)stg[orow*64+d0*32+r32]=__float2bfloat16(o[d0][r]*rli[r]);}
    asm volatile("s_waitcnt lgkmcnt(0)":::"memory");
    #pragma unroll
    for(int i=0;i<4;++i){const int row=i*8+(lane>>3),ch=lane&7; const u32x4 v=*(const u32x4*)(stg+row*64+ch*8); ATTN_STORE16(Ow+(long)row*PO+ch*8,v);} }
  asm volatile("s_waitcnt lgkmcnt(0)\n\ts_barrier":::"memory");
  #undef DMA_K
  #undef KROW
  #undef DMA_V
  #undef CMASK
  #undef START
  #undef RESC
  #undef ROT
}
constexpr int ATTN_LDS_BYTES=LDS_BYTES;
#undef SBAR
#undef WAIT_BAR
}

template <int LAYER> __device__ __forceinline__ void attn_fast_phase(Frame& F, char* shm) {
    using attn_body::bf16;
    const int G = gridDim.x, bx = blockIdx.x, vcu = (G % 8 == 0) ? (bx % 8) * (G / 8) + bx / 8 : bx;
    constexpr int NQH = LAYER == 0 ? 12 : 16, GQ = LAYER == 0 ? 3 : 4, QC0 = LAYER == 0 ? 256 : 0;
    constexpr int NLAT = NB * NQH * 32, NUN = NLAT + (LAYER == 0 ? NB * NQH : 0);
    const bf16* QKV = (const bf16*)F_qkvu; bf16* MIXO = (bf16*)F_mix;
    bool fast = false;
    if (LAYER == 0) { float gq = fabsf(F.in[I_EQG][F.lane]), gk = fabsf(F.in[I_EKG][F.lane]);
#pragma unroll
        for (int o = 1; o < 64; o <<= 1) { gq = fmaxf(gq, __shfl_xor(gq, o)); gk = fmaxf(gk, __shfl_xor(gk, o)); }
        fast = __builtin_amdgcn_readfirstlane((int)(64.f * 1.05f * attn_body::C2 * gq * gk < 60.f)) != 0; }
    if (LAYER == 1) {
        constexpr int NU1 = NB * 4 * (SEQ / 64);
        bool kpre = false;
        for (int id = vcu; id < NU1; id += G) {
            const int chunk = id % (SEQ / 64), hg = id / (SEQ / 64), kvh = hg & 3, b = hg >> 2, q0 = chunk * 64;
            const int idn = id + G; const bf16* Kn = idn < NU1 ? QKV + (size_t)((idn / (SEQ / 64)) >> 2) * RB * DIN + 1024 + ((idn / (SEQ / 64)) & 3) * 64 : nullptr;
            const size_t brow = (size_t)b * RB, qrow = brow + CTXL + (size_t)q0;
            int ws = q0 >= 128 ? q0 - 128 : 0; const int we = q0 + 192 <= SEQ ? q0 + 192 : SEQ; int n = (we - ws) / 64;
            if (n & 1) { ++n; if (ws + 64 * n > SEQ) ws -= 64; }
            attn_body::attn_unit<8, true, 1, false, true>(QKV + qrow * DIN + kvh * 256, QKV + brow * DIN + 1024 + kvh * 64, QKV + brow * DIN + 1280 + kvh * 64, MIXO + qrow * DM + kvh * 256, 4 + n, ws, q0, 0.f, nullptr, true, shm, F.in[I_OSINK] + kvh * 4, Kn, kpre); kpre = Kn != nullptr;
        }
        return;
    }
    bool kpre = false;
    for (int id = vcu; id < NUN; id += G) {
        const bf16* Kn = nullptr;
        { const int idn = id + G; if (idn < NUN) { const int hgn = idn < NLAT ? idn >> 5 : idn - NLAT; Kn = QKV + (size_t)(hgn / NQH) * RB * DIN + 1024 + ((hgn % NQH) / GQ) * 64; } }
        if (id < NLAT) {
            const int chunk = id & 31, hg = id >> 5, h = hg % NQH, b = hg / NQH;
            const size_t brow = (size_t)b * RB, qrow = brow + CTXL + (size_t)chunk * 256;
            const bf16* Qu = QKV + qrow * DIN + QC0 + h * 64; const bf16* Kh = QKV + brow * DIN + 1024 + (h / GQ) * 64; bf16* Ou = MIXO + qrow * DM + QC0 + h * 64;
            if (LAYER == 0) { if (fast) attn_body::attn_unit<8, false, 2, true>(Qu, Kh, Kh + 256, Ou, RB / 64, 0, chunk * 256, 0.f, F.in[I_EQG], true, shm, nullptr, Kn, kpre); else attn_body::attn_unit<8, false, 2, false>(Qu, Kh, Kh + 256, Ou, RB / 64, 0, chunk * 256, 0.f, F.in[I_EQG], true, shm, nullptr, Kn, kpre); }
        } else if (LAYER == 0) {
            const int cu = id - NLAT, h = cu % NQH, b = cu / NQH; const size_t brow = (size_t)b * RB;
            if (fast) attn_body::attn_unit<8, false, 2, true>(QKV + brow * DIN + QC0 + h * 64, QKV + brow * DIN + 1024 + (h / GQ) * 64, QKV + brow * DIN + 1280 + (h / GQ) * 64, MIXO + brow * DM + QC0 + h * 64, 4, 0, 0, 0.f, F.in[I_EQG], false, shm, nullptr, Kn, kpre);
            else attn_body::attn_unit<8, false, 2, false>(QKV + brow * DIN + QC0 + h * 64, QKV + brow * DIN + 1024 + (h / GQ) * 64, QKV + brow * DIN + 1280 + (h / GQ) * 64, MIXO + brow * DM + QC0 + h * 64, 4, 0, 0, 0.f, F.in[I_EQG], false, shm, nullptr, Kn, kpre);
        }
        kpre = Kn != nullptr;
    }
}

template <int G> __device__ __forceinline__ void pool_group(const bf16* ub, int t, int L, int lane, const bf16* pwT, const float* ps, bf16* orow) {
    constexpr int W = 2 << G; const int fr = lane & 15, kq = lane >> 4;
    int lo = t - W / 2; if (lo < 0) lo = 0; int hi = t + W - W / 2; if (hi > L) hi = L; const float rc = 1.f / (float)(hi - lo);
    f32x4 acc[4];
#pragma unroll
    for (int nb = 0; nb < 4; ++nb) acc[nb] = (f32x4){0.f, 0.f, 0.f, 0.f};
#pragma unroll
    for (int ks = 0; ks < 2; ++ks) {
        const bf16* up = ub + G * 64 + 32 * ks + 8 * kq;
        float sm[8], self[8];
#pragma unroll
        for (int c = 0; c < 8; ++c) { sm[c] = 0.f; self[c] = 0.f; }
#pragma unroll
        for (int i = 0; i < W; ++i) { const int p = t - W / 2 + i; const bool ok = p >= 0 && p < L; const int pc = ok ? p : t;
            const u32x4 w = *(const u32x4*)(up + (size_t)pc * DIN); const float f = ok ? 1.f : 0.f;
            const float e0 = bflo(w.x), e1 = bfhi(w.x), e2 = bflo(w.y), e3 = bfhi(w.y), e4 = bflo(w.z), e5 = bfhi(w.z), e6 = bflo(w.w), e7 = bfhi(w.w);
            sm[0] += f * e0; sm[1] += f * e1; sm[2] += f * e2; sm[3] += f * e3; sm[4] += f * e4; sm[5] += f * e5; sm[6] += f * e6; sm[7] += f * e7;
            if (i == W / 2) { self[0] = e0; self[1] = e1; self[2] = e2; self[3] = e3; self[4] = e4; self[5] = e5; self[6] = e6; self[7] = e7; } }
        u32x4 pb; pb.x = pk2(sm[0] * rc - self[0], sm[1] * rc - self[1]); pb.y = pk2(sm[2] * rc - self[2], sm[3] * rc - self[3]); pb.z = pk2(sm[4] * rc - self[4], sm[5] * rc - self[5]); pb.w = pk2(sm[6] * rc - self[6], sm[7] * rc - self[7]);
        const bf16x8 bfr = __builtin_bit_cast(bf16x8, pb);
#pragma unroll
        for (int nb = 0; nb < 4; ++nb) { const bf16x8 afr = *(const bf16x8*)(pwT + (size_t)(G * 64 + 16 * nb + fr) * 64 + 32 * ks + 8 * kq); acc[nb] = __builtin_amdgcn_mfma_f32_16x16x32_bf16(afr, bfr, acc[nb], 0, 0, 0); }
    }
#pragma unroll
    for (int nb = 0; nb < 4; ++nb) { const int d = G * 64 + 16 * nb + 4 * kq; const f32x4 sc = *(const f32x4*)(ps + d);
        u32x2 o; o.x = pk2(acc[nb][0] * sc.x, acc[nb][1] * sc.y); o.y = pk2(acc[nb][2] * sc.z, acc[nb][3] * sc.w); *(u32x2*)(orow + d) = o; }
}
__device__ __forceinline__ void pool_phase(Frame& F) {
    const int lane = F.lane, fr = lane & 15;
    for (int rg = F.gw; rg < NR / 16; rg += F.ngw) {
        const int r = rg * 16 + fr; int b, j; row_info(r, b, j);
        const int L = j < CTXL ? CTXL : SEQ, t = j < CTXL ? j : j - CTXL;
        const bf16* ub = F_qkvu + (size_t)(r - t) * DIN; bf16* orow = F_mix + (size_t)r * DM;
        pool_group<0>(ub, t, L, lane, F_pwT, F.in[I_EPS], orow); pool_group<1>(ub, t, L, lane, F_pwT, F.in[I_EPS], orow);
        pool_group<2>(ub, t, L, lane, F_pwT, F.in[I_EPS], orow); pool_group<3>(ub, t, L, lane, F_pwT, F.in[I_EPS], orow);
    }
}

#define INS16(L, v) do { float _v = (v); _Pragma("unroll") for (int _i = 0; _i < 16; ++_i) { const float _m = fmaxf(L[_i], _v); _v = fminf(L[_i], _v); L[_i] = _m; } } while (0)
#define BSORT16(L) do { _Pragma("unroll") for (int _st = 8; _st >= 1; _st >>= 1) { _Pragma("unroll") for (int _i = 0; _i < 16; ++_i) { if ((_i & _st) == 0) { const float _a = L[_i], _b = L[_i + _st]; L[_i] = fmaxf(_a, _b); L[_i + _st] = fminf(_a, _b); } } } } while (0)
#define CE16_(V, i, j) do { const float _a = V[i], _b = V[j]; V[i] = fmaxf(_a, _b); V[j] = fminf(_a, _b); } while (0)
#define SORT16(V) do { \
    CE16_(V,0,13); CE16_(V,1,12); CE16_(V,2,15); CE16_(V,3,14); CE16_(V,4,8); CE16_(V,5,6); CE16_(V,7,11); CE16_(V,9,10); \
    CE16_(V,0,5); CE16_(V,1,7); CE16_(V,2,9); CE16_(V,3,4); CE16_(V,6,13); CE16_(V,8,14); CE16_(V,10,15); CE16_(V,11,12); \
    CE16_(V,0,1); CE16_(V,2,3); CE16_(V,4,5); CE16_(V,6,8); CE16_(V,7,9); CE16_(V,10,11); CE16_(V,12,13); CE16_(V,14,15); \
    CE16_(V,0,2); CE16_(V,1,3); CE16_(V,4,10); CE16_(V,5,11); CE16_(V,6,7); CE16_(V,8,9); CE16_(V,12,14); CE16_(V,13,15); \
    CE16_(V,1,2); CE16_(V,3,12); CE16_(V,4,6); CE16_(V,5,7); CE16_(V,8,10); CE16_(V,9,11); CE16_(V,13,14); \
    CE16_(V,1,4); CE16_(V,2,6); CE16_(V,5,8); CE16_(V,7,10); CE16_(V,9,13); CE16_(V,11,14); \
    CE16_(V,2,4); CE16_(V,3,6); CE16_(V,9,12); CE16_(V,11,13); \
    CE16_(V,3,5); CE16_(V,6,8); CE16_(V,7,9); CE16_(V,10,12); \
    CE16_(V,3,4); CE16_(V,5,6); CE16_(V,7,8); CE16_(V,9,10); CE16_(V,11,12); \
    CE16_(V,6,7); CE16_(V,8,9); } while (0)
#define MERGE_LISTS(L, B) do { _Pragma("unroll") for (int _i = 0; _i < 16; ++_i) L[_i] = fmaxf(L[_i], B[15 - _i]); BSORT16(L); } while (0)
#define MERGE16(L, X) do { float _o[16]; _Pragma("unroll") for (int _i = 0; _i < 16; ++_i) _o[_i] = __shfl_xor(L[15 - _i], X); _Pragma("unroll") for (int _i = 0; _i < 16; ++_i) L[_i] = fmaxf(L[_i], _o[_i]); BSORT16(L); } while (0)
constexpr int RT_KROW = 272, RT_KHALF = 128 * RT_KROW, RT_LUT = 73728;
__device__ __forceinline__ void route_qload(const bf16* qp, int lane, bf16x8 (&qf)[4]) {
    const int c = lane & 15, kq = lane >> 4;
#pragma unroll
    for (int ks = 0; ks < 4; ++ks) qf[ks] = *(const bf16x8*)(qp + (size_t)c * 256 + 32 * ks + 8 * kq);
}
__device__ __forceinline__ void route_half(const bf16x8 (&qf)[4], const LAS unsigned char* kl, int lane, float (&L)[16]) {
    const int c = lane & 15, kq = lane >> 4;
    float va[16], vb[16];
#pragma unroll
    for (int rb = 0; rb < 8; ++rb) {
        f32x4 acc = (f32x4){0.f, 0.f, 0.f, 0.f};
#pragma unroll
        for (int ks = 0; ks < 4; ++ks) { const bf16x8 kf = *(const LAS bf16x8*)(kl + (16 * rb + c) * RT_KROW + (32 * ks + 8 * kq) * 2); acc = __builtin_amdgcn_mfma_f32_16x16x32_bf16(kf, qf[ks], acc, 0, 0, 0); }
#pragma unroll
        for (int i = 0; i < 4; ++i) { const float v = __uint_as_float((__float_as_uint(acc[i]) & 0xffffff80u) | (unsigned)(16 * rb + 4 * kq + i)); if (rb < 4) va[4 * rb + i] = v; else vb[4 * (rb - 4) + i] = v; }
    }
    SORT16(va); SORT16(vb);
#pragma unroll
    for (int i = 0; i < 16; ++i) L[i] = va[i];
    MERGE_LISTS(L, vb);
    MERGE16(L, 16); MERGE16(L, 32);
}
__device__ __forceinline__ void route_fast_phase(Frame& F, int layer, bool skip_ctx) {
    const int lane = F.lane, ngrp = NR * 8 / 16;
    const float* scl = F_scl + (size_t)layer * NEXP * 2;
    { const bf16* kg = F_keys + (size_t)layer * 2 * 16384;
      for (int i = F.tid; i < 2 * 128 * 16; i += NTHR) { const int row = i >> 4, ch = i & 15; *(LAS u32x4*)(F.lds + row * RT_KROW + ch * 16) = *(const u32x4*)(kg + (size_t)row * 128 + ch * 8); }
      __syncthreads(); }
    ticket_reset(F);
    const int ngw_ = (ngrp - (int)blockIdx.x + (int)gridDim.x - 1) / (int)gridDim.x, nfull = ((ngw_ / 4) / 8) * 8;
    for (;;) {
        const int tk = ticket_next(F); const int k0 = tk < nfull ? 4 * tk : 4 * nfull + (tk - nfull), kn = tk < nfull ? 4 : 1; if ((int)blockIdx.x + k0 * (int)gridDim.x >= ngrp) break;
        float L1[16], L2[16];
#pragma unroll
        for (int i = 0; i < 16; ++i) { L1[i] = 0.f; L2[i] = 0.f; }
        int vmask = 0;
        bf16x8 qn1[4], qn2[4];
        { const int g0 = (int)blockIdx.x + k0 * (int)gridDim.x; const bf16* qp = F_pq + (size_t)(g0 < ngrp ? g0 : ngrp - 1) * 16 * 256; route_qload(qp, lane, qn1); route_qload(qp + 128, lane, qn2); }
#pragma unroll 1
        for (int g = 0; g < kn; ++g) { const int grp = (int)blockIdx.x + (k0 + g) * (int)gridDim.x;
            bf16x8 q1[4], q2[4];
#pragma unroll
            for (int ks = 0; ks < 4; ++ks) { q1[ks] = qn1[ks]; q2[ks] = qn2[ks]; }
            asm volatile("" ::: "memory");
            { const int gn = grp + (int)gridDim.x; const bf16* qp = F_pq + (size_t)(gn < ngrp ? gn : ngrp - 1) * 16 * 256; route_qload(qp, lane, qn1); route_qload(qp + 128, lane, qn2); }
            if (grp >= ngrp || (skip_ctx && ((grp * 2) % RB) < CTXL)) continue;
            vmask |= 1 << g;
            float A1[16], A2[16];
            route_half(q1, F.lds, lane, A1);
            route_half(q2, F.lds + RT_KHALF, lane, A2);
            const bool mine = (lane >> 4) == g;
#pragma unroll
            for (int i = 0; i < 16; ++i) { L1[i] = mine ? A1[i] : L1[i]; L2[i] = mine ? A2[i] : L2[i]; } }
        if (vmask == 0) continue;
#define CAND(i, j) __uint_as_float((__float_as_uint(L1[i] + L2[j]) & 0xffffff00u) | (unsigned)(16 * (i) + (j)))
        float T[16], U[16], W[16];
#pragma unroll
        for (int jj = 0; jj < 16; ++jj) T[jj] = CAND(0, jj);
        U[0] = CAND(1, 0); U[1] = CAND(1, 1); U[2] = CAND(1, 2); U[3] = CAND(1, 3); U[4] = CAND(1, 4); U[5] = CAND(1, 5); U[6] = CAND(1, 6); U[7] = CAND(1, 7); U[8] = CAND(2, 0); U[9] = CAND(2, 1); U[10] = CAND(2, 2); U[11] = CAND(2, 3); U[12] = CAND(2, 4); U[13] = CAND(3, 0); U[14] = CAND(3, 1); U[15] = CAND(3, 2);
        W[0] = CAND(3, 3); W[1] = CAND(4, 0); W[2] = CAND(4, 1); W[3] = CAND(4, 2); W[4] = CAND(5, 0); W[5] = CAND(5, 1); W[6] = CAND(6, 0); W[7] = CAND(6, 1); W[8] = CAND(7, 0); W[9] = CAND(7, 1); W[10] = CAND(8, 0); W[11] = CAND(9, 0); W[12] = CAND(10, 0); W[13] = CAND(11, 0); W[14] = CAND(12, 0); W[15] = CAND(13, 0);
        SORT16(U); SORT16(W);
        MERGE_LISTS(T, U); MERGE_LISTS(T, W);
        INS16(T, CAND(14, 0)); INS16(T, CAND(15, 0));
#undef CAND
        LAS unsigned char* lut = F.lds + RT_LUT + F.wave * 2048 + lane * 32;
#define PK4(L, m) ((__float_as_uint(L[4 * (m)]) & 127u) | ((__float_as_uint(L[4 * (m) + 1]) & 127u) << 8) | ((__float_as_uint(L[4 * (m) + 2]) & 127u) << 16) | ((__float_as_uint(L[4 * (m) + 3]) & 127u) << 24))
        *(LAS u32x4*)lut = (u32x4){PK4(L1, 0), PK4(L1, 1), PK4(L1, 2), PK4(L1, 3)};
        *(LAS u32x4*)(lut + 16) = (u32x4){PK4(L2, 0), PK4(L2, 1), PK4(L2, 2), PK4(L2, 3)};
#undef PK4
        int P[16];
#pragma unroll
        for (int k = 0; k < 16; ++k) { const unsigned code = __float_as_uint(T[k]) & 255u; P[k] = (int)lut[code >> 4] * 128 + (int)lut[16 + (code & 15u)]; }
        float sum = 0.f, ex[16];
#pragma unroll
        for (int k = 0; k < 16; ++k) { ex[k] = __expf(T[k] - T[0]); sum += ex[k]; }
        const float rs = 1.f / sum;
        if ((vmask >> (lane >> 4)) & 1) { const size_t pair = ((size_t)((int)blockIdx.x + (k0 + (lane >> 4)) * (int)gridDim.x)) * 16 + (lane & 15);
            u32x2* op = F_rt + pair * 16;
            typedef float f32x2r __attribute__((ext_vector_type(2))); f32x2r st[16];
#pragma unroll
            for (int k = 0; k < 16; ++k) st[k] = *(const f32x2r*)(scl + 2 * (size_t)P[k]);
#pragma unroll
            for (int k = 0; k < 16; k += 2) { u32x4 o; o.x = (unsigned)P[k] | (pk2(0.f, st[k].x) & 0xffff0000u); o.y = __float_as_uint(ex[k] * rs * st[k].y); o.z = (unsigned)P[k + 1] | (pk2(0.f, st[k + 1].x) & 0xffff0000u); o.w = __float_as_uint(ex[k + 1] * rs * st[k + 1].y);
                *(u32x4*)(op + k) = o; }
        }
    }
}

typedef _Float16 h2_t __attribute__((ext_vector_type(2)));
__device__ __forceinline__ unsigned q4o(float a, float b, float c, float d, float inv) {
    return ((unsigned)(int)rintf(a * inv + 8.f) & 255u) | (((unsigned)(int)rintf(b * inv + 8.f) & 255u) << 8) | (((unsigned)(int)rintf(c * inv + 8.f) & 255u) << 16) | (((unsigned)(int)rintf(d * inv + 8.f) & 255u) << 24);
}
__device__ __forceinline__ void glds16x4(const void* up, const void* up2, const void* vp, const void* vp2, unsigned l0, unsigned l1, unsigned l2, unsigned l3) { unsigned keep;
    asm volatile("s_mov_b32 %0, m0\n\ts_mov_b32 m0, %5\n\ts_nop 0\n\tglobal_load_lds_dwordx4 %1, off\n\ts_mov_b32 m0, %6\n\ts_nop 0\n\tglobal_load_lds_dwordx4 %2, off\n\ts_mov_b32 m0, %7\n\ts_nop 0\n\tglobal_load_lds_dwordx4 %3, off\n\ts_mov_b32 m0, %8\n\ts_nop 0\n\tglobal_load_lds_dwordx4 %4, off\n\ts_mov_b32 m0, %0"
                 : "=&s"(keep) : "v"(up), "v"(up2), "v"(vp), "v"(vp2), "s"(l0), "s"(l1), "s"(l2), "s"(l3) : "memory"); }
#define ROR_(x, c) __builtin_amdgcn_update_dpp(0, (x), (c), 0xf, 0xf, true)
__device__ __forceinline__ int row16_sum_i(int d) { d += ROR_(d, 0x128); d += ROR_(d, 0x124); d += ROR_(d, 0x122); d += ROR_(d, 0x121); return d; }
__device__ __forceinline__ float row16_sum_f(float v) {
    v += __int_as_float(ROR_(__float_as_int(v), 0x128)); v += __int_as_float(ROR_(__float_as_int(v), 0x124)); v += __int_as_float(ROR_(__float_as_int(v), 0x122)); v += __int_as_float(ROR_(__float_as_int(v), 0x121)); return v; }
__device__ __forceinline__ float row16_max_f(float v) {
    v = fmaxf(v, __int_as_float(ROR_(__float_as_int(v), 0x128))); v = fmaxf(v, __int_as_float(ROR_(__float_as_int(v), 0x124))); v = fmaxf(v, __int_as_float(ROR_(__float_as_int(v), 0x122))); v = fmaxf(v, __int_as_float(ROR_(__float_as_int(v), 0x121))); return v; }
#undef ROR_
__device__ __forceinline__ void gather_q8_phase(Frame& F, int layer, bool skip_ctx, bool last, bool nextn) {
    const unsigned char* tu = F_tabu + (size_t)layer * NEXP * (DM / 2); const unsigned char* tv = F_tabv + (size_t)layer * NEXP * (DM / 2);
    const int lane = F.lane, s = lane & 15, e4 = lane >> 4;
    ticket_reset(F);
    int mi_c = -1; u32x4 ga[2] = {}, sa[2] = {}, eg[2] = {}, en[4] = {};
    const int ccol = 32 * s + 512 * (e4 >> 1) + 16 * (e4 & 1);
    f32x4 fg[4] = {};
    if (last) {
#pragma unroll
        for (int hh = 0; hh < 4; ++hh) fg[hh] = *(const f32x4*)(F.in[I_FING] + ccol + 4 * hh); }
    for (;;) {
        const int r = (int)blockIdx.x + ticket_next(F) * (int)gridDim.x; if (r >= NR) break;
        int b, j; row_info(r, b, j); if (skip_ctx && j < CTXL) continue;
        unsigned xq[2][8]; float sx, hsx; u32x4 xkeep[2];
        {
            const int mi = j < CTXL ? 4 : b, q0 = e4 >> 1, p0 = 2 * (e4 & 1);
            const bf16* xr = F_xs + (size_t)r * DM + 32 * s + 512 * q0 + 8 * p0; const bf16* gp = F_gbs + ((size_t)layer * 5 + mi) * 2 * DM + 32 * s + 512 * q0 + 8 * p0;
            const u32x4 xa[2] = {*(const u32x4*)xr, *(const u32x4*)(xr + 8)}; xkeep[0] = xa[0]; xkeep[1] = xa[1];
            if (mi != mi_c) { ga[0] = *(const u32x4*)gp; ga[1] = *(const u32x4*)(gp + 8); sa[0] = *(const u32x4*)(gp + DM); sa[1] = *(const u32x4*)(gp + DM + 8); mi_c = mi;
                const bf16* g2 = F_g2b + ((size_t)layer * 5 + mi) * DM + ccol; eg[0] = *(const u32x4*)g2; eg[1] = *(const u32x4*)(g2 + 8);
                if (nextn) { const bf16* nb = F_n1b + (size_t)mi * 2 * DM + ccol; en[0] = *(const u32x4*)nb; en[1] = *(const u32x4*)(nb + 8); en[2] = *(const u32x4*)(nb + DM); en[3] = *(const u32x4*)(nb + DM + 8); } }
            float ssq = 0.f, mx = 0.f;
#pragma unroll
            for (int c = 0; c < 2; ++c)
#pragma unroll
                for (int w = 0; w < 4; ++w) { const float a = bflo(xa[c][w]), d = bfhi(xa[c][w]); ssq += a * a + d * d; }
            const float rstd = rsqrtf(wave_sum(ssq) * (1.f / DM) + EPS);
            float hv[2][8];
#pragma unroll
            for (int c = 0; c < 2; ++c)
#pragma unroll
                for (int w = 0; w < 4; ++w) { const float a = (bflo(xa[c][w]) * rstd) * bflo(ga[c][w]) + bflo(sa[c][w]), d = (bfhi(xa[c][w]) * rstd) * bfhi(ga[c][w]) + bfhi(sa[c][w]);
                    hv[c][2 * w] = a; hv[c][2 * w + 1] = d; mx = fmaxf(mx, fmaxf(fabsf(a), fabsf(d))); }
            mx = wave_max(mx);
            const float inv = mx > 0.f ? 119.f / mx : 0.f; sx = mx * (1.f / 119.f);
            int sumt = 0; unsigned own[2][2];
#pragma unroll
            for (int c = 0; c < 2; ++c) { const unsigned tlo = q4o(hv[c][0], hv[c][1], hv[c][2], hv[c][3], inv), thi = q4o(hv[c][4], hv[c][5], hv[c][6], hv[c][7], inv);
                own[c][0] = ((tlo >> 4) & 0x0f0f0f0fu) | (thi & 0xf0f0f0f0u);
                own[c][1] = ((tlo & 0x0f0f0f0fu) | ((thi & 0x0f0f0f0fu) << 4)) ^ 0x88888888u;
                sumt = __builtin_amdgcn_sdot4((int)tlo, 0x01010101, sumt, false); sumt = __builtin_amdgcn_sdot4((int)thi, 0x01010101, sumt, false); }
            sumt = wave_sum_i(sumt);
            hsx = 0.5f * (float)(sumt - 8 * DM);
            unsigned z[4][2];
#pragma unroll
            for (int c = 0; c < 2; ++c)
#pragma unroll
                for (int h = 0; h < 2; ++h) { const auto rr = __builtin_amdgcn_permlane16_swap(own[c][h], own[c][h], false, false); z[c][h] = rr[0]; z[2 + c][h] = rr[1]; }
#pragma unroll
            for (int p = 0; p < 4; ++p)
#pragma unroll
                for (int h = 0; h < 2; ++h) { const auto rr = __builtin_amdgcn_permlane32_swap(z[p][h], z[p][h], false, false); xq[0][2 * p + h] = rr[0]; xq[1][2 * p + h] = rr[1]; }
        }
        LAS int* tl_id = (LAS int*)(F.lds + 133120 + F.wave * 1536); LAS float* tl_g = (LAS float*)(tl_id + 128); LAS float* tl_u = tl_g + 128;
        { const size_t o = (size_t)r * 128 + lane;
          const u32x2 t0 = F_rt[o], t1 = F_rt[o + 64];
          tl_id[lane] = (int)(t0.x & 0xffffu); tl_id[64 + lane] = (int)(t1.x & 0xffffu); tl_g[lane] = __uint_as_float(t0.y); tl_g[64 + lane] = __uint_as_float(t1.y); tl_u[lane] = __uint_as_float(t0.x & 0xffff0000u) * sx; tl_u[64 + lane] = __uint_as_float(t1.x & 0xffff0000u) * sx; }
        h2_t hacc[2][4][4]; float wsum = 0.f;
#pragma unroll
        for (int q = 0; q < 2; ++q)
#pragma unroll
            for (int dd = 0; dd < 4; ++dd)
#pragma unroll
                for (int k = 0; k < 4; ++k) hacc[q][dd][k] = (h2_t){(_Float16)0.f, (_Float16)0.f};
        const unsigned lslice = (unsigned)(uintptr_t)F.lds + (unsigned)F.wave * 16384u; LAS unsigned char* lrd = F.lds + F.wave * 16384 + lane * 16;
#define GD_ISSUE(k, it) do { const int _id = tl_id[4 * (it) + e4]; \
            const unsigned char* _up = tu + (size_t)_id * (DM / 2) + 16 * s; const unsigned char* _vp = tv + (size_t)_id * (DM / 2) + 16 * s; \
            const unsigned _lb = (unsigned)__builtin_amdgcn_readfirstlane((int)(lslice + (k) * 4096u)); \
            glds16x4(_up, _up + 256, _vp, _vp + 256, _lb, _lb + 1024u, _lb + 2048u, _lb + 3072u); } while (0)
#define ROR16_(d) do { d += __builtin_amdgcn_update_dpp(0, d, 0x128, 0xf, 0xf, true); d += __builtin_amdgcn_update_dpp(0, d, 0x124, 0xf, 0xf, true); d += __builtin_amdgcn_update_dpp(0, d, 0x122, 0xf, 0xf, true); d += __builtin_amdgcn_update_dpp(0, d, 0x121, 0xf, 0xf, true); } while (0)
#define GD_BODY2(k, REFILL, WAITN) do { const int i = i0 + (k), ea = 4 * i + e4; \
            asm volatile("s_waitcnt vmcnt(" #WAITN ")" ::: "memory"); __builtin_amdgcn_sched_barrier(0);            \
            const u32x4 ua0 = *(const LAS u32x4*)(lrd + (k) * 4096), ua1 = *(const LAS u32x4*)(lrd + (k) * 4096 + 1024), va0 = *(const LAS u32x4*)(lrd + (k) * 4096 + 2048), va1 = *(const LAS u32x4*)(lrd + (k) * 4096 + 3072); \
            const u32x4 ub0 = *(const LAS u32x4*)(lrd + (k) * 4096 + 4096), ub1 = *(const LAS u32x4*)(lrd + (k) * 4096 + 5120), vb0 = *(const LAS u32x4*)(lrd + (k) * 4096 + 6144), vb1 = *(const LAS u32x4*)(lrd + (k) * 4096 + 7168); \
            asm volatile("s_waitcnt lgkmcnt(0)" : "+v"(*(u32x4*)&ua0), "+v"(*(u32x4*)&ua1), "+v"(*(u32x4*)&va0), "+v"(*(u32x4*)&va1), "+v"(*(u32x4*)&ub0), "+v"(*(u32x4*)&ub1), "+v"(*(u32x4*)&vb0), "+v"(*(u32x4*)&vb1) :: "memory"); __builtin_amdgcn_sched_barrier(0);     \
            if (REFILL) { GD_ISSUE(k, i + 4); GD_ISSUE((k) + 1, i + 5); } __builtin_amdgcn_sched_barrier(0); \
            int dla = 0, dha = 0, dlb = 0, dhb = 0; \
            _Pragma("unroll") for (int dd = 0; dd < 4; ++dd) { dha = __builtin_amdgcn_sdot8((int)ua0[dd], (int)xq[0][2 * dd], dha, false); dla = __builtin_amdgcn_sdot8((int)ua0[dd], (int)xq[0][2 * dd + 1], dla, false); } \
            _Pragma("unroll") for (int dd = 0; dd < 4; ++dd) { dha = __builtin_amdgcn_sdot8((int)ua1[dd], (int)xq[1][2 * dd], dha, false); dla = __builtin_amdgcn_sdot8((int)ua1[dd], (int)xq[1][2 * dd + 1], dla, false); } \
            _Pragma("unroll") for (int dd = 0; dd < 4; ++dd) { dhb = __builtin_amdgcn_sdot8((int)ub0[dd], (int)xq[0][2 * dd], dhb, false); dlb = __builtin_amdgcn_sdot8((int)ub0[dd], (int)xq[0][2 * dd + 1], dlb, false); } \
            _Pragma("unroll") for (int dd = 0; dd < 4; ++dd) { dhb = __builtin_amdgcn_sdot8((int)ub1[dd], (int)xq[1][2 * dd], dhb, false); dlb = __builtin_amdgcn_sdot8((int)ub1[dd], (int)xq[1][2 * dd + 1], dlb, false); } \
            int da = 16 * dha + dla, db = 16 * dhb + dlb;        \
            ROR16_(da); ROR16_(db); \
            const int odd = s & 1, es = ea + 4 * odd; const float g = tl_g[es], usc = tl_u[es]; \
            const float w = g * gelu_erf(((float)(odd ? db : da) + hsx) * usc); \
            const float wa = __int_as_float(__builtin_amdgcn_update_dpp(0, __float_as_int(w), 0xA0, 0xf, 0xf, true)), wb = __int_as_float(__builtin_amdgcn_update_dpp(0, __float_as_int(w), 0xF5, 0xf, 0xf, true));     \
            wsum += wa + wb; \
            const _Float16 wa16 = (_Float16)(wa * 8192.f), wa16b = (_Float16)(wa * 512.f), wb16 = (_Float16)(wb * 8192.f), wb16b = (_Float16)(wb * 512.f);     \
            const h2_t wha = (h2_t){wa16, wa16}, whab = (h2_t){wa16b, wa16b}, whb = (h2_t){wb16, wb16}, whbb = (h2_t){wb16b, wb16b}; \
            _Pragma("unroll") for (int dd = 0; dd < 4; ++dd) { const unsigned a0_ = va0[dd], a1_ = a0_ >> 8, b0_ = va1[dd], b1_ = b0_ >> 8; \
                hacc[0][dd][0] = __builtin_elementwise_fma(__builtin_bit_cast(h2_t, a0_ & 0x000f000fu), wha, hacc[0][dd][0]); hacc[0][dd][1] = __builtin_elementwise_fma(__builtin_bit_cast(h2_t, a0_ & 0x00f000f0u), whab, hacc[0][dd][1]); \
                hacc[0][dd][2] = __builtin_elementwise_fma(__builtin_bit_cast(h2_t, a1_ & 0x000f000fu), wha, hacc[0][dd][2]); hacc[0][dd][3] = __builtin_elementwise_fma(__builtin_bit_cast(h2_t, a1_ & 0x00f000f0u), whab, hacc[0][dd][3]); \
                hacc[1][dd][0] = __builtin_elementwise_fma(__builtin_bit_cast(h2_t, b0_ & 0x000f000fu), wha, hacc[1][dd][0]); hacc[1][dd][1] = __builtin_elementwise_fma(__builtin_bit_cast(h2_t, b0_ & 0x00f000f0u), whab, hacc[1][dd][1]); \
                hacc[1][dd][2] = __builtin_elementwise_fma(__builtin_bit_cast(h2_t, b1_ & 0x000f000fu), wha, hacc[1][dd][2]); hacc[1][dd][3] = __builtin_elementwise_fma(__builtin_bit_cast(h2_t, b1_ & 0x00f000f0u), whab, hacc[1][dd][3]); } \
            _Pragma("unroll") for (int dd = 0; dd < 4; ++dd) { const unsigned a0_ = vb0[dd], a1_ = a0_ >> 8, b0_ = vb1[dd], b1_ = b0_ >> 8; \
                hacc[0][dd][0] = __builtin_elementwise_fma(__builtin_bit_cast(h2_t, a0_ & 0x000f000fu), whb, hacc[0][dd][0]); hacc[0][dd][1] = __builtin_elementwise_fma(__builtin_bit_cast(h2_t, a0_ & 0x00f000f0u), whbb, hacc[0][dd][1]); \
                hacc[0][dd][2] = __builtin_elementwise_fma(__builtin_bit_cast(h2_t, a1_ & 0x000f000fu), whb, hacc[0][dd][2]); hacc[0][dd][3] = __builtin_elementwise_fma(__builtin_bit_cast(h2_t, a1_ & 0x00f000f0u), whbb, hacc[0][dd][3]); \
                hacc[1][dd][0] = __builtin_elementwise_fma(__builtin_bit_cast(h2_t, b0_ & 0x000f000fu), whb, hacc[1][dd][0]); hacc[1][dd][1] = __builtin_elementwise_fma(__builtin_bit_cast(h2_t, b0_ & 0x00f000f0u), whbb, hacc[1][dd][1]); \
                hacc[1][dd][2] = __builtin_elementwise_fma(__builtin_bit_cast(h2_t, b1_ & 0x000f000fu), whb, hacc[1][dd][2]); hacc[1][dd][3] = __builtin_elementwise_fma(__builtin_bit_cast(h2_t, b1_ & 0x00f000f0u), whbb, hacc[1][dd][3]); } \
            } while (0)
        GD_ISSUE(0, 0); GD_ISSUE(1, 1); GD_ISSUE(2, 2); GD_ISSUE(3, 3);
#pragma unroll 1
        for (int i0 = 0; i0 < 28; i0 += 4) { GD_BODY2(0, true, 8); GD_BODY2(2, true, 8); }
        { const int i0 = 28; GD_BODY2(0, false, 8); GD_BODY2(2, false, 0); }
#undef GD_BODY2
#undef ROR16_
#undef GD_ISSUE
        h2_t r1p[16], r2p[8];
#pragma unroll
        for (int k = 0; k < 16; ++k) { const auto rr = __builtin_amdgcn_permlane32_swap(__builtin_bit_cast(unsigned, hacc[0][k >> 2][k & 3]), __builtin_bit_cast(unsigned, hacc[1][k >> 2][k & 3]), false, false);
            r1p[k] = __builtin_bit_cast(h2_t, (unsigned)rr[0]) + __builtin_bit_cast(h2_t, (unsigned)rr[1]); }
#pragma unroll
        for (int k = 0; k < 8; ++k) { const auto rr = __builtin_amdgcn_permlane16_swap(__builtin_bit_cast(unsigned, r1p[k]), __builtin_bit_cast(unsigned, r1p[8 + k]), false, false);
            r2p[k] = __builtin_bit_cast(h2_t, (unsigned)rr[0]) + __builtin_bit_cast(h2_t, (unsigned)rr[1]); }
        float r2[16];
#pragma unroll
        for (int dd = 0; dd < 2; ++dd) { const int a0 = 8 * dd;
            r2[a0 + 0] = (float)r2p[4 * dd + 0].x * 2048.f; r2[a0 + 2] = (float)r2p[4 * dd + 0].y * 2048.f; r2[a0 + 4] = (float)r2p[4 * dd + 1].x * 2048.f; r2[a0 + 6] = (float)r2p[4 * dd + 1].y * 2048.f;
            r2[a0 + 1] = (float)r2p[4 * dd + 2].x * 2048.f; r2[a0 + 3] = (float)r2p[4 * dd + 2].y * 2048.f; r2[a0 + 5] = (float)r2p[4 * dd + 3].x * 2048.f; r2[a0 + 7] = (float)r2p[4 * dd + 3].y * 2048.f; }
        wsum = xrow_sum(wsum);
        const float corr = 7.5f * wsum;
        const int c0 = 32 * (s + 16 * (e4 >> 1)) + 16 * (e4 & 1);
        const int mi = j < CTXL ? 4 : b;
        bf16* xs = F_xs + (size_t)r * DM;
        f32x4 y[4]; float ss = 0.f;
        { const u32x4 wa = xkeep[0], wb = xkeep[1];
          const f32x4 xv[4] = {(f32x4){bflo(wa.x), bfhi(wa.x), bflo(wa.y), bfhi(wa.y)}, (f32x4){bflo(wa.z), bfhi(wa.z), bflo(wa.w), bfhi(wa.w)}, (f32x4){bflo(wb.x), bfhi(wb.x), bflo(wb.y), bfhi(wb.y)}, (f32x4){bflo(wb.z), bfhi(wb.z), bflo(wb.w), bfhi(wb.w)}};
          const u32x4 gA = eg[0], gB = eg[1];
          const f32x4 gq[4] = {(f32x4){bflo(gA.x), bfhi(gA.x), bflo(gA.y), bfhi(gA.y)}, (f32x4){bflo(gA.z), bfhi(gA.z), bflo(gA.w), bfhi(gA.w)}, (f32x4){bflo(gB.x), bfhi(gB.x), bflo(gB.y), bfhi(gB.y)}, (f32x4){bflo(gB.z), bfhi(gB.z), bflo(gB.w), bfhi(gB.w)}};
#pragma unroll
          for (int hh = 0; hh < 4; ++hh) { const f32x4 gv = gq[hh];
            const f32x4 yy = xv[hh] + gv * ((f32x4){r2[4 * hh], r2[4 * hh + 1], r2[4 * hh + 2], r2[4 * hh + 3]} - corr);
            y[hh] = yy; ss += (yy.x * yy.x + yy.y * yy.y) + (yy.z * yy.z + yy.w * yy.w); } }
        float rstd = 1.f;
        if (last || nextn) rstd = rsqrtf(wave_sum(ss) * (1.f / DM) + EPS);
        if (last) {
            float* orow = F.out + ((size_t)b * SEQ + (j - CTXL)) * DM;
#pragma unroll
            for (int hh = 0; hh < 4; ++hh) { const int c = c0 + 4 * hh; *(f32x4*)(orow + c) = y[hh] * rstd * fg[hh]; }
        } else {
            u32x4 oa, ob; oa.x = pk2(y[0].x, y[0].y); oa.y = pk2(y[0].z, y[0].w); oa.z = pk2(y[1].x, y[1].y); oa.w = pk2(y[1].z, y[1].w);
            ob.x = pk2(y[2].x, y[2].y); ob.y = pk2(y[2].z, y[2].w); ob.z = pk2(y[3].x, y[3].y); ob.w = pk2(y[3].z, y[3].w);
            *(u32x4*)(xs + c0) = oa; *(u32x4*)(xs + c0 + 8) = ob;
        }
        if (nextn) {
            bf16* orow = F_xn + (size_t)r * DM + c0;
            const u32x4 na = en[0], nbb = en[1], ha = en[2], hb = en[3];
            const f32x4 gq[4] = {(f32x4){bflo(na.x), bfhi(na.x), bflo(na.y), bfhi(na.y)}, (f32x4){bflo(na.z), bfhi(na.z), bflo(na.w), bfhi(na.w)}, (f32x4){bflo(nbb.x), bfhi(nbb.x), bflo(nbb.y), bfhi(nbb.y)}, (f32x4){bflo(nbb.z), bfhi(nbb.z), bflo(nbb.w), bfhi(nbb.w)}};
            const f32x4 hq[4] = {(f32x4){bflo(ha.x), bfhi(ha.x), bflo(ha.y), bfhi(ha.y)}, (f32x4){bflo(ha.z), bfhi(ha.z), bflo(ha.w), bfhi(ha.w)}, (f32x4){bflo(hb.x), bfhi(hb.x), bflo(hb.y), bfhi(hb.y)}, (f32x4){bflo(hb.z), bfhi(hb.z), bflo(hb.w), bfhi(hb.w)}};
            f32x4 z[4];
#pragma unroll
            for (int hh = 0; hh < 4; ++hh) z[hh] = (y[hh] * rstd) * gq[hh] + hq[hh];
            u32x4 oa, ob; oa.x = pk2(z[0].x, z[0].y); oa.y = pk2(z[0].z, z[0].w); oa.z = pk2(z[1].x, z[1].y); oa.w = pk2(z[1].z, z[1].w);
            ob.x = pk2(z[2].x, z[2].y); ob.y = pk2(z[2].z, z[2].w); ob.z = pk2(z[3].x, z[3].y); ob.w = pk2(z[3].z, z[3].w);
            *(u32x4*)orow = oa; *(u32x4*)(orow + 8) = ob;
        }
    }
}

#define RLX_AGENT __ATOMIC_RELAXED, __HIP_MEMORY_SCOPE_AGENT
#define XB_TMO      128
#define XB_XCNT(j)  (256  + 64 * (j))
#define XB_XSUB(j)  (1280 + 64 * (j))
#define XB_XGEN(j)  (2304 + 64 * (j))
#define XB_TOP      3328
#define XB_TOPGEN   3392
#define XCD_BAR_WORDS 3456
#define XB_SPIN_CAP (1u << 18)

__device__ __forceinline__ unsigned xb_ld(unsigned* p)              { return __hip_atomic_load(p, __ATOMIC_RELAXED, __HIP_MEMORY_SCOPE_AGENT); }
__device__ __forceinline__ unsigned xb_add(unsigned* p, unsigned v) { return __hip_atomic_fetch_add(p, v, __ATOMIC_RELAXED, __HIP_MEMORY_SCOPE_AGENT); }
__device__ __forceinline__ unsigned xb_xcc_id() { return (unsigned)__builtin_amdgcn_s_getreg((3 << 11) | 20) & 0xFu; }
#define XB_SPIN(cond, bar) do { unsigned _sp = 0; while (cond) { __builtin_amdgcn_s_sleep(1); \
    if ((++_sp & 255u) == 0u) { if (xb_ld(&(bar)[XB_TMO])) break; if (_sp > XB_SPIN_CAP) { atomicAdd(&(bar)[XB_TMO], 1u); break; } } } } while (0)

struct XcdBarrier {
    unsigned* bar; unsigned x;
    volatile LAS unsigned* st;
};

__device__ __forceinline__ XcdBarrier xcd_barrier_post(unsigned* bar, volatile LAS unsigned* st) {
    XcdBarrier b; b.bar = bar; b.x = xb_xcc_id(); b.st = st;
    if (threadIdx.x == 0) (void)xb_add(&bar[XB_XCNT(b.x)], 1u);
    return b;
}
__device__ __forceinline__ void xcd_barrier_complete(unsigned* bar, unsigned x, unsigned& nloc, unsigned& nx) {
    const unsigned G = gridDim.x * gridDim.y * gridDim.z;
    unsigned sum, cnt, mine, sp = 0u;
    for (;;) {
        sum = 0u; cnt = 0u; mine = 0u;
#pragma unroll
        for (unsigned j = 0; j < 16; ++j) { const unsigned c = xb_ld(&bar[XB_XCNT(j)]); sum += c; cnt += (c > 0u) ? 1u : 0u; mine = (j == x) ? c : mine; }
        if (sum == G) break;
        __builtin_amdgcn_s_sleep(1);
        if ((++sp & 255u) == 0u) { if (xb_ld(&bar[XB_TMO])) break; if (sp > XB_SPIN_CAP) { atomicAdd(&bar[XB_TMO], 1u); break; } }
    }
    nloc = mine > 0u ? mine : 1u; nx = cnt > 0u ? cnt : 1u;
}

__device__ __forceinline__ void xcd_barrier(const XcdBarrier& b) {
    asm volatile("s_waitcnt vmcnt(0)" ::: "memory");
    __syncthreads();
    if (threadIdx.x == 0) {
        unsigned* bar = b.bar;
        __builtin_amdgcn_s_waitcnt(0);
        unsigned nloc = b.st[0], nx = b.st[1];
        if (nloc == 0u) { xcd_barrier_complete(bar, b.x, nloc, nx); b.st[0] = nloc; b.st[1] = nx; }
        const unsigned old = xb_add(&bar[XB_XSUB(b.x)], 1u);
        const unsigned gen = old / nloc;
        if (old + 1u == (gen + 1u) * nloc) {
            __builtin_amdgcn_fence(__ATOMIC_RELEASE, "agent");
            asm volatile("s_waitcnt vmcnt(0)" ::: "memory");
            const unsigned og = xb_add(&bar[XB_TOP], 1u);
            const unsigned tg = og / nx;
            if (og + 1u == (tg + 1u) * nx) xb_add(&bar[XB_TOPGEN], 1u);
            else XB_SPIN(xb_ld(&bar[XB_TOPGEN]) == tg, bar);
            __builtin_amdgcn_fence(__ATOMIC_ACQUIRE, "agent");
            xb_add(&bar[XB_XGEN(b.x)], 1u);
            asm volatile("s_waitcnt vmcnt(0)" ::: "memory");
        } else {
            XB_SPIN(xb_ld(&bar[XB_XGEN(b.x)]) == gen, bar);
            __builtin_amdgcn_fence(__ATOMIC_ACQUIRE, "agent");
            asm volatile("s_waitcnt vmcnt(0)" ::: "memory");
        }
    }
    __syncthreads();
}


#define IN(k) (lo <= (k) && (k) < hi)
#define SEAM(k) do { if (IN(k) && IN((k) + 1)) xcd_barrier(bar); } while (0)
template <int LAYER> __device__ __forceinline__ void layer_phases(Frame& F, char* shm, const int lo, const int hi, cg::grid_group& grid, const XcdBarrier& bar) {
    constexpr int P = 1 + 9 * LAYER; constexpr bool lastl = LAYER == 1;
    if (LAYER == 0) { if (IN(P + 0)) norm_phase<0>(F, LAYER, true, false, true); SEAM(P + 0); }
    if (IN(P + 1)) { if (LAYER == 0) fold_norm2(F);
        const pg8::Gemm g{F_xn, F_winT + (size_t)LAYER * DIN * DM, NR, DIN, DM}; pg8::Order S; S.init(132, DIN, gridDim.x, blockIdx.x, 0); S.kfix = F_qkvu; S.kg = LAYER == 0 ? F.in[I_EKG] : nullptr; const pg8::EpiBf16 E{F_qkvu, DIN};
        pg8::gemm_phase<pg8::EpiBf16, pg8::Order, true, true>(F.lds, g, S, E);
        if (LAYER == 0) tables_tail(F, 0); }
    SEAM(P + 1);
    if (IN(P + 3)) { attn_fast_phase<LAYER>(F, shm); if (LAYER == 0) pool_phase(F); }
    SEAM(P + 3);
    if (IN(P + 4)) { const pg8::Gemm g{F_mix, F_woutT + (size_t)LAYER * DM * DM, NR, DM, DM}; pg8::Order S; S.init(lastl ? 128 : 132, DM, gridDim.x, blockIdx.x, lastl ? 1 : 0);
        const pg8::EpiResid16T<LAYER == 0> E{F.in[I_X], F.in[I_CTX], F_xs, F_mod + (size_t)LAYER * 5 * MODW + 2 * DM, F_ssp};
        pg8::gemm_phase<pg8::EpiResid16T<LAYER == 0>, pg8::Order, true, true>(F.lds, g, S, E);
        if (LAYER == 0) tables_tail(F, 1); }
    SEAM(P + 4);
    if (IN(P + 6)) { const pg8::Gemm g{F_xs, F_wqb + (size_t)LAYER * 5 * DPQ * DM, NR, DPQ, DM, (size_t)DPQ * DM * 2}; pg8::Order S; S.init(lastl ? 128 : 132, DPQ, gridDim.x, blockIdx.x, lastl ? 1 : 0);
        const pg8::EpiPQ E{F_pq, DPQ, F_ssp, F_pqbias + (size_t)LAYER * 5 * DPQ, (LAS float*)(F.lds + 135168)};
        pg8::gemm_phase<pg8::EpiPQ, pg8::Order, true, true>(F.lds, g, S, E);
        if (LAYER == 0) tables_tail(F, 2); }
    SEAM(P + 6);
    if (IN(P + 7)) route_fast_phase(F, LAYER, lastl);
    SEAM(P + 7);
    if (IN(P + 8)) gather_q8_phase(F, LAYER, lastl, lastl, !lastl);
}
#undef IN
#undef SEAM

constexpr int PH_PER_LAYER = 9, N_PHASES = 1 + 2 * PH_PER_LAYER;
__global__ void __launch_bounds__(NTHR, 2) mk_fwd(Args args) {
    extern __shared__ __attribute__((aligned(16))) unsigned char lds_raw[];
    Frame F;
    F.in = args.in; F.out = args.out; F.ws = args.ws; F.lds = (LAS unsigned char*)lds_raw;
    F.tid = threadIdx.x; F.lane = F.tid & 63; F.wave = __builtin_amdgcn_readfirstlane(F.tid >> 6);
    F.gw = blockIdx.x * NWAVES + F.wave; F.ngw = gridDim.x * NWAVES; F.gtid = blockIdx.x * NTHR + F.tid; F.ngt = gridDim.x * NTHR;
    cg::grid_group grid = cg::this_grid();
    volatile LAS unsigned* bst = (volatile LAS unsigned*)(F.lds + 131072 + 512);
    if (F.tid < 2) bst[F.tid] = 0u;
    __syncthreads();
    const XcdBarrier bar = xcd_barrier_post((unsigned*)(F.ws + WS_CTL) + 4096, bst);
    const int lo = args.ph_lo, hi = args.ph_hi;
#define IN(k) (lo <= (k) && (k) < hi)
#define SEAM(k) do { if (IN(k) && IN((k) + 1)) xcd_barrier(bar); } while (0)
    if (lo < 0) grid.sync();
    if (IN(0)) prep_phase(F);
    SEAM(0);
    layer_phases<0>(F, (char*)lds_raw, lo, hi, grid, bar);
    SEAM(PH_PER_LAYER);
    layer_phases<1>(F, (char*)lds_raw, lo, hi, grid, bar);
}

extern "C" void kernel_launch(void* const* d_in, const int* in_sizes, int n_in, void* d_out, int out_size, void* d_ws, size_t ws_size, hipStream_t stream) {
    static int grid = 0;
    if (grid == 0) {
        if (n_in != N_IN || out_size != NB * SEQ * DM || ws_size < WS_END) { fprintf(stderr, "kernel_launch: unexpected problem (n_in %d out %d ws %zu)\n", n_in, out_size, ws_size); grid = -1; return; }
        int dev = 0, cus = 0, per_cu = 0;
        hipGetDevice(&dev); hipDeviceGetAttribute(&cus, hipDeviceAttributeMultiprocessorCount, dev);
        hipFuncSetAttribute((const void*)mk_fwd, hipFuncAttributeMaxDynamicSharedMemorySize, LDS_BYTES);
        hipOccupancyMaxActiveBlocksPerMultiprocessor(&per_cu, (const void*)mk_fwd, NTHR, LDS_BYTES);
        if (per_cu < 1) { fprintf(stderr, "kernel_launch: occupancy query says %d blocks per CU\n", per_cu); per_cu = 1; }
        if (per_cu > 1) per_cu = 1;
        grid = cus * per_cu;
        (void)hipGetLastError();
    }
    if (grid < 0) return;
    hipMemsetAsync((char*)d_ws + WS_CTL, 0, 65536, stream);
    Args a{};
    for (int i = 0; i < N_IN; ++i) a.in[i] = (const float*)d_in[i];
    a.out = (float*)d_out; a.ws = (unsigned char*)d_ws;
#if MK_ONE_LAUNCH
    a.ph_lo = 0; a.ph_hi = N_PHASES;
    void* kargs[] = {&a};
    hipError_t e = hipLaunchCooperativeKernel((const void*)mk_fwd, dim3(grid), dim3(NTHR), kargs, LDS_BYTES, stream);
    if (e != hipSuccess) fprintf(stderr, "cooperative launch failed: %s (grid %d)\n", hipGetErrorString(e), grid);
#else
    for (int ph = 0; ph < N_PHASES; ++ph) { a.ph_lo = ph; a.ph_hi = ph + 1; hipLaunchKernelGGL(mk_fwd, dim3(grid), dim3(NTHR), LDS_BYTES, stream, a); }
#endif
}
```

```cpp
#include <hip/hip_runtime.h>
#include <hip/hip_cooperative_groups.h>
#include <cstdio>
#include <cstdint>
namespace cg = cooperative_groups;

#ifndef MK_ONE_LAUNCH
#define MK_ONE_LAUNCH 1
#endif

#define LAS __attribute__((address_space(3)))
typedef unsigned short bf16;
typedef short bf16x8 __attribute__((ext_vector_type(8)));
typedef float f32x4 __attribute__((ext_vector_type(4)));
typedef unsigned u32x4 __attribute__((ext_vector_type(4)));
typedef unsigned u32x2 __attribute__((ext_vector_type(2)));

constexpr int NB = 4, SEQ = 8192, DM = 1024, CTXL = 256, RB = SEQ + CTXL, NR = NB * RB;
constexpr int DIN = 1536, DPQ = 2048, NEXP = 16384;
constexpr int MODW = 6 * DM;
constexpr float EPS = 1e-6f;
constexpr float C2 = 0.125f * 1.4426950408889634f;
constexpr float LOG2E = 1.4426950408889634f;
constexpr int NWAVES = 8, NTHR = 512;
constexpr int LDS_BYTES = 147456;

constexpr size_t MiB = 1u << 20;
constexpr size_t WS_CTL = 0, WS_MOD = 1 * MiB, WS_XCTX = 2 * MiB, WS_WINT = 6 * MiB, WS_WOUTT = 12 * MiB, WS_WQT = 16 * MiB, WS_KEYS = 24 * MiB;
constexpr size_t WS_XN = 26 * MiB, WS_QKVU = 92 * MiB, WS_MIX = 191 * MiB, WS_PQ = 92 * MiB  ;
constexpr size_t WS_IDX = 257 * MiB, WS_GW = 274 * MiB, WS_TABU = 291 * MiB, WS_TABV = 323 * MiB, WS_SCL = 355 * MiB, WS_XS = 357 * MiB, WS_WQB = 423 * MiB, WS_PQAUX = 463 * MiB, WS_SSP = 464 * MiB, WS_US = 467 * MiB, WS_END = 485 * MiB;
static_assert(WS_XN + (size_t)NR * DM * 2 <= WS_QKVU && WS_QKVU + (size_t)NR * DIN * 2 <= WS_MIX && WS_MIX + (size_t)NR * DM * 2 <= WS_IDX, "ws map");
static_assert(WS_PQ + (size_t)NR * DPQ * 2 <= WS_IDX && WS_IDX + (size_t)NR * 128 * 8 <= WS_TABU, "ws map 2");
static_assert(WS_TABU + (size_t)2 * NEXP * DM <= WS_TABV && WS_TABV + (size_t)2 * NEXP * DM <= WS_SCL && WS_SCL + (size_t)4 * NEXP * 4 <= WS_END, "ws map 3");

enum { I_X = 0, I_C, I_CTX, I_CCTX, I_ADAW, I_ADAB, I_N1G, I_N2G, I_FING, I_EWIN, I_EQG, I_EKG, I_EPW, I_EPS, I_EWOUT, I_OWIN, I_OSINK, I_OWOUT, I_PWQ, I_PK1, I_PK2, I_PU, I_PV, N_IN };

struct Args { const float* in[N_IN]; float* out; unsigned char* ws; int ph_lo, ph_hi; };

struct Frame {
    const float* const* in;
    float* out; unsigned char* ws;
    LAS unsigned char* lds;
    int tid, lane, wave, gw, ngw, gtid, ngt;
};
#define F_mod   ((float*)(F.ws + WS_MOD))
#define F_wqb   ((bf16*)(F.ws + WS_WQB))
#define F_pqbias ((float*)(F.ws + WS_PQAUX))
#define F_gbs   ((bf16*)(F.ws + WS_PQAUX + 131072))
#define F_g2b   ((bf16*)(F.ws + WS_PQAUX + 196608))
#define F_n1b   ((bf16*)(F.ws + WS_PQAUX + 229376))
#define F_ssp   ((float*)(F.ws + WS_SSP))
#define F_xs    ((bf16*)(F.ws + WS_XS))
#define F_winT  ((bf16*)(F.ws + WS_WINT))
#define F_woutT ((bf16*)(F.ws + WS_WOUTT))
#define F_wqT   ((bf16*)(F.ws + WS_WQT))
#define F_keys  ((bf16*)(F.ws + WS_KEYS))
#define F_xn    ((bf16*)(F.ws + WS_XN))
#define F_qkvu  ((bf16*)(F.ws + WS_QKVU))
#define F_mix   ((bf16*)(F.ws + WS_MIX))
#define F_pq    ((bf16*)(F.ws + WS_PQ))
#define F_idx   ((int*)(F.ws + WS_IDX))
#define F_rt    ((u32x2*)(F.ws + WS_IDX))
#define F_gwt   ((float*)(F.ws + WS_GW))
#define F_ust   ((float*)(F.ws + WS_US))
#define F_tabu  ((unsigned char*)(F.ws + WS_TABU))
#define F_tabv  ((unsigned char*)(F.ws + WS_TABV))
#define F_scl   ((float*)(F.ws + WS_SCL))
#define F_part  ((float*)(F.ws + WS_IDX))
#define F_pwT   ((bf16*)(F.ws + WS_KEYS + 131072))

__device__ __forceinline__ float bf2f(unsigned v) { return __uint_as_float(v << 16); }
__device__ __forceinline__ float bflo(unsigned w) { return __uint_as_float(w << 16); }
__device__ __forceinline__ float bfhi(unsigned w) { return __uint_as_float(w & 0xffff0000u); }
__device__ __forceinline__ unsigned f2bf(float f) { unsigned u = __float_as_uint(f); return (u + 0x7fffu + ((u >> 16) & 1u)) >> 16; }
__device__ __forceinline__ unsigned pk2(float lo, float hi) { unsigned r; asm("v_cvt_pk_bf16_f32 %0, %1, %2" : "=v"(r) : "v"(lo), "v"(hi)); return r; }
__device__ __forceinline__ float xrow_sum(float v) {
    { const auto rr = __builtin_amdgcn_permlane16_swap(__float_as_uint(v), __float_as_uint(v), false, false); v = __uint_as_float(rr[0]) + __uint_as_float(rr[1]); }
    { const auto rr = __builtin_amdgcn_permlane32_swap(__float_as_uint(v), __float_as_uint(v), false, false); v = __uint_as_float(rr[0]) + __uint_as_float(rr[1]); }
    return v;
}
__device__ __forceinline__ float wave_max(float v) {
#define ROR_(x, c) __int_as_float(__builtin_amdgcn_update_dpp(0, __float_as_int(x), (c), 0xf, 0xf, true))
    v = fmaxf(v, ROR_(v, 0x128)); v = fmaxf(v, ROR_(v, 0x124)); v = fmaxf(v, ROR_(v, 0x122)); v = fmaxf(v, ROR_(v, 0x121));
#undef ROR_
    { const auto rr = __builtin_amdgcn_permlane16_swap(__float_as_uint(v), __float_as_uint(v), false, false); v = fmaxf(__uint_as_float(rr[0]), __uint_as_float(rr[1])); }
    { const auto rr = __builtin_amdgcn_permlane32_swap(__float_as_uint(v), __float_as_uint(v), false, false); v = fmaxf(__uint_as_float(rr[0]), __uint_as_float(rr[1])); }
    return v;
}
__device__ __forceinline__ int wave_sum_i(int d) {
    d += __builtin_amdgcn_update_dpp(0, d, 0x128, 0xf, 0xf, true); d += __builtin_amdgcn_update_dpp(0, d, 0x124, 0xf, 0xf, true); d += __builtin_amdgcn_update_dpp(0, d, 0x122, 0xf, 0xf, true); d += __builtin_amdgcn_update_dpp(0, d, 0x121, 0xf, 0xf, true);
    { const auto rr = __builtin_amdgcn_permlane16_swap((unsigned)d, (unsigned)d, false, false); d = (int)rr[0] + (int)rr[1]; }
    { const auto rr = __builtin_amdgcn_permlane32_swap((unsigned)d, (unsigned)d, false, false); d = (int)rr[0] + (int)rr[1]; }
    return d;
}
__device__ __forceinline__ float wave_sum(float v) {
#define ROR_(x, c) __int_as_float(__builtin_amdgcn_update_dpp(0, __float_as_int(x), (c), 0xf, 0xf, true))
    v += ROR_(v, 0x128); v += ROR_(v, 0x124); v += ROR_(v, 0x122); v += ROR_(v, 0x121);
#undef ROR_
    return xrow_sum(v);
}
__device__ __forceinline__ void row_info(int r, int& b, int& j) { b = r / RB; j = r - b * RB; }
__device__ __forceinline__ const float* in_row(const Frame& F, int b, int j) { return j < CTXL ? F.in[I_CTX] + (size_t)(b * CTXL + j) * DM : F.in[I_X] + (size_t)(b * SEQ + (j - CTXL)) * DM; }
__device__ __forceinline__ float silu_f(float x) { return x / (1.f + __expf(-x)); }
__device__ __forceinline__ float gelu_erf(float v) {
    const float t = __builtin_amdgcn_rcpf(fabsf(v) * 0.2316418882f + 1.0f);
    float q = t * 0.5307027145f + (-0.7265760135f); q = q * t + 0.7107068705f; q = q * t + (-0.142248368f); q = q * t + 0.127414796f; q = q * t;
    const float m = v * (q * __builtin_amdgcn_exp2f((v * v) * (-0.72134752044f)));
    return v < 0.f ? m : v - m;
}

constexpr int TICKET_OFF = 145408;
__device__ __forceinline__ void ticket_reset(Frame& F) { __syncthreads(); if (F.tid == 0) *(LAS int*)(F.lds + TICKET_OFF) = 0; __syncthreads(); }
__device__ __forceinline__ int ticket_next(Frame& F) { int k = 0; if (F.lane == 0) k = __hip_atomic_fetch_add((LAS int*)(F.lds + TICKET_OFF), 1, __ATOMIC_RELAXED, __HIP_MEMORY_SCOPE_WORKGROUP); return __builtin_amdgcn_readfirstlane(k); }
__device__ __forceinline__ void transpose_item(const float* W, int K, int N, bf16* WT, LAS float* scr, int item, int lane) {
    const int nblk = N / 32, kb = item / nblk, nb = item % nblk, k0 = 64 * kb, n0 = 32 * nb;
    f32x4 t[8];
#pragma unroll
    for (int i = 0; i < 8; ++i) t[i] = *(const f32x4*)(W + (size_t)(k0 + (lane >> 3) + 8 * i) * N + n0 + 4 * (lane & 7));
#pragma unroll
    for (int i = 0; i < 8; ++i) { LAS float* d = scr + ((lane >> 3) + 8 * i) * 33 + 4 * (lane & 7); d[0] = t[i].x; d[1] = t[i].y; d[2] = t[i].z; d[3] = t[i].w; }
    asm volatile("s_waitcnt lgkmcnt(0)" ::: "memory");
    const int c = lane & 7;
#pragma unroll
    for (int j = 0; j < 4; ++j) { const int n = (lane >> 3) + 8 * j; const LAS float* s = scr + (8 * c) * 33 + n;
        u32x4 o; o.x = pk2(s[0 * 33], s[1 * 33]); o.y = pk2(s[2 * 33], s[3 * 33]); o.z = pk2(s[4 * 33], s[5 * 33]); o.w = pk2(s[6 * 33], s[7 * 33]);
        *(u32x4*)(WT + (size_t)(n0 + n) * K + k0 + 8 * c) = o; }
    asm volatile("s_waitcnt lgkmcnt(0)" ::: "memory");
}
__device__ __forceinline__ void cvt_stream(const float* src, bf16* dst, size_t n, size_t gt, size_t ngt) {
    for (size_t i = gt * 8; i < n; i += ngt * 8) { const f32x4 a = *(const f32x4*)(src + i), b = *(const f32x4*)(src + i + 4);
        u32x4 o; o.x = pk2(a.x, a.y); o.y = pk2(a.z, a.w); o.z = pk2(b.x, b.y); o.w = pk2(b.z, b.w); *(u32x4*)(dst + i) = o; }
}
__device__ __forceinline__ void tab_row(Frame& F, int it, const f32x4 (&v)[4]) {
    const int tbl = it / (2 * NEXP), rr = it % (2 * NEXP);
    float ss = 0.f;
#pragma unroll
    for (int q = 0; q < 4; ++q) ss += (v[q].x * v[q].x + v[q].y * v[q].y) + (v[q].z * v[q].z + v[q].w * v[q].w);
    const float step = 0.3352f * sqrtf(wave_sum(ss) * (1.f / DM)), inv = step > 0.f ? 1.f / step : 0.f;
    unsigned nb[16];
#pragma unroll
    for (int q = 0; q < 4; ++q) {
        const int n0 = (int)floorf(v[q].x * inv), n1 = (int)floorf(v[q].y * inv), n2 = (int)floorf(v[q].z * inv), n3 = (int)floorf(v[q].w * inv);
        const int ob = tbl == 1 ? 8 : 0;
        nb[4 * q] = (unsigned)((n0 < -8 ? -8 : n0 > 7 ? 7 : n0) + ob) & 15u; nb[4 * q + 1] = (unsigned)((n1 < -8 ? -8 : n1 > 7 ? 7 : n1) + ob) & 15u; nb[4 * q + 2] = (unsigned)((n2 < -8 ? -8 : n2 > 7 ? 7 : n2) + ob) & 15u; nb[4 * q + 3] = (unsigned)((n3 < -8 ? -8 : n3 > 7 ? 7 : n3) + ob) & 15u; }
    u32x2 o2;
#pragma unroll
    for (int d = 0; d < 2; ++d) { unsigned w = 0;
#pragma unroll
        for (int jj = 0; jj < 4; ++jj) w |= (nb[8 * d + jj] | (nb[8 * d + 4 + jj] << 4)) << (8 * jj);
        o2[d] = w; }
    *(u32x2*)((tbl == 0 ? F_tabu : F_tabv) + (size_t)rr * (DM / 2) + 8 * F.lane) = o2;
    if (F.lane == 0) F_scl[(size_t)rr * 2 + tbl] = step;
}
struct TailSlots { int idle[3], total, rps; };
__device__ __forceinline__ TailSlots tail_slots(int G) {
    TailSlots t; const int nw[3] = {132 * (DIN / 256), 132 * (DM / 256), 132 * (DPQ / 256)}; t.total = 0;
#pragma unroll
    for (int k = 0; k < 3; ++k) { const int rem = nw[k] % G; t.idle[k] = (rem != 0 && nw[k] > G) ? G - rem : 0; t.total += t.idle[k]; }
    t.rps = t.total > 0 ? (((4 * NEXP + t.total - 1) / t.total + 7) / 8) * 8 : 0;
    return t;
}
__device__ __forceinline__ void tables_rows(Frame& F, int r0, int r1) {
    for (int base = r0 + F.wave * 6; base < r1; base += 48) {
        f32x4 v[6][4];
#pragma unroll
        for (int k = 0; k < 6; ++k) { const int it = base + k < r1 ? base + k : r1 - 1; const float* src = F.in[it < 2 * NEXP ? I_PU : I_PV] + (size_t)(it % (2 * NEXP)) * DM + 16 * F.lane;
#pragma unroll
            for (int q = 0; q < 4; ++q) v[k][q] = *(const f32x4*)(src + 4 * q); }
#pragma unroll
        for (int k = 0; k < 6; ++k) if (base + k < r1) tab_row(F, base + k, v[k]);
    }
}
__device__ __forceinline__ void tables_tail(Frame& F, int k) {
    const TailSlots t = tail_slots((int)gridDim.x);
    if (t.total == 0) { if (k == 0) for (int c = blockIdx.x; c < 4 * NEXP / 256; c += gridDim.x) tables_rows(F, c * 256, c * 256 + 256); return; }
    if (t.idle[k] == 0) return;
    const int first_idle = (int)gridDim.x - t.idle[k]; if ((int)blockIdx.x < first_idle) return;
    int s = (int)blockIdx.x - first_idle; for (int j = 0; j < k; ++j) s += t.idle[j];
    const int r0 = s * t.rps, r1 = r0 + t.rps < 4 * NEXP ? r0 + t.rps : 4 * NEXP;
    if (r0 < r1) tables_rows(F, r0, r1);
}
__device__ __forceinline__ void prep_phase(Frame& F) {
    if (F.wave < 3) {
        for (int item = blockIdx.x * 3 + F.wave; item < 768; item += gridDim.x * 3) {
            const int l = item / 384, rem = item % 384, cc = rem / 16, kc = rem % 16, col = cc * 256 + 4 * F.lane, k = kc * 64 + F.lane;
            float sv[5];
#pragma unroll
            for (int m = 0; m < 5; ++m) sv[m] = silu_f(m < 4 ? F.in[I_C][m * DM + k] : F.in[I_CCTX][k]);
            const float* w = F.in[I_ADAW] + ((size_t)l * DM + kc * 64) * MODW + col;
            f32x4 acc[5];
#pragma unroll
            for (int m = 0; m < 5; ++m) acc[m] = (f32x4){0.f, 0.f, 0.f, 0.f};
#pragma unroll 8
            for (int kk = 0; kk < 64; ++kk) { const f32x4 wv = *(const f32x4*)(w + (size_t)kk * MODW);
#pragma unroll
                for (int m = 0; m < 5; ++m) acc[m] += wv * __uint_as_float(__builtin_amdgcn_readlane(__float_as_uint(sv[m]), kk)); }
#pragma unroll
            for (int m = 0; m < 5; ++m) *(f32x4*)(F_part + ((size_t)(kc * 2 + l) * 5 + m) * MODW + col) = acc[m];
        }
    }
    for (int i = F.gtid; i < 4 * 64 * 64; i += F.ngt) { const int g = i >> 12, d = (i >> 6) & 63, c = i & 63; F_pwT[i] = (bf16)f2bf(F.in[I_EPW][(g * 64 + c) * 64 + d]); }
    LAS float* scr = (LAS float*)(F.lds + 32768 + F.wave * 12288);
    constexpr int I_IN = 16 * (DIN / 32), I_OUT = 16 * (DM / 32), I_Q = 16 * (DPQ / 32), I_L = I_IN + I_OUT + I_Q;
    for (int it = F.gw; it < 2 * I_L; it += F.ngw) {
        const int l = it / I_L; int r = it % I_L;
        if (r < I_IN) { transpose_item(l == 0 ? F.in[I_EWIN] : F.in[I_OWIN], DM, DIN, F_winT + (size_t)l * DIN * DM, scr, r, F.lane); continue; } r -= I_IN;
        if (r < I_OUT) { transpose_item(l == 0 ? F.in[I_EWOUT] : F.in[I_OWOUT], DM, DM, F_woutT + (size_t)l * DM * DM, scr, r, F.lane); continue; } r -= I_OUT;
        transpose_item(F.in[I_PWQ] + (size_t)l * DM * DPQ, DM, DPQ, F_wqT + (size_t)l * DPQ * DM, scr, r, F.lane);
    }
    for (int l = 0; l < 2; ++l) { cvt_stream(F.in[I_PK1] + l * 16384, F_keys + (l * 2 + 0) * 16384, 16384, F.gtid, F.ngt); cvt_stream(F.in[I_PK2] + l * 16384, F_keys + (l * 2 + 1) * 16384, 16384, F.gtid, F.ngt); }
}

__device__ __forceinline__ void fold_norm2(Frame& F) {
    for (int it = F.gw; it < 2 * DPQ; it += F.ngw) {
        const int l = it / DPQ, n = it % DPQ; const bf16* wr = F_wqT + ((size_t)l * DPQ + n) * DM; const float* gam = F.in[I_N2G] + l * DM;
        float wg[2][8], w[2][8];
#pragma unroll
        for (int q = 0; q < 2; ++q) { const int c = 8 * F.lane + 512 * q; const u32x4 ww = *(const u32x4*)(wr + c); const f32x4 g0 = *(const f32x4*)(gam + c), g1 = *(const f32x4*)(gam + c + 4);
            w[q][0] = bflo(ww.x); w[q][1] = bfhi(ww.x); w[q][2] = bflo(ww.y); w[q][3] = bfhi(ww.y); w[q][4] = bflo(ww.z); w[q][5] = bfhi(ww.z); w[q][6] = bflo(ww.w); w[q][7] = bfhi(ww.w);
#pragma unroll
            for (int k = 0; k < 4; ++k) { wg[q][k] = w[q][k] * g0[k]; wg[q][4 + k] = w[q][4 + k] * g1[k]; } }
#pragma unroll
        for (int m = 0; m < 5; ++m) { const float* sh = F_mod + ((size_t)l * 5 + m) * MODW + 3 * DM; const float* sc = sh + DM; float bs = 0.f;
#pragma unroll
            for (int q = 0; q < 2; ++q) { const int c = 8 * F.lane + 512 * q; const f32x4 s0a = *(const f32x4*)(sh + c), s0b = *(const f32x4*)(sh + c + 4), s1a = *(const f32x4*)(sc + c) + 1.f, s1b = *(const f32x4*)(sc + c + 4) + 1.f;
                u32x4 o; o.x = pk2(wg[q][0] * s1a[0], wg[q][1] * s1a[1]); o.y = pk2(wg[q][2] * s1a[2], wg[q][3] * s1a[3]); o.z = pk2(wg[q][4] * s1b[0], wg[q][5] * s1b[1]); o.w = pk2(wg[q][6] * s1b[2], wg[q][7] * s1b[3]);
                *(u32x4*)(F_wqb + (((size_t)l * 5 + m) * DPQ + n) * DM + c) = o;
#pragma unroll
                for (int k = 0; k < 4; ++k) bs += w[q][k] * s0a[k] + w[q][4 + k] * s0b[k]; }
            bs = wave_sum(bs);
            if (F.lane == 0) F_pqbias[((size_t)l * 5 + m) * DPQ + n] = bs; }
    }
    for (int i = F.gtid; i < 2 * 5 * (DM / 8); i += F.ngt) {
        const int lm = i / (DM / 8), c = (i % (DM / 8)) * 8, l = lm / 5; const float* gam = F.in[I_N2G] + l * DM + c; const float* sh = F_mod + (size_t)lm * MODW + 3 * DM + c; const float* sc = sh + DM;
        const f32x4 g0 = *(const f32x4*)gam, g1 = *(const f32x4*)(gam + 4), a0 = *(const f32x4*)sc + 1.f, a1 = *(const f32x4*)(sc + 4) + 1.f, h0 = *(const f32x4*)sh, h1 = *(const f32x4*)(sh + 4);
        u32x4 og, oh; og.x = pk2(g0[0] * a0[0], g0[1] * a0[1]); og.y = pk2(g0[2] * a0[2], g0[3] * a0[3]); og.z = pk2(g1[0] * a1[0], g1[1] * a1[1]); og.w = pk2(g1[2] * a1[2], g1[3] * a1[3]);
        oh.x = pk2(h0[0], h0[1]); oh.y = pk2(h0[2], h0[3]); oh.z = pk2(h1[0], h1[1]); oh.w = pk2(h1[2], h1[3]);
        *(u32x4*)(F_gbs + (size_t)lm * 2 * DM + c) = og; *(u32x4*)(F_gbs + (size_t)lm * 2 * DM + DM + c) = oh;
        { const float* gt = F_mod + (size_t)lm * MODW + 5 * DM + c; const f32x4 t0 = *(const f32x4*)gt, t1 = *(const f32x4*)(gt + 4);
          u32x4 o; o.x = pk2(t0[0], t0[1]); o.y = pk2(t0[2], t0[3]); o.z = pk2(t1[0], t1[1]); o.w = pk2(t1[2], t1[3]); *(u32x4*)(F_g2b + (size_t)lm * DM + c) = o; }
        if (l == 1) { const int m = lm - 5; const float* g1 = F.in[I_N1G] + DM + c; const float* s0 = F_mod + (size_t)lm * MODW + c; const float* s1 = s0 + DM;
          const f32x4 p0 = *(const f32x4*)g1 * (*(const f32x4*)s1 + 1.f), p1 = *(const f32x4*)(g1 + 4) * (*(const f32x4*)(s1 + 4) + 1.f), q0 = *(const f32x4*)s0, q1 = *(const f32x4*)(s0 + 4);
          u32x4 o; o.x = pk2(p0[0], p0[1]); o.y = pk2(p0[2], p0[3]); o.z = pk2(p1[0], p1[1]); o.w = pk2(p1[2], p1[3]); *(u32x4*)(F_n1b + (size_t)m * 2 * DM + c) = o;
          o.x = pk2(q0[0], q0[1]); o.y = pk2(q0[2], q0[3]); o.z = pk2(q1[0], q1[1]); o.w = pk2(q1[2], q1[3]); *(u32x4*)(F_n1b + (size_t)m * 2 * DM + DM + c) = o; } }
}

template <int WHICH> __device__ __forceinline__ void norm_phase(Frame& F, int layer, bool from_input, bool skip_ctx, bool finalize_mod) {
    const float* gam = F.in[WHICH == 0 ? I_N1G : I_N2G] + layer * DM;
    LAS float* lmod = (LAS float*)F.lds;
    if (finalize_mod) {
        for (int i = F.tid * 4; i < 5 * 2048; i += NTHR * 4) { const int m = i >> 11, c = i & 2047; f32x4 a = *(const f32x4*)(F.in[I_ADAB] + c);
#pragma unroll
            for (int kc = 0; kc < 16; ++kc) a += *(const f32x4*)(F_part + ((size_t)(kc * 2) * 5 + m) * MODW + c);
            *(LAS f32x4*)(lmod + i) = a; }
        for (int o = F.gtid * 4; o < 2 * 5 * MODW; o += F.ngt * 4) { const int l = o / (5 * MODW), rem = o % (5 * MODW); f32x4 a = *(const f32x4*)(F.in[I_ADAB] + l * MODW + rem % MODW);
#pragma unroll
            for (int kc = 0; kc < 16; ++kc) a += *(const f32x4*)(F_part + (size_t)(kc * 2 + l) * 5 * MODW + rem);
            *(f32x4*)(F_mod + o) = a; }
        __syncthreads();
    }
    f32x4 gin[2][2] = {};
    if (from_input) {
#pragma unroll
        for (int q = 0; q < 2; ++q)
#pragma unroll
            for (int h = 0; h < 2; ++h) gin[q][h] = *(const f32x4*)(gam + 8 * F.lane + 512 * q + 4 * h); }
    if (from_input && finalize_mod && !skip_ctx) {
        ticket_reset(F);
        int r = (int)blockIdx.x + ticket_next(F) * (int)gridDim.x; f32x4 v[2][2] = {};
        if (r < NR) { int b, j; row_info(r, b, j); const float* xr = in_row(F, b, j);
#pragma unroll
            for (int q = 0; q < 2; ++q)
#pragma unroll
                for (int h = 0; h < 2; ++h) v[q][h] = *(const f32x4*)(xr + 8 * F.lane + 512 * q + 4 * h); }
        while (r < NR) {
            const int rn = (int)blockIdx.x + ticket_next(F) * (int)gridDim.x; f32x4 vn[2][2] = {};
            if (rn < NR) { int bn, jn; row_info(rn, bn, jn); const float* xr = in_row(F, bn, jn);
#pragma unroll
                for (int q = 0; q < 2; ++q)
#pragma unroll
                    for (int h = 0; h < 2; ++h) vn[q][h] = *(const f32x4*)(xr + 8 * F.lane + 512 * q + 4 * h); }
            int b, j; row_info(r, b, j); const int mi = j < CTXL ? 4 : b; bf16* orow = F_xn + (size_t)r * DM; float ss = 0.f;
#pragma unroll
            for (int q = 0; q < 2; ++q)
#pragma unroll
                for (int h = 0; h < 2; ++h) ss += (v[q][h].x * v[q][h].x + v[q][h].y * v[q][h].y) + (v[q][h].z * v[q][h].z + v[q][h].w * v[q][h].w);
            const float rstd = rsqrtf(wave_sum(ss) * (1.f / DM) + EPS);
#pragma unroll
            for (int q = 0; q < 2; ++q) { u32x4 o;
#pragma unroll
                for (int h = 0; h < 2; ++h) { const int c = 8 * F.lane + 512 * q + 4 * h; const f32x4 s0 = *(const LAS f32x4*)(lmod + mi * 2048 + c), s1 = *(const LAS f32x4*)(lmod + mi * 2048 + DM + c);
                    const f32x4 y = (v[q][h] * rstd * gin[q][h]) * (s1 + 1.f) + s0; o[2 * h] = pk2(y.x, y.y); o[2 * h + 1] = pk2(y.z, y.w); }
                *(u32x4*)(orow + 8 * F.lane + 512 * q) = o; }
            r = rn;
#pragma unroll
            for (int q = 0; q < 2; ++q)
#pragma unroll
                for (int h = 0; h < 2; ++h) v[q][h] = vn[q][h];
        }
        return;
    }
    ticket_reset(F);
    for (;;) {
        const int r = (int)blockIdx.x + ticket_next(F) * (int)gridDim.x; if (r >= NR) break;
        int b, j; row_info(r, b, j); if (skip_ctx && j < CTXL) continue;
        const int mi = j < CTXL ? 4 : b;
        const float* sh = F_mod + ((size_t)layer * 5 + mi) * MODW + (WHICH ? 3 * DM : 0); const float* sc = sh + DM;
        bf16* orow = F_xn + (size_t)r * DM;
        if (from_input) {
            const float* xr = in_row(F, b, j);
            f32x4 v[2][2]; float ss = 0.f;
#pragma unroll
            for (int q = 0; q < 2; ++q)
#pragma unroll
                for (int h = 0; h < 2; ++h) { v[q][h] = *(const f32x4*)(xr + 8 * F.lane + 512 * q + 4 * h); ss += (v[q][h].x * v[q][h].x + v[q][h].y * v[q][h].y) + (v[q][h].z * v[q][h].z + v[q][h].w * v[q][h].w); }
            const float rstd = rsqrtf(wave_sum(ss) * (1.f / DM) + EPS);
#pragma unroll
            for (int q = 0; q < 2; ++q) { u32x4 o;
#pragma unroll
                for (int h = 0; h < 2; ++h) { const int c = 8 * F.lane + 512 * q + 4 * h; f32x4 s1, s0;
                    if (finalize_mod) { s0 = *(const LAS f32x4*)(lmod + mi * 2048 + c); s1 = *(const LAS f32x4*)(lmod + mi * 2048 + DM + c); }
                    else { s1 = *(const f32x4*)(sc + c); s0 = *(const f32x4*)(sh + c); }
                    const f32x4 y = (v[q][h] * rstd * gin[q][h]) * (s1 + 1.f) + s0; o[2 * h] = pk2(y.x, y.y); o[2 * h + 1] = pk2(y.z, y.w); }
                *(u32x4*)(orow + 8 * F.lane + 512 * q) = o; }
        } else {
            const bf16* xr = F_xs + (size_t)r * DM;
            float v[2][8]; float ss = 0.f;
#pragma unroll
            for (int q = 0; q < 2; ++q) { const u32x4 w = *(const u32x4*)(xr + 8 * F.lane + 512 * q);
                v[q][0] = bflo(w.x); v[q][1] = bfhi(w.x); v[q][2] = bflo(w.y); v[q][3] = bfhi(w.y); v[q][4] = bflo(w.z); v[q][5] = bfhi(w.z); v[q][6] = bflo(w.w); v[q][7] = bfhi(w.w);
#pragma unroll
                for (int k = 0; k < 8; ++k) ss += v[q][k] * v[q][k]; }
            const float rstd = rsqrtf(wave_sum(ss) * (1.f / DM) + EPS);
#pragma unroll
            for (int q = 0; q < 2; ++q) { const int c = 8 * F.lane + 512 * q; u32x4 o;
#pragma unroll
                for (int hh = 0; hh < 2; ++hh) { const f32x4 g = *(const f32x4*)(gam + c + 4 * hh), s1 = *(const f32x4*)(sc + c + 4 * hh), s0 = *(const f32x4*)(sh + c + 4 * hh);
                    const f32x4 x4 = (f32x4){v[q][4 * hh], v[q][4 * hh + 1], v[q][4 * hh + 2], v[q][4 * hh + 3]}; const f32x4 y = (x4 * rstd * g) * (s1 + 1.f) + s0;
                    o[2 * hh] = pk2(y.x, y.y); o[2 * hh + 1] = pk2(y.z, y.w); }
                *(u32x4*)(orow + c) = o; }
        }
    }
}

__device__ __forceinline__ void khead_finish(bf16* p, const float* g, int t) {
    float x[64];
#pragma unroll
    for (int c = 0; c < 8; ++c) { const u32x4 w = *(const u32x4*)(p + 8 * c); x[8 * c] = bflo(w.x); x[8 * c + 1] = bfhi(w.x); x[8 * c + 2] = bflo(w.y); x[8 * c + 3] = bfhi(w.y); x[8 * c + 4] = bflo(w.z); x[8 * c + 5] = bfhi(w.z); x[8 * c + 6] = bflo(w.w); x[8 * c + 7] = bfhi(w.w); }
    if (g) { float ss = 0.f;
#pragma unroll
        for (int c = 0; c < 64; ++c) ss += x[c] * x[c];
        const float rs = rsqrtf(ss * (1.f / 64.f) + EPS);
#pragma unroll
        for (int c = 0; c < 64; ++c) x[c] = x[c] * rs * g[c]; }
    if (t >= 0) { const float pr = (float)(t >> 6), pc = (float)(t & 63);
#pragma unroll
        for (int c = 0; c < 16; ++c) {
            const float inv = exp2f(-(float)c * (13.287712379549449f / 16.f)) * 0.15915494309189535f;
            float rr = pr * inv, rc = pc * inv; rr -= floorf(rr); rc -= floorf(rc);
            const float sr = __builtin_amdgcn_sinf(rr), cr = __builtin_amdgcn_cosf(rr), sc_ = __builtin_amdgcn_sinf(rc), cc = __builtin_amdgcn_cosf(rc);
            const float a1 = x[c], a2 = x[16 + c]; x[c] = a1 * cr - a2 * sr; x[16 + c] = a1 * sr + a2 * cr;
            const float b1 = x[32 + c], b2 = x[48 + c]; x[32 + c] = b1 * cc - b2 * sc_; x[48 + c] = b1 * sc_ + b2 * cc; } }
#pragma unroll
    for (int c = 0; c < 8; ++c) { u32x4 w; w.x = pk2(x[8 * c], x[8 * c + 1]); w.y = pk2(x[8 * c + 2], x[8 * c + 3]); w.z = pk2(x[8 * c + 4], x[8 * c + 5]); w.w = pk2(x[8 * c + 6], x[8 * c + 7]); *(u32x4*)(p + 8 * c) = w; }
}
namespace pg8 {
#define PG8_LAS __attribute__((address_space(3)))
typedef unsigned short bf16_t;
constexpr int BM = 256, BK = 64, HALF = 128, HTB = HALF * BK * 2, STAGE_BYTES = 8 * HTB, NXCD = 8, WGM = 8;
__host__ __device__ __forceinline__ int lds_byte(int r, int c) { const int st = (r >> 4) * 2 + (c >> 5), rr = r & 15, cc = c & 31, ob = rr * 64 + cc * 2; return st * 1024 + (ob ^ (((ob >> 9) & 1) << 5)); }
__host__ __device__ __forceinline__ void stage_rc(int b, int& R, int& C) { const int st = b / 1024, sb = b % 1024, swz = sb ^ (((sb >> 9) & 1) << 5); R = (st >> 1) * 16 + swz / 64; C = (st & 1) * 32 + (swz % 64) / 2; }
__host__ __device__ __forceinline__ int perm32(int rho) { const int n = rho >> 4, i = rho & 15; return 8 * (i >> 2) + 4 * n + (i & 3); }
struct Unit { int pm, pn; };
struct Gemm { const bf16_t* A; const bf16_t* Bt; int M, N, K; size_t bstride; };
__device__ __forceinline__ size_t bvar(const Gemm& g, int pm) { return g.bstride ? (size_t)(pm % 33 == 0 ? 4 : pm / 33) * g.bstride : (size_t)0; }
struct Order {
    int nM, nN, nwg, G, c, skip; bf16_t* kfix; const float* kg;
    __device__ void init(int nM_, int N, int G_, int c_, int skip_) { nM = nM_; nN = N / BM; nwg = nM * nN; G = G_; c = c_; skip = skip_; kfix = nullptr; kg = nullptr; }
    __device__ bool next(int i, Unit& u) const {
        const long L = (long)i * G + c; if (L >= nwg) return false;
        int wgid = (int)L; { const int q = nwg / NXCD, r = nwg % NXCD, xcd = wgid % NXCD, off = wgid / NXCD; wgid = (xcd < r ? xcd * (q + 1) : r * (q + 1) + (xcd - r) * q) + off; }
        const int nig = WGM * nN, gid = wgid / nig, fm = gid * WGM, gsz = (nM - fm) < WGM ? (nM - fm) : WGM;
        u.pm = fm + ((wgid % nig) % gsz); u.pn = (wgid % nig) / gsz;
        if (skip) u.pm += u.pm / 32 + 1;
        return true;
    }
    __device__ __forceinline__ void a_ready(const Unit&) const {}
    __device__ __forceinline__ void done(const Unit& u) const {
        if (kfix == nullptr || u.pn != 4) return;
        asm volatile("s_waitcnt vmcnt(0)" ::: "memory"); __builtin_amdgcn_s_barrier(); asm volatile("" ::: "memory");
        const int jt = u.pm % 33;
#pragma unroll 1
        for (int it = threadIdx.x; it < 1024; it += 512) { const int rl = it >> 2, hh = it & 3; khead_finish(kfix + (size_t)(u.pm * BM + rl) * DIN + 1024 + hh * 64, kg, jt == 0 ? -1 : (jt - 1) * 256 + rl); }
    }
};
__device__ __forceinline__ unsigned cvt_pk_bf16(float lo, float hi) { unsigned r; asm volatile("v_cvt_pk_bf16_f32 %0, %1, %2" : "=v"(r) : "v"(lo), "v"(hi)); return r; }
__device__ __forceinline__ void line_pair(const u32x4& w0, const u32x4& w1, u32x4& lo8, u32x4& hi8) {
#pragma unroll
    for (int k = 0; k < 4; ++k) { lo8[k] = (unsigned)__builtin_amdgcn_update_dpp((int)w0[k], (int)w1[k], 0x128, 0xf, 0xc, false);
                                  hi8[k] = (unsigned)__builtin_amdgcn_update_dpp((int)w1[k], (int)w0[k], 0x128, 0xf, 0x3, false); }
}
struct EpiBf16 {
    static constexpr bool PERM = true, AFTER_DRAIN = false;
    bf16_t* O; int ldc;
    __device__ __forceinline__ void operator()(const f32x4 (&acc)[2][2][4][2], const Unit& u, int wr, int wc, int fr, int fq) const {
        const int rowA = u.pm * BM + wr * 64 + (fr & 7), colx = u.pn * BM + wc * 64 + 32 * (fr >> 3) + 8 * fq;
#pragma unroll
        for (int ai = 0; ai < 2; ++ai)
#pragma unroll
            for (int m = 0; m < 4; ++m) { u32x4 w[2];
#pragma unroll
                for (int bj = 0; bj < 2; ++bj) { const f32x4 v0 = acc[ai][bj][m][0], v1 = acc[ai][bj][m][1];
                    w[bj].x = cvt_pk_bf16(v0[0], v0[1]); w[bj].y = cvt_pk_bf16(v0[2], v0[3]); w[bj].z = cvt_pk_bf16(v1[0], v1[1]); w[bj].w = cvt_pk_bf16(v1[2], v1[3]); }
                u32x4 lo8, hi8; line_pair(w[0], w[1], lo8, hi8);
                bf16_t* rowp = O + (size_t)(rowA + ai * HALF + m * 16) * ldc + colx;
                *(u32x4*)rowp = lo8; *(u32x4*)(rowp + (size_t)8 * ldc) = hi8; }
    }
};
template <bool FROM_INPUT> struct EpiResid16T {
    static constexpr bool PERM = true, AFTER_DRAIN = false;
    const float* x_in; const float* ctx_in; bf16_t* xs; const float* gate; float* ssp;
    __device__ __forceinline__ void operator()(const f32x4 (&acc)[2][2][4][2], const Unit& u, int wr, int wc, int fr, int fq) const {
        const int b = u.pm / 33, jt = u.pm - b * 33; const bool isc = jt == 0;
        const float* g = gate + (size_t)(isc ? 4 : b) * MODW; const int col0 = u.pn * BM + wc * 64 + 8 * fq;
        const float* srcb = isc ? ctx_in + (size_t)b * CTXL * DM : x_in + ((size_t)b * SEQ + (size_t)(jt - 1) * 256) * DM;
        f32x4 gv[2][2];
#pragma unroll
        for (int bj = 0; bj < 2; ++bj)
#pragma unroll
            for (int n = 0; n < 2; ++n) gv[bj][n] = *(const f32x4*)(g + col0 + bj * 32 + 4 * n);
        f32x4 nf[2][2]; u32x4 nw[2];
#define RESID_LOAD(blk) do { const int _rl = ((blk) >> 2) * HALF + wr * 64 + ((blk) & 3) * 16 + fr; \
            if (FROM_INPUT) { const float* _sp = srcb + (size_t)_rl * DM + col0; nf[0][0] = *(const f32x4*)_sp; nf[0][1] = *(const f32x4*)(_sp + 4); nf[1][0] = *(const f32x4*)(_sp + 32); nf[1][1] = *(const f32x4*)(_sp + 36); } \
            else { const bf16_t* _xp = xs + ((size_t)u.pm * BM + _rl) * DM + col0; nw[0] = *(const u32x4*)_xp; nw[1] = *(const u32x4*)(_xp + 32); } } while (0)
        RESID_LOAD(0);
#pragma unroll
        for (int blk = 0; blk < 8; ++blk) { const int ai = blk >> 2, m = blk & 3; float ssq = 0.f; u32x4 ow[2];
            f32x4 cf[2][2]; u32x4 cw[2];
#pragma unroll
            for (int bj = 0; bj < 2; ++bj) { cf[bj][0] = nf[bj][0]; cf[bj][1] = nf[bj][1]; cw[bj] = nw[bj]; }
            if (blk < 7) RESID_LOAD(blk + 1);
#pragma unroll
            for (int bj = 0; bj < 2; ++bj) { f32x4 b0, b1;
                if (FROM_INPUT) { b0 = cf[bj][0]; b1 = cf[bj][1]; }
                else { const u32x4 w = cw[bj]; b0 = (f32x4){__uint_as_float(w.x << 16), __uint_as_float(w.x & 0xffff0000u), __uint_as_float(w.y << 16), __uint_as_float(w.y & 0xffff0000u)};
                    b1 = (f32x4){__uint_as_float(w.z << 16), __uint_as_float(w.z & 0xffff0000u), __uint_as_float(w.w << 16), __uint_as_float(w.w & 0xffff0000u)}; }
                const f32x4 v0 = b0 + gv[bj][0] * acc[ai][bj][m][0], v1 = b1 + gv[bj][1] * acc[ai][bj][m][1];
                u32x4 o; o.x = cvt_pk_bf16(v0[0], v0[1]); o.y = cvt_pk_bf16(v0[2], v0[3]); o.z = cvt_pk_bf16(v1[0], v1[1]); o.w = cvt_pk_bf16(v1[2], v1[3]);
                ow[bj] = o;
                const f32x4 r0 = (f32x4){__uint_as_float(o.x << 16), __uint_as_float(o.x & 0xffff0000u), __uint_as_float(o.y << 16), __uint_as_float(o.y & 0xffff0000u)}, r1 = (f32x4){__uint_as_float(o.z << 16), __uint_as_float(o.z & 0xffff0000u), __uint_as_float(o.w << 16), __uint_as_float(o.w & 0xffff0000u)};
                ssq += ((r0[0] * r0[0] + r0[1] * r0[1]) + (r0[2] * r0[2] + r0[3] * r0[3])) + ((r1[0] * r1[0] + r1[1] * r1[1]) + (r1[2] * r1[2] + r1[3] * r1[3])); }
            { u32x4 lo8, hi8; line_pair(ow[0], ow[1], lo8, hi8);
              bf16_t* sp8 = xs + ((size_t)u.pm * BM + ai * HALF + wr * 64 + m * 16 + (fr & 7)) * DM + col0 + 32 * (fr >> 3); *(u32x4*)sp8 = lo8; *(u32x4*)(sp8 + (size_t)8 * DM) = hi8; }
            ssq = xrow_sum(ssq);
            if (fq == 0) *(float*)((char*)ssp + ((unsigned)(((u.pm * BM + wr * 64 + fr) * 16 + 4 * u.pn + wc) * 4) + (unsigned)((ai * HALF + m * 16) * 64))) = ssq; }
#undef RESID_LOAD
    }
};
struct EpiPQ {
    static constexpr bool PERM = true, AFTER_DRAIN = false;
    bf16_t* O; int ldc; const float* ssp; const float* bias; PG8_LAS float* rl;
    __device__ __forceinline__ void operator()(const f32x4 (&acc)[2][2][4][2], const Unit& u, int wr, int wc, int fr, int fq) const {
        const int b = u.pm / 33, jt = u.pm - b * 33; const float* bb = bias + (size_t)(jt == 0 ? 4 : b) * 2048 + u.pn * BM + wc * 64 + 8 * fq;
        const int tid = threadIdx.x;
        if (tid < BM) { const float* sp = ssp + ((size_t)u.pm * BM + tid) * 16;
            const f32x4 s0 = *(const f32x4*)sp, s1 = *(const f32x4*)(sp + 4), s2 = *(const f32x4*)(sp + 8), s3 = *(const f32x4*)(sp + 12);
            const float ss = (((s0[0] + s0[1]) + (s0[2] + s0[3])) + ((s1[0] + s1[1]) + (s1[2] + s1[3]))) + (((s2[0] + s2[1]) + (s2[2] + s2[3])) + ((s3[0] + s3[1]) + (s3[2] + s3[3])));
            rl[tid] = rsqrtf(ss * (1.f / DM) + EPS); }
        f32x4 bv[2][2];
#pragma unroll
        for (int bj = 0; bj < 2; ++bj) { bv[bj][0] = *(const f32x4*)(bb + bj * 32); bv[bj][1] = *(const f32x4*)(bb + bj * 32 + 4); }
        asm volatile("s_waitcnt lgkmcnt(0)" ::: "memory"); __builtin_amdgcn_s_barrier(); asm volatile("" ::: "memory");
        const int rowA = u.pm * BM + wr * 64 + (fr & 7), colx = u.pn * BM + wc * 64 + 32 * (fr >> 3) + 8 * fq;
#pragma unroll
        for (int ai = 0; ai < 2; ++ai)
#pragma unroll
            for (int m = 0; m < 4; ++m) { const int rloc = wr * 64 + fr + ai * HALF + m * 16; const float rstd = rl[rloc]; bf16_t* rowp = O + (size_t)(rowA + ai * HALF + m * 16) * ldc + colx; u32x4 ww[2];
#pragma unroll
                for (int bj = 0; bj < 2; ++bj) { const f32x4 v0 = acc[ai][bj][m][0] * rstd + bv[bj][0], v1 = acc[ai][bj][m][1] * rstd + bv[bj][1];
                    u32x4 w; w.x = cvt_pk_bf16(v0[0], v0[1]); w.y = cvt_pk_bf16(v0[2], v0[3]); w.z = cvt_pk_bf16(v1[0], v1[1]); w.w = cvt_pk_bf16(v1[2], v1[3]);
                    ww[bj] = w; }
                u32x4 lo8, hi8; line_pair(ww[0], ww[1], lo8, hi8); *(u32x4*)rowp = lo8; *(u32x4*)(rowp + (size_t)8 * ldc) = hi8; }
    }
};
template <class Epi, class Sched, bool ALIGN_EPI = false, bool SP2 = false>
__device__ __forceinline__ void gemm_phase(PG8_LAS unsigned char* lds, const Gemm g, const Sched& S, const Epi& E) {
    const int tid = threadIdx.x, wid = __builtin_amdgcn_readfirstlane(tid >> 6), lane = tid & 63, wr = wid >> 2, wc = wid & 3, fr = lane & 15, fq = lane >> 4;
    const int K = g.K, nt = K / BK;
    unsigned voffA[2], voffB[2];
#pragma unroll
    for (int i = 0; i < 2; ++i) { int R, C; stage_rc(tid * 16 + i * 8192, R, C); const int Rb = Epi::PERM ? (64 * (R >> 5) + perm32(R & 31)) : R;
        voffA[i] = (unsigned)(R * K + C) * 2u; voffB[i] = (unsigned)(Rb * K + C) * 2u; }
    const size_t kstep = (size_t)(BK * 2);
    const size_t hstep = (size_t)HALF * K * 2;
    const size_t tstep = 2 * hstep;
    const size_t hstepB = Epi::PERM ? (size_t)32 * K * 2 : hstep;
    const unsigned ldsw = (unsigned)wid * 1024u;
    const int aoff = lds_byte(wr * 64 + fr, fq * 8), boff = lds_byte(wc * 32 + fr, fq * 8);
#define PG8_SA(b, h) (((b) * 2 + (h)) * HTB)
#define PG8_SB(b, h) ((4 + (b) * 2 + (h)) * HTB)
#define PG8_STAGE(bufoff, gbase, voff) do { _Pragma("unroll") for (int _i = 0; _i < 2; ++_i) \
        __builtin_amdgcn_global_load_lds((const unsigned*)((const char*)(gbase) + (voff)[_i]), (PG8_LAS unsigned*)(lds + (bufoff) + ldsw + _i * 8192), 16, 0, 0); } while (0)
#define PG8_LDA(dst, b, h) do { _Pragma("unroll") for (int m = 0; m < 4; ++m) _Pragma("unroll") for (int k = 0; k < 2; ++k) dst[m][k] = *(const PG8_LAS bf16x8*)(lds + PG8_SA(b, h) + aoff + m * 2048 + k * 1024); } while (0)
#define PG8_LDB(dst, b, h) do { _Pragma("unroll") for (int n = 0; n < 2; ++n) _Pragma("unroll") for (int k = 0; k < 2; ++k) dst[n][k] = *(const PG8_LAS bf16x8*)(lds + PG8_SB(b, h) + boff + n * 2048 + k * 1024); } while (0)
#define PG8_MMA(ai, bj, At, Bt) do { __builtin_amdgcn_s_setprio(1); _Pragma("unroll") for (int m = 0; m < 4; ++m) _Pragma("unroll") for (int n = 0; n < 2; ++n) _Pragma("unroll") for (int k = 0; k < 2; ++k) \
        acc[ai][bj][m][n] = __builtin_amdgcn_mfma_f32_16x16x32_bf16(Bt[n][k], At[m][k], acc[ai][bj][m][n], 0, 0, 0); __builtin_amdgcn_s_setprio(0); } while (0)
#define PG8_WAIT_V(n) asm volatile("s_waitcnt vmcnt(" #n ")" ::: "memory")
#define PG8_WAIT_L(n) asm volatile("s_waitcnt lgkmcnt(" #n ")" ::: "memory")
#define PG8_BAR __builtin_amdgcn_s_barrier()
#define PG8_SCHED __builtin_amdgcn_sched_barrier(0)
    Unit cur, nxt; int ui = 0;
    if (!S.next(0, cur)) return;
    f32x4 acc[2][2][4][2];
#pragma unroll
    for (int a = 0; a < 2; ++a)
#pragma unroll
        for (int b = 0; b < 2; ++b)
#pragma unroll
            for (int m = 0; m < 4; ++m)
#pragma unroll
                for (int n = 0; n < 2; ++n) acc[a][b][m][n] = (f32x4){0.f, 0.f, 0.f, 0.f};
    bf16x8 At[4][2], B0[2][2], B1[2][2];
    const char* cA = (const char*)g.A + (size_t)cur.pm * tstep; const char* cB = (const char*)g.Bt + (size_t)cur.pn * tstep + bvar(g, cur.pm);
    S.a_ready(cur);
    if constexpr (SP2) {
        PG8_STAGE(PG8_SB(0, 0), cB, voffB); PG8_STAGE(PG8_SB(0, 1), cB + hstepB, voffB); PG8_STAGE(PG8_SA(0, 0), cA, voffA); PG8_STAGE(PG8_SA(0, 1), cA + hstep, voffA);
        if (wr == 1) PG8_BAR;
        PG8_WAIT_V(2); PG8_BAR;
        PG8_STAGE(PG8_SB(1, 0), cB + kstep, voffB); PG8_STAGE(PG8_SA(1, 0), cA + kstep, voffA); PG8_STAGE(PG8_SB(1, 1), cB + hstepB + kstep, voffB);
        PG8_WAIT_V(6); PG8_BAR;
    } else {
        PG8_STAGE(PG8_SB(0, 0), cB, voffB); PG8_STAGE(PG8_SA(0, 0), cA, voffA); PG8_STAGE(PG8_SB(0, 1), cB + hstepB, voffB); PG8_STAGE(PG8_SA(0, 1), cA + hstep, voffA);
        if (wr == 1) PG8_BAR;
        PG8_WAIT_V(4); PG8_BAR;
        PG8_STAGE(PG8_SB(1, 0), cB + kstep, voffB); PG8_STAGE(PG8_SA(1, 0), cA + kstep, voffA); PG8_STAGE(PG8_SB(1, 1), cB + hstepB + kstep, voffB);
        PG8_WAIT_V(6); PG8_BAR;
    }
    for (;;) {
        const bool has_next = S.next(ui + 1, nxt);
        const char* nA = has_next ? (const char*)g.A + (size_t)nxt.pm * tstep : cA; const char* nB = has_next ? (const char*)g.Bt + (size_t)nxt.pn * tstep + bvar(g, nxt.pm) : cB;
        for (int t = 0; t < nt; t += 2) {
            const bool last = (t == nt - 2);
            const char* a1 = cA + (size_t)(t + 1) * kstep;
            const char* a2 = last ? nA : cA + (size_t)(t + 2) * kstep; const char* b2 = last ? nB : cB + (size_t)(t + 2) * kstep;
            const char* a3 = a2 + kstep; const char* b3 = b2 + kstep;
            if (last && has_next) S.a_ready(nxt);
            if constexpr (SP2) {
            PG8_LDB(B0, 0, 0); PG8_LDB(B1, 0, 1); PG8_SCHED; PG8_LDA(At, 0, 0); PG8_STAGE(PG8_SA(1, 1), a1 + hstep, voffA);
            PG8_WAIT_V(8); PG8_WAIT_L(0); PG8_BAR; PG8_MMA(0, 0, At, B0); PG8_MMA(0, 1, At, B1); PG8_BAR; PG8_SCHED;
            PG8_LDA(At, 0, 1); PG8_STAGE(PG8_SB(0, 0), b2, voffB); PG8_STAGE(PG8_SB(0, 1), b2 + hstepB, voffB); PG8_STAGE(PG8_SA(0, 0), a2, voffA);
            PG8_WAIT_V(8); PG8_WAIT_L(0); PG8_BAR; PG8_MMA(1, 0, At, B0); PG8_MMA(1, 1, At, B1); PG8_BAR; PG8_SCHED;
            PG8_LDB(B0, 1, 0); PG8_LDB(B1, 1, 1); PG8_SCHED; PG8_LDA(At, 1, 0); PG8_STAGE(PG8_SA(0, 1), a2 + hstep, voffA);
            PG8_WAIT_V(8); PG8_WAIT_L(0); PG8_BAR; PG8_MMA(0, 0, At, B0); PG8_MMA(0, 1, At, B1); PG8_BAR; PG8_SCHED;
            PG8_LDA(At, 1, 1); PG8_STAGE(PG8_SB(1, 0), b3, voffB); PG8_STAGE(PG8_SB(1, 1), b3 + hstepB, voffB); PG8_STAGE(PG8_SA(1, 0), a3, voffA);
            PG8_WAIT_V(8); PG8_WAIT_L(0); PG8_BAR; PG8_MMA(1, 0, At, B0); PG8_MMA(1, 1, At, B1); PG8_BAR; PG8_SCHED;
            } else {
            PG8_LDB(B0, 0, 0); PG8_SCHED; PG8_LDA(At, 0, 0); PG8_STAGE(PG8_SA(1, 1), a1 + hstep, voffA);
            PG8_WAIT_L(8); PG8_BAR; PG8_WAIT_L(0); PG8_MMA(0, 0, At, B0); PG8_BAR; PG8_SCHED;
            PG8_LDB(B1, 0, 1); PG8_STAGE(PG8_SB(0, 0), b2, voffB);
            PG8_BAR; PG8_WAIT_L(0); PG8_MMA(0, 1, At, B1); PG8_BAR;
            PG8_LDA(At, 0, 1); PG8_STAGE(PG8_SA(0, 0), a2, voffA);
            PG8_BAR; PG8_WAIT_L(0); PG8_MMA(1, 0, At, B0); PG8_BAR; PG8_SCHED;
            PG8_STAGE(PG8_SB(0, 1), b2 + hstepB, voffB);
            PG8_WAIT_V(6); PG8_BAR; PG8_MMA(1, 1, At, B1); PG8_BAR;
            PG8_LDB(B0, 1, 0); PG8_SCHED; PG8_LDA(At, 1, 0); PG8_STAGE(PG8_SA(0, 1), a2 + hstep, voffA);
            PG8_WAIT_L(8); PG8_BAR; PG8_WAIT_L(0); PG8_MMA(0, 0, At, B0); PG8_BAR; PG8_SCHED;
            PG8_LDB(B1, 1, 1); PG8_STAGE(PG8_SB(1, 0), b3, voffB);
            PG8_BAR; PG8_WAIT_L(0); PG8_MMA(0, 1, At, B1); PG8_BAR;
            PG8_LDA(At, 1, 1); PG8_STAGE(PG8_SA(1, 0), a3, voffA);
            PG8_BAR; PG8_WAIT_L(0); PG8_MMA(1, 0, At, B0); PG8_BAR; PG8_SCHED;
            PG8_STAGE(PG8_SB(1, 1), b3 + hstepB, voffB);
            PG8_WAIT_V(6); PG8_BAR; PG8_MMA(1, 1, At, B1); PG8_BAR;
            }
        }
        if constexpr (ALIGN_EPI) { if (wr == 0) PG8_BAR; }
        if constexpr (!Epi::AFTER_DRAIN) { E(acc, cur, wr, wc, fr, fq); S.done(cur); }
        if (!has_next) break;
#pragma unroll
        for (int a = 0; a < 2; ++a)
#pragma unroll
            for (int b = 0; b < 2; ++b)
#pragma unroll
                for (int m = 0; m < 4; ++m)
#pragma unroll
                    for (int n = 0; n < 2; ++n) acc[a][b][m][n] = (f32x4){0.f, 0.f, 0.f, 0.f};
        cur = nxt; cA = nA; cB = nB; ++ui;
        if constexpr (ALIGN_EPI) { if (wr == 1) PG8_BAR; }
    }
    PG8_WAIT_V(0);
    if constexpr (!ALIGN_EPI) { if (wr == 0) PG8_BAR; }
    PG8_BAR;
    if constexpr (Epi::AFTER_DRAIN) { E.fused(acc, cur, wr, wc, fr, fq, lds, wid, lane); S.done(cur); }
#undef PG8_SA
#undef PG8_SB
#undef PG8_STAGE
#undef PG8_LDA
#undef PG8_LDB
#undef PG8_MMA
#undef PG8_WAIT_V
#undef PG8_WAIT_L
#undef PG8_BAR
#undef PG8_SCHED
}
}

#include <hip/hip_bf16.h>
#include <cmath>
namespace attn_body {
using bf16=__hip_bfloat16;
using bf16x8=__attribute__((ext_vector_type(8)))short;
using s16x4=__attribute__((ext_vector_type(4)))short;
using f32x16=__attribute__((ext_vector_type(16)))float;
using u32x4=__attribute__((ext_vector_type(4)))unsigned;
constexpr int D=64,PQKV=1536,PO=1024;
constexpr int NW=8,QBLK=32,QB=QBLK*NW,KVBLK=64;
__device__ __forceinline__ int crow(int r,int hi){return (r&3)+8*(r>>2)+4*hi;}
#define SBAR() __builtin_amdgcn_sched_barrier(0)
__device__ __forceinline__ void wmask(f32x16&p0,f32x16&p1,int dq,int hi){
  const float NEG=-INFINITY; const int d0=dq+4*hi;
  #pragma unroll
  for(int r=0;r<16;++r){const int d=d0+(r&3)+8*(r>>2); if(d>128||d<-128)p0[r]=NEG; if(d+32>128||d+32<-128)p1[r]=NEG;}
}

constexpr int NSLOT=3, SLOTB=8192;
constexpr int LDS_K=0, LDS_V=NSLOT*SLOTB, LDS_WS=2*NSLOT*SLOTB, LDS_OST=LDS_WS+NW*64*4, LDS_BYTES=LDS_OST+NW*4096;
constexpr float C2=0.125f*1.4426950408889634f;
__device__ __forceinline__ void glds16(const void*gsrc,unsigned lds_dst){unsigned keep;
  asm volatile("s_mov_b32 %0, m0\n\ts_mov_b32 m0, %2\n\ts_nop 0\n\tglobal_load_lds_dwordx4 %1, off\n\ts_mov_b32 m0, %0":"=&s"(keep):"v"(gsrc),"s"(lds_dst):"memory");}
__device__ __forceinline__ float max3f(float a,float b,float c){float r;asm("v_max3_f32 %0, %1, %2, %3":"=v"(r):"v"(a),"v"(b),"v"(c));return r;}
__device__ __forceinline__ float max2f(float a,float b){float r;asm("v_max_f32_e32 %0, %1, %2":"=v"(r):"v"(a),"v"(b));return r;}
__device__ __forceinline__ float fadd_s(float a,float b){float r;asm("v_add_f32_e32 %0, %1, %2":"=v"(r):"v"(a),"v"(b));return r;}
__device__ __forceinline__ float fsub_s(float a,float b){float r;asm("v_sub_f32_e32 %0, %1, %2":"=v"(r):"v"(a),"v"(b));return r;}
typedef float f32x2_t __attribute__((ext_vector_type(2))); typedef __bf16 bf16x2_t __attribute__((ext_vector_type(2)));
__device__ __forceinline__ unsigned cvtpk_s(float lo,float hi){f32x2_t v={lo,hi};bf16x2_t b=__builtin_convertvector(v,bf16x2_t);return __builtin_bit_cast(unsigned,b);}
#define WAIT_BAR(N) asm volatile("s_waitcnt vmcnt(" #N ") lgkmcnt(0)\n\ts_barrier":::"memory")

__device__ __forceinline__ void qkt(f32x16&p0,f32x16&p1,const char*Kslot,const bf16x8*qr,const f32x16&negm,int r32,int hi){
  const char*kb=Kslot+r32*128; const int sw=r32&7;
  #pragma unroll
  for(int d0=0;d0<4;++d0){
    const int off=((2*d0+hi)^sw)<<4;
    const bf16x8 b0=*reinterpret_cast<const bf16x8*>(kb+off);
    const bf16x8 b1=*reinterpret_cast<const bf16x8*>(kb+off+4096);
    if(d0==0){p0=__builtin_amdgcn_mfma_f32_32x32x16_bf16(b0,qr[0],negm,0,0,0);p1=__builtin_amdgcn_mfma_f32_32x32x16_bf16(b1,qr[0],negm,0,0,0);}
    else{p0=__builtin_amdgcn_mfma_f32_32x32x16_bf16(b0,qr[d0],p0,0,0,0);p1=__builtin_amdgcn_mfma_f32_32x32x16_bf16(b1,qr[d0],p1,0,0,0);}}
}
typedef __attribute__((address_space(3))) const char* lds_cptr;
typedef short v4i16_t __attribute__((ext_vector_type(4)));
__device__ __forceinline__ void kload2(bf16x8*kf,lds_cptr kp,const int*koff,int j){ kf[2*j]=*(const __attribute__((address_space(3))) bf16x8*)(kp+koff[j]); kf[2*j+1]=*(const __attribute__((address_space(3))) bf16x8*)(kp+koff[j]+4096); }
__device__ __forceinline__ void kload8(bf16x8*kf,lds_cptr kp,const int*koff){ kload2(kf,kp,koff,0); kload2(kf,kp,koff,1); kload2(kf,kp,koff,2); kload2(kf,kp,koff,3); }
__device__ __forceinline__ s16x4 vtr(lds_cptr p){ return __builtin_bit_cast(s16x4,__builtin_amdgcn_ds_read_tr16_b64_v4i16((__attribute__((address_space(3))) v4i16_t*)p)); }
__device__ __forceinline__ float rowmax(const f32x16&p0,const f32x16&p1){
  float a=max3f(p0[0],p0[1],p1[0]),b=max3f(p0[2],p0[3],p1[1]);a=max3f(a,p1[2],p1[3]);
  #pragma unroll
  for(int r=4;r<16;r+=4){a=max3f(a,p0[r],p0[r+1]);b=max3f(b,p0[r+2],p0[r+3]);a=max3f(a,p1[r],p1[r+1]);b=max3f(b,p1[r+2],p1[r+3]);}
  const float m=max2f(a,b);
  auto rr=__builtin_amdgcn_permlane32_swap(__float_as_uint(m),__float_as_uint(m),false,false);
  return max2f(__uint_as_float(rr[0]),__uint_as_float(rr[1]));
}
__device__ __forceinline__ void pv(f32x16*o,int vbA,int vbB,bf16x8 pa0,bf16x8 pa1,bf16x8 pa2,bf16x8 pa3){
  #pragma unroll
  for(int d0=0;d0<2;++d0){s16x4 lo[4],hi[4]; const int vb=d0?vbB:vbA;
    #pragma unroll
    for(int ks=0;ks<4;++ks){
      asm volatile("ds_read_b64_tr_b16 %0,%1 offset:%c2":"=&v"(lo[ks]):"v"(vb),"i"(ks*2048):"memory");
      asm volatile("ds_read_b64_tr_b16 %0,%1 offset:%c2":"=&v"(hi[ks]):"v"(vb),"i"(ks*2048+1024):"memory");}
    asm volatile("s_waitcnt lgkmcnt(0)":::"memory");SBAR();
    #define PK(k) (bf16x8){lo[k][0],lo[k][1],lo[k][2],lo[k][3],hi[k][0],hi[k][1],hi[k][2],hi[k][3]}
    o[d0]=__builtin_amdgcn_mfma_f32_32x32x16_bf16(pa0,PK(0),o[d0],0,0,0);
    o[d0]=__builtin_amdgcn_mfma_f32_32x32x16_bf16(pa1,PK(1),o[d0],0,0,0);
    o[d0]=__builtin_amdgcn_mfma_f32_32x32x16_bf16(pa2,PK(2),o[d0],0,0,0);
    o[d0]=__builtin_amdgcn_mfma_f32_32x32x16_bf16(pa3,PK(3),o[d0],0,0,0);
    #undef PK
  }
}

#ifndef ATTN_STORE16
#define ATTN_STORE16(p,v) (*(u32x4*)(p)=(v))
#endif
template<int THRL,bool WIN,int QMODE,bool FAST=false,bool GQ4=false> __device__ __forceinline__ void attn_unit(const bf16*Qu,const bf16*__restrict__ Kh,const bf16*__restrict__ Vh,bf16*Ou,const int NT,const int jump,const int qpos0,float sink2,const float*qg,const bool qrope,char*shm,const float*sinks=nullptr,const bf16*Knext=nullptr,const bool kpre=false){
  const int tid=threadIdx.x,lane=tid&63,r32=lane&31,hi=lane>>5; const int wid=__builtin_amdgcn_readfirstlane(tid>>6);
  const int qb_=GQ4?(wid&1):wid, hoff_=GQ4?(wid>>1)*64:0;
  if(GQ4)sink2=sinks[wid>>1]*1.4426950408889634f;
  const bf16*Qw=Qu+(long)(qb_*QBLK)*PQKV+hoff_;
  const unsigned lds0=(unsigned)(uintptr_t)shm;
  float*wsf=(float*)(shm+LDS_WS)+wid*64;
  const int krow_=8*wid+(lane>>3); const bf16*ksrc=Kh+(long)krow_*PQKV+(((lane&7)^(krow_&7))*8);
  const bf16*vsrc=Vh+(long)krow_*PQKV+(((lane&7)^(krow_&7))*8);
  const unsigned kdst=lds0+LDS_K+wid*1024, vdst=lds0+LDS_V+wid*1024;
  #define KROW(t) ((long)(t)*KVBLK+((t)>=4?jump:0))
  #define DMA_K(t,slot) glds16(ksrc+KROW(t)*PQKV,(unsigned)__builtin_amdgcn_readfirstlane(kdst+(slot)))
  #define DMA_V(t,slot) glds16(vsrc+KROW(t)*PQKV,(unsigned)__builtin_amdgcn_readfirstlane(vdst+(slot)))
  const int vrs_=4*hi+((lane&15)>>2), vch_=((lane>>4)&1)*2+((lane&3)>>1);
  const int voffA_=vrs_*128+(((vch_)^vrs_)<<4)+(lane&1)*8, voffB_=vrs_*128+(((4+vch_)^vrs_)<<4)+(lane&1)*8;
  const int vb0A=(int)(lds0+LDS_V)+voffA_, vb0B=(int)(lds0+LDS_V)+voffB_;
  const char*Kbase=shm+LDS_K; bf16x8 kf[8];
  const lds_cptr shm3=(lds_cptr)shm; const lds_cptr kp0=shm3+LDS_K+r32*128; const int koff[4]={((0+hi)^(r32&7))<<4,((2+hi)^(r32&7))<<4,((4+hi)^(r32&7))<<4,((6+hi)^(r32&7))<<4}; const lds_cptr vp0A=shm3+LDS_V+voffA_, vp0B=shm3+LDS_V+voffB_;
  if(!kpre){DMA_K(0,0);} DMA_V(0,0); if(!kpre){DMA_K(1,SLOTB);}
  bf16x8 qr[4];
  #pragma unroll
  for(int d0=0;d0<4;++d0)qr[d0]=*reinterpret_cast<const bf16x8*>(&Qw[(long)r32*PQKV+d0*16+hi*8]);
  if(!kpre){DMA_K(2,2*SLOTB);}
  if(QMODE){ float x[32];
    #pragma unroll
    for(int d0=0;d0<4;++d0){
      #pragma unroll
      for(int j=0;j<8;++j)x[8*d0+j]=__uint_as_float(((unsigned)(unsigned short)qr[d0][j])<<16);}
    if(QMODE==2){ float ss=0.f;
      #pragma unroll
      for(int i=0;i<32;++i)ss+=x[i]*x[i];
      ss+=__shfl_xor(ss,32); const float rs=rsqrtf(ss*(1.f/64.f)+1e-6f);
      #pragma unroll
      for(int d0=0;d0<4;++d0){
        #pragma unroll
        for(int j=0;j<8;++j)x[8*d0+j]*=rs*qg[16*d0+8*hi+j];} }
    if(qrope){ const int t=qpos0+qb_*QBLK+r32; const float pr=(float)(t>>6),pc=(float)(t&63);
      #pragma unroll
      for(int j=0;j<8;++j){ const float inv=exp2f(-(float)(8*hi+j)*(13.287712379549449f/16.f))*0.15915494309189535f;
        float rr=pr*inv,rc=pc*inv; rr-=floorf(rr); rc-=floorf(rc);
        const float sr=__builtin_amdgcn_sinf(rr),cr=__builtin_amdgcn_cosf(rr),sc=__builtin_amdgcn_sinf(rc),cc=__builtin_amdgcn_cosf(rc);
        const float a1=x[j],a2=x[8+j]; x[j]=a1*cr-a2*sr; x[8+j]=a1*sr+a2*cr;
        const float b1=x[16+j],b2=x[24+j]; x[16+j]=b1*cc-b2*sc; x[24+j]=b1*sc+b2*cc; } }
    #pragma unroll
    for(int d0=0;d0<4;++d0){ u32x4 w; w.x=cvtpk_s(x[8*d0]*C2,x[8*d0+1]*C2); w.y=cvtpk_s(x[8*d0+2]*C2,x[8*d0+3]*C2); w.z=cvtpk_s(x[8*d0+4]*C2,x[8*d0+5]*C2); w.w=cvtpk_s(x[8*d0+6]*C2,x[8*d0+7]*C2); qr[d0]=__builtin_bit_cast(bf16x8,w); } }
  float mhat=0.f,l_reg=0.f;f32x16 o[2];o[0]=f32x16{};o[1]=f32x16{};f32x16 negm=f32x16{};if(!WIN&&!FAST)asm volatile("":"+v"(negm)); f32x16 o2=f32x16{}; const bf16x8 ones8=(bf16x8){(short)0x3F80,(short)0x3F80,(short)0x3F80,(short)0x3F80,(short)0x3F80,(short)0x3F80,(short)0x3F80,(short)0x3F80};
  const int qrel=qpos0+qb_*QBLK+r32;
  #define CMASK(P0,P1,t) do{ if(WIN){ if((t)>=4) wmask(P0,P1,(int)KROW(t)-256-qrel,hi); } }while(0)
  bool resc=false;
  #define START(P0,P1) do{ resc=false; if(!FAST){ const float rm=rowmax(P0,P1); \
    { const float dl=rm; mhat=fadd_s(mhat,dl); \
      _Pragma("unroll") for(int r=0;r<16;++r){P0[r]=fsub_s(P0[r],dl);P1[r]=fsub_s(P1[r],dl);} \
      if(!WIN){ _Pragma("unroll") for(int r=0;r<16;++r)negm[r]=-mhat; asm volatile("":"+v"(negm)); } } } \
    _Pragma("unroll") for(int r=0;r<16;++r)P0[r]=__builtin_amdgcn_exp2f(P0[r]); }while(0)
  #define RESC() do{ if(resc){ asm volatile("s_waitcnt lgkmcnt(0)":::"memory"); \
      _Pragma("unroll") for(int d_=0;d_<2;++d_) _Pragma("unroll") for(int r=0;r<16;++r)o[d_][r]*=wsf[crow(r,hi)]; } }while(0)
  f32x16 pA0,pA1,pB0,pB1;
  int sl_prev=0,sl_cur=0,sl_next=SLOTB;
  #define ROT() do{sl_prev=sl_cur;sl_cur=sl_next;sl_next=(sl_next==(NSLOT-1)*SLOTB)?0:sl_next+SLOTB;}while(0)
  WAIT_BAR(3);
  qkt(pA0,pA1,Kbase,qr,negm,r32,hi);asm volatile("s_nop 15\n\ts_nop 7":"+v"(pA0),"+v"(pA1));CMASK(pA0,pA1,0);
  START(pA0,pA1);
  _Pragma("unroll") for(int r=0;r<16;++r)pA1[r]=__builtin_amdgcn_exp2f(pA1[r]);
  WAIT_BAR(0);
  DMA_K(3,0);DMA_V(1,SLOTB);
  ROT();
  kload8(kf,kp0+sl_cur,koff);
  WAIT_BAR(2);
  s16x4 vlo[8],vhi[8]; u32x4 pw0,pw1,pw2,pw3;
  #define PKW(P,B) cvtpk_s(P[B],P[B+1])
  #define PAF(k) __builtin_bit_cast(bf16x8,pw##k)
  #define VFR(i) (bf16x8){vlo[i][0],vlo[i][1],vlo[i][2],vlo[i][3],vhi[i][0],vhi[i][1],vhi[i][2],vhi[i][3]}
  #define PIN(x) asm volatile("":"+v"(x))
  #define MX3(a,b,c) __builtin_fmaxf(__builtin_fmaxf((a),(b)),(c))
  #define GAPA(MF,A0,A1,A2,A3,W0,W1,PW) do{ MF; if(!FAST){ sacc+=A0; sacc+=A1; sacc+=A2; sacc+=A3; PIN(sacc); } W0; W1; PIN(PW); SBAR(); }while(0)
  #define EX(v) __builtin_amdgcn_exp2f(v)
  #define GAPB(MF,X,B) do{ MF; X[B]=EX(X[B]); X[B+1]=EX(X[B+1]); X[B+2]=EX(X[B+2]); X[B+3]=EX(X[B+3]); PIN(X); SBAR(); }while(0)
  #define VRD(i) do{ vlo[i]=vtr((((i)>>2)?vpB_:vpA_)+((i)&3)*2048); vhi[i]=vtr((((i)>>2)?vpB_:vpA_)+((i)&3)*2048+1024); }while(0)
  #define ONESMF(k) do{ if(FAST){ o2=__builtin_amdgcn_mfma_f32_32x32x16_bf16(PAF(k),ones8,o2,0,0,0); SBAR(); } }while(0)
  #define KRD(G,j) do{ if(G){ kload2(kf,kp0+sl_next,koff,j); SBAR(); } }while(0)
  #define STEP(C0,C1,P0,P1,t,GK,GV,GL) do{ SBAR(); \
    const lds_cptr vpA_=vp0A+sl_prev, vpB_=vp0B+sl_prev; \
    VRD(0); SBAR(); float sacc=FAST?0.f:(P0[0]+P0[1]); \
    GAPA(C0=__builtin_amdgcn_mfma_f32_32x32x16_bf16(kf[0],qr[0],negm,0,0,0), P0[2],P0[3],P0[4],P0[5],     pw0[0]=PKW(P0,0), pw0[1]=PKW(P0,2), pw0); \
    VRD(4); SBAR(); GAPA(C1=__builtin_amdgcn_mfma_f32_32x32x16_bf16(kf[1],qr[0],negm,0,0,0), P0[6],P0[7],P0[8],P0[9],     pw0[2]=PKW(P0,4), pw0[3]=PKW(P0,6), pw0); \
    VRD(1); SBAR(); GAPA(C0=__builtin_amdgcn_mfma_f32_32x32x16_bf16(kf[2],qr[1],C0,0,0,0),   P0[10],P0[11],P0[12],P0[13], pw1[0]=PKW(P0,8), pw1[1]=PKW(P0,10), pw1); \
    VRD(5); SBAR(); GAPA(C1=__builtin_amdgcn_mfma_f32_32x32x16_bf16(kf[3],qr[1],C1,0,0,0),   P0[14],P0[15],P1[0],P1[1],   pw1[2]=PKW(P0,12),pw1[3]=PKW(P0,14), pw1); \
    VRD(2); SBAR(); GAPA(C0=__builtin_amdgcn_mfma_f32_32x32x16_bf16(kf[4],qr[2],C0,0,0,0),   P1[2],P1[3],P1[4],P1[5],     pw2[0]=PKW(P1,0), pw2[1]=PKW(P1,2), pw2); \
    VRD(6); SBAR(); GAPA(C1=__builtin_amdgcn_mfma_f32_32x32x16_bf16(kf[5],qr[2],C1,0,0,0),   P1[6],P1[7],P1[8],P1[9],     pw2[2]=PKW(P1,4), pw2[3]=PKW(P1,6), pw2); \
    VRD(3); SBAR(); GAPA(C0=__builtin_amdgcn_mfma_f32_32x32x16_bf16(kf[6],qr[3],C0,0,0,0),   P1[10],P1[11],P1[12],P1[13], pw3[0]=PKW(P1,8), pw3[1]=PKW(P1,10), pw3); \
    VRD(7); SBAR(); GAPA(C1=__builtin_amdgcn_mfma_f32_32x32x16_bf16(kf[7],qr[3],C1,0,0,0),   P1[14],P1[15],0.f,0.f,       pw3[2]=PKW(P1,12),pw3[3]=PKW(P1,14), pw3); \
    if(!FAST)l_reg+=sacc; \
    if(GK){DMA_K((t)+3,sl_cur);} if(GV){DMA_V((t)+1,sl_next);} \
    if(WIN){ _Pragma("unroll") for(int r=0;r<16;++r){C0[r]-=mhat;C1[r]-=mhat;} } \
    CMASK(C0,C1,t); \
    if(!FAST){ float a=MX3(C0[0],C0[1],C1[0]),b=MX3(C0[2],C0[3],C1[1]); a=MX3(a,C1[2],C1[3]); \
      _Pragma("unroll") for(int r=4;r<16;r+=4){a=MX3(a,C0[r],C0[r+1]);b=MX3(b,C0[r+2],C0[r+3]);a=MX3(a,C1[r],C1[r+1]);b=MX3(b,C1[r+2],C1[r+3]);} \
      float rm=__builtin_fmaxf(a,b); { auto rr=__builtin_amdgcn_permlane32_swap(__float_as_uint(rm),__float_as_uint(rm),false,false); rm=__builtin_fmaxf(__uint_as_float(rr[0]),__uint_as_float(rr[1])); } \
      resc=false; \
      if(__builtin_expect(__any(rm>(float)THRL),0)){ const float dl=__builtin_fmaxf(rm,0.f); mhat+=dl; \
        _Pragma("unroll") for(int r=0;r<16;++r){C0[r]-=dl;C1[r]-=dl;} \
        if(!WIN){ _Pragma("unroll") for(int r=0;r<16;++r)negm[r]=-mhat; asm volatile("":"+v"(negm)); } \
        const float f=__builtin_amdgcn_exp2f(-dl); l_reg*=f; if(hi==0)wsf[r32]=f; resc=true; } } \
    SBAR(); \
    GAPB(o[0]=__builtin_amdgcn_mfma_f32_32x32x16_bf16(PAF(0),VFR(0),o[0],0,0,0), C0,0); \
    GAPB(o[1]=__builtin_amdgcn_mfma_f32_32x32x16_bf16(PAF(0),VFR(4),o[1],0,0,0), C0,4); ONESMF(0); \
    KRD(GL,0); GAPB(o[0]=__builtin_amdgcn_mfma_f32_32x32x16_bf16(PAF(1),VFR(1),o[0],0,0,0), C0,8); \
    KRD(GL,1); GAPB(o[1]=__builtin_amdgcn_mfma_f32_32x32x16_bf16(PAF(1),VFR(5),o[1],0,0,0), C0,12); ONESMF(1); \
    KRD(GL,2); GAPB(o[0]=__builtin_amdgcn_mfma_f32_32x32x16_bf16(PAF(2),VFR(2),o[0],0,0,0), C1,0); \
    KRD(GL,3); GAPB(o[1]=__builtin_amdgcn_mfma_f32_32x32x16_bf16(PAF(2),VFR(6),o[1],0,0,0), C1,4); ONESMF(2); \
    GAPB(o[0]=__builtin_amdgcn_mfma_f32_32x32x16_bf16(PAF(3),VFR(3),o[0],0,0,0), C1,8); \
    GAPB(o[1]=__builtin_amdgcn_mfma_f32_32x32x16_bf16(PAF(3),VFR(7),o[1],0,0,0), C1,12); ONESMF(3); \
    }while(0)
  int t=1; const int NE=NT&~1;
  for(;t+5<NE;t+=2){
    STEP(pB0,pB1,pA0,pA1,t,true,true,true);     WAIT_BAR(2); RESC(); ROT();
    STEP(pA0,pA1,pB0,pB1,t+1,true,true,true);   WAIT_BAR(2); RESC(); ROT();
  }
  #define ENDW(tt) do{ if((tt)+3<NT){WAIT_BAR(2);} else if((tt)+2<NT){WAIT_BAR(1);} else {WAIT_BAR(0);} }while(0)
  for(;t+1<NE;t+=2){
    STEP(pB0,pB1,pA0,pA1,t,(t+3<NT),(t+1<NT),(t+1<NT));       ENDW(t);   RESC(); ROT();
    STEP(pA0,pA1,pB0,pB1,t+1,(t+4<NT),(t+2<NT),(t+2<NT));     ENDW(t+1); RESC(); ROT();
  }
  if(NT&1){
    STEP(pB0,pB1,pA0,pA1,NT-2,false,true,true); WAIT_BAR(0); RESC(); ROT();
    { const f32x16 x0=pA0,x1=pA1; pA0=pB0; pA1=pB1; pB0=x0; pB1=x1; }
  }
  if(Knext){ const bf16*kn=Knext+(long)krow_*PQKV+(((lane&7)^(krow_&7))*8); glds16(kn,(unsigned)__builtin_amdgcn_readfirstlane(kdst)); glds16(kn+(long)KVBLK*PQKV,(unsigned)__builtin_amdgcn_readfirstlane(kdst+SLOTB)); glds16(kn+(long)2*KVBLK*PQKV,(unsigned)__builtin_amdgcn_readfirstlane(kdst+2*SLOTB)); }
  STEP(pB0,pB1,pA0,pA1,NT-1,false,false,false); RESC();
  { if(!FAST){ float sacc=pB0[0]+pB0[1]; _Pragma("unroll") for(int r=2;r<16;++r)sacc+=pB0[r]; _Pragma("unroll") for(int r=0;r<16;++r)sacc+=pB1[r]; l_reg+=sacc; }
    pw0=(u32x4){PKW(pB0,0),PKW(pB0,2),PKW(pB0,4),PKW(pB0,6)};pw1=(u32x4){PKW(pB0,8),PKW(pB0,10),PKW(pB0,12),PKW(pB0,14)};pw2=(u32x4){PKW(pB1,0),PKW(pB1,2),PKW(pB1,4),PKW(pB1,6)};pw3=(u32x4){PKW(pB1,8),PKW(pB1,10),PKW(pB1,12),PKW(pB1,14)};
    SBAR(); pv(o,vb0A+sl_cur,vb0B+sl_cur,PAF(0),PAF(1),PAF(2),PAF(3)); ONESMF(0); ONESMF(1); ONESMF(2); ONESMF(3); }
  #undef PKW
  #undef PAF
  #undef VFR
  #undef PIN
  #undef MX3
  #undef GAPA
  #undef GAPB
  #undef EX
  #undef VRD
  #undef KRD
  #undef ONESMF
  #undef STEP
  #undef ENDW
  float rli[16];
  if(FAST){
    #pragma unroll
    for(int r=0;r<16;++r)rli[r]=__builtin_amdgcn_rcpf(o2[r]);
  } else {
  {auto rr=__builtin_amdgcn_permlane32_swap(__float_as_uint(l_reg),__float_as_uint(l_reg),false,false);l_reg=__uint_as_float(rr[0])+__uint_as_float(rr[1]);}
  if(WIN)l_reg+=__builtin_amdgcn_exp2f(sink2-mhat);
  if(hi==0)wsf[32+r32]=l_reg;asm volatile("s_waitcnt lgkmcnt(0)":::"memory");
  #pragma unroll
  for(int r=0;r<16;++r)rli[r]=__builtin_amdgcn_rcpf(wsf[32+crow(r,hi)]);
  }
  bf16*Ow=Ou+(long)(qb_*QBLK)*PO+hoff_;
  { bf16*stg=(bf16*)(shm+LDS_OST)+wid*2048;
    #pragma unroll
    for(int r=0;r<16;++r){const int orow=crow(r,hi);
      #pragma unroll
      for(int d0=0;d0<2;++d0)stg[orow*64+d0*32+r32]=__float2bfloat16(o[d0][r]*rli[r]);}
    asm volatile("s_waitcnt lgkmcnt(0)":::"memory");
    #pragma unroll
    for(int i=0;i<4;++i){const int row=i*8+(lane>>3),ch=lane&7; const u32x4 v=*(const u32x4*)(stg+row*64+ch*8); ATTN_STORE16(Ow+(long)row*PO+ch*8,v);} }
  asm volatile("s_waitcnt lgkmcnt(0)\n\ts_barrier":::"memory");
  #undef DMA_K
  #undef KROW
  #undef DMA_V
  #undef CMASK
  #undef START
  #undef RESC
  #undef ROT
}
constexpr int ATTN_LDS_BYTES=LDS_BYTES;
#undef SBAR
#undef WAIT_BAR
}

template <int LAYER> __device__ __forceinline__ void attn_fast_phase(Frame& F, char* shm) {
    using attn_body::bf16;
    const int G = gridDim.x, bx = blockIdx.x, vcu = (G % 8 == 0) ? (bx % 8) * (G / 8) + bx / 8 : bx;
    constexpr int NQH = LAYER == 0 ? 12 : 16, GQ = LAYER == 0 ? 3 : 4, QC0 = LAYER == 0 ? 256 : 0;
    constexpr int NLAT = NB * NQH * 32, NUN = NLAT + (LAYER == 0 ? NB * NQH : 0);
    const bf16* QKV = (const bf16*)F_qkvu; bf16* MIXO = (bf16*)F_mix;
    bool fast = false;
    if (LAYER == 0) { float gq = fabsf(F.in[I_EQG][F.lane]), gk = fabsf(F.in[I_EKG][F.lane]);
#pragma unroll
        for (int o = 1; o < 64; o <<= 1) { gq = fmaxf(gq, __shfl_xor(gq, o)); gk = fmaxf(gk, __shfl_xor(gk, o)); }
        fast = __builtin_amdgcn_readfirstlane((int)(64.f * 1.05f * attn_body::C2 * gq * gk < 60.f)) != 0; }
    if (LAYER == 1) {
        constexpr int NU1 = NB * 4 * (SEQ / 64);
        bool kpre = false;
        for (int id = vcu; id < NU1; id += G) {
            const int chunk = id % (SEQ / 64), hg = id / (SEQ / 64), kvh = hg & 3, b = hg >> 2, q0 = chunk * 64;
            const int idn = id + G; const bf16* Kn = idn < NU1 ? QKV + (size_t)((idn / (SEQ / 64)) >> 2) * RB * DIN + 1024 + ((idn / (SEQ / 64)) & 3) * 64 : nullptr;
            const size_t brow = (size_t)b * RB, qrow = brow + CTXL + (size_t)q0;
            int ws = q0 >= 128 ? q0 - 128 : 0; const int we = q0 + 192 <= SEQ ? q0 + 192 : SEQ; int n = (we - ws) / 64;
            attn_body::attn_unit<8, true, 1, false, true>(QKV + qrow * DIN + kvh * 256, QKV + brow * DIN + 1024 + kvh * 64, QKV + brow * DIN + 1280 + kvh * 64, MIXO + qrow * DM + kvh * 256, 4 + n, ws, q0, 0.f, nullptr, true, shm, F.in[I_OSINK] + kvh * 4, Kn, kpre); kpre = Kn != nullptr;
        }
        return;
    }
    bool kpre = false;
    for (int id = vcu; id < NUN; id += G) {
        const bf16* Kn = nullptr;
        { const int idn = id + G; if (idn < NUN) { const int hgn = idn < NLAT ? idn >> 5 : idn - NLAT; Kn = QKV + (size_t)(hgn / NQH) * RB * DIN + 1024 + ((hgn % NQH) / GQ) * 64; } }
        if (id < NLAT) {
            const int chunk = id & 31, hg = id >> 5, h = hg % NQH, b = hg / NQH;
            const size_t brow = (size_t)b * RB, qrow = brow + CTXL + (size_t)chunk * 256;
            const bf16* Qu = QKV + qrow * DIN + QC0 + h * 64; const bf16* Kh = QKV + brow * DIN + 1024 + (h / GQ) * 64; bf16* Ou = MIXO + qrow * DM + QC0 + h * 64;
            if (LAYER == 0) { if (fast) attn_body::attn_unit<8, false, 2, true>(Qu, Kh, Kh + 256, Ou, RB / 64, 0, chunk * 256, 0.f, F.in[I_EQG], true, shm, nullptr, Kn, kpre); else attn_body::attn_unit<8, false, 2, false>(Qu, Kh, Kh + 256, Ou, RB / 64, 0, chunk * 256, 0.f, F.in[I_EQG], true, shm, nullptr, Kn, kpre); }
        } else if (LAYER == 0) {
            const int cu = id - NLAT, h = cu % NQH, b = cu / NQH; const size_t brow = (size_t)b * RB;
            if (fast) attn_body::attn_unit<8, false, 2, true>(QKV + brow * DIN + QC0 + h * 64, QKV + brow * DIN + 1024 + (h / GQ) * 64, QKV + brow * DIN + 1280 + (h / GQ) * 64, MIXO + brow * DM + QC0 + h * 64, 4, 0, 0, 0.f, F.in[I_EQG], false, shm, nullptr, Kn, kpre);
            else attn_body::attn_unit<8, false, 2, false>(QKV + brow * DIN + QC0 + h * 64, QKV + brow * DIN + 1024 + (h / GQ) * 64, QKV + brow * DIN + 1280 + (h / GQ) * 64, MIXO + brow * DM + QC0 + h * 64, 4, 0, 0, 0.f, F.in[I_EQG], false, shm, nullptr, Kn, kpre);
        }
        kpre = Kn != nullptr;
    }
}

template <int G> __device__ __forceinline__ void pool_group(const bf16* ub, int t, int L, int lane, const bf16* pwT, const float* ps, bf16* orow) {
    constexpr int W = 2 << G; const int fr = lane & 15, kq = lane >> 4;
    int lo = t - W / 2; if (lo < 0) lo = 0; int hi = t + W - W / 2; if (hi > L) hi = L; const float rc = 1.f / (float)(hi - lo);
    f32x4 acc[4];
#pragma unroll
    for (int nb = 0; nb < 4; ++nb) acc[nb] = (f32x4){0.f, 0.f, 0.f, 0.f};
#pragma unroll
    for (int ks = 0; ks < 2; ++ks) {
        const bf16* up = ub + G * 64 + 32 * ks + 8 * kq;
        float sm[8], self[8];
#pragma unroll
        for (int c = 0; c < 8; ++c) { sm[c] = 0.f; self[c] = 0.f; }
#pragma unroll
        for (int i = 0; i < W; ++i) { const int p = t - W / 2 + i; const bool ok = p >= 0 && p < L; const int pc = ok ? p : t;
            const u32x4 w = *(const u32x4*)(up + (size_t)pc * DIN); const float f = ok ? 1.f : 0.f;
            const float e0 = bflo(w.x), e1 = bfhi(w.x), e2 = bflo(w.y), e3 = bfhi(w.y), e4 = bflo(w.z), e5 = bfhi(w.z), e6 = bflo(w.w), e7 = bfhi(w.w);
            sm[0] += f * e0; sm[1] += f * e1; sm[2] += f * e2; sm[3] += f * e3; sm[4] += f * e4; sm[5] += f * e5; sm[6] += f * e6; sm[7] += f * e7;
            if (i == W / 2) { self[0] = e0; self[1] = e1; self[2] = e2; self[3] = e3; self[4] = e4; self[5] = e5; self[6] = e6; self[7] = e7; } }
        u32x4 pb; pb.x = pk2(sm[0] * rc - self[0], sm[1] * rc - self[1]); pb.y = pk2(sm[2] * rc - self[2], sm[3] * rc - self[3]); pb.z = pk2(sm[4] * rc - self[4], sm[5] * rc - self[5]); pb.w = pk2(sm[6] * rc - self[6], sm[7] * rc - self[7]);
        const bf16x8 bfr = __builtin_bit_cast(bf16x8, pb);
#pragma unroll
        for (int nb = 0; nb < 4; ++nb) { const bf16x8 afr = *(const bf16x8*)(pwT + (size_t)(G * 64 + 16 * nb + fr) * 64 + 32 * ks + 8 * kq); acc[nb] = __builtin_amdgcn_mfma_f32_16x16x32_bf16(afr, bfr, acc[nb], 0, 0, 0); }
    }
#pragma unroll
    for (int nb = 0; nb < 4; ++nb) { const int d = G * 64 + 16 * nb + 4 * kq; const f32x4 sc = *(const f32x4*)(ps + d);
        u32x2 o; o.x = pk2(acc[nb][0] * sc.x, acc[nb][1] * sc.y); o.y = pk2(acc[nb][2] * sc.z, acc[nb][3] * sc.w); *(u32x2*)(orow + d) = o; }
}
__device__ __forceinline__ void pool_phase(Frame& F) {
    const int lane = F.lane, fr = lane & 15;
    for (int rg = F.gw; rg < NR / 16; rg += F.ngw) {
        const int r = rg * 16 + fr; int b, j; row_info(r, b, j);
        const int L = j < CTXL ? CTXL : SEQ, t = j < CTXL ? j : j - CTXL;
        const bf16* ub = F_qkvu + (size_t)(r - t) * DIN; bf16* orow = F_mix + (size_t)r * DM;
        pool_group<0>(ub, t, L, lane, F_pwT, F.in[I_EPS], orow); pool_group<1>(ub, t, L, lane, F_pwT, F.in[I_EPS], orow);
        pool_group<2>(ub, t, L, lane, F_pwT, F.in[I_EPS], orow); pool_group<3>(ub, t, L, lane, F_pwT, F.in[I_EPS], orow);
    }
}

#define INS16(L, v) do { float _v = (v); _Pragma("unroll") for (int _i = 0; _i < 16; ++_i) { const float _m = fmaxf(L[_i], _v); _v = fminf(L[_i], _v); L[_i] = _m; } } while (0)
#define BSORT16(L) do { _Pragma("unroll") for (int _st = 8; _st >= 1; _st >>= 1) { _Pragma("unroll") for (int _i = 0; _i < 16; ++_i) { if ((_i & _st) == 0) { const float _a = L[_i], _b = L[_i + _st]; L[_i] = fmaxf(_a, _b); L[_i + _st] = fminf(_a, _b); } } } } while (0)
#define CE16_(V, i, j) do { const float _a = V[i], _b = V[j]; V[i] = fmaxf(_a, _b); V[j] = fminf(_a, _b); } while (0)
#define SORT16(V) do { \
    CE16_(V,0,13); CE16_(V,1,12); CE16_(V,2,15); CE16_(V,3,14); CE16_(V,4,8); CE16_(V,5,6); CE16_(V,7,11); CE16_(V,9,10); \
    CE16_(V,0,5); CE16_(V,1,7); CE16_(V,2,9); CE16_(V,3,4); CE16_(V,6,13); CE16_(V,8,14); CE16_(V,10,15); CE16_(V,11,12); \
    CE16_(V,0,1); CE16_(V,2,3); CE16_(V,4,5); CE16_(V,6,8); CE16_(V,7,9); CE16_(V,10,11); CE16_(V,12,13); CE16_(V,14,15); \
    CE16_(V,0,2); CE16_(V,1,3); CE16_(V,4,10); CE16_(V,5,11); CE16_(V,6,7); CE16_(V,8,9); CE16_(V,12,14); CE16_(V,13,15); \
    CE16_(V,1,2); CE16_(V,3,12); CE16_(V,4,6); CE16_(V,5,7); CE16_(V,8,10); CE16_(V,9,11); CE16_(V,13,14); \
    CE16_(V,1,4); CE16_(V,2,6); CE16_(V,5,8); CE16_(V,7,10); CE16_(V,9,13); CE16_(V,11,14); \
    CE16_(V,2,4); CE16_(V,3,6); CE16_(V,9,12); CE16_(V,11,13); \
    CE16_(V,3,5); CE16_(V,6,8); CE16_(V,7,9); CE16_(V,10,12); \
    CE16_(V,3,4); CE16_(V,5,6); CE16_(V,7,8); CE16_(V,9,10); CE16_(V,11,12); \
    CE16_(V,6,7); CE16_(V,8,9); } while (0)
#define MERGE_LISTS(L, B) do { _Pragma("unroll") for (int _i = 0; _i < 16; ++_i) L[_i] = fmaxf(L[_i], B[15 - _i]); BSORT16(L); } while (0)
#define MERGE16(L, X) do { float _o[16]; _Pragma("unroll") for (int _i = 0; _i < 16; ++_i) _o[_i] = __shfl_xor(L[15 - _i], X); _Pragma("unroll") for (int _i = 0; _i < 16; ++_i) L[_i] = fmaxf(L[_i], _o[_i]); BSORT16(L); } while (0)
constexpr int RT_KROW = 272, RT_KHALF = 128 * RT_KROW, RT_LUT = 73728;
__device__ __forceinline__ void route_qload(const bf16* qp, int lane, bf16x8 (&qf)[4]) {
    const int c = lane & 15, kq = lane >> 4;
#pragma unroll
    for (int ks = 0; ks < 4; ++ks) qf[ks] = *(const bf16x8*)(qp + (size_t)c * 256 + 32 * ks + 8 * kq);
}
__device__ __forceinline__ void route_half(const bf16x8 (&qf)[4], const LAS unsigned char* kl, int lane, float (&L)[16]) {
    const int c = lane & 15, kq = lane >> 4;
    float va[16], vb[16];
#pragma unroll
    for (int rb = 0; rb < 8; ++rb) {
        f32x4 acc = (f32x4){0.f, 0.f, 0.f, 0.f};
#pragma unroll
        for (int ks = 0; ks < 4; ++ks) { const bf16x8 kf = *(const LAS bf16x8*)(kl + (16 * rb + c) * RT_KROW + (32 * ks + 8 * kq) * 2); acc = __builtin_amdgcn_mfma_f32_16x16x32_bf16(kf, qf[ks], acc, 0, 0, 0); }
#pragma unroll
        for (int i = 0; i < 4; ++i) { const float v = __uint_as_float((__float_as_uint(acc[i]) & 0xffffff80u) | (unsigned)(16 * rb + 4 * kq + i)); if (rb < 4) va[4 * rb + i] = v; else vb[4 * (rb - 4) + i] = v; }
    }
    SORT16(va); SORT16(vb);
#pragma unroll
    for (int i = 0; i < 16; ++i) L[i] = va[i];
    MERGE_LISTS(L, vb);
    MERGE16(L, 16); MERGE16(L, 32);
}
__device__ __forceinline__ void route_fast_phase(Frame& F, int layer, bool skip_ctx) {
    const int lane = F.lane, ngrp = NR * 8 / 16;
    const float* scl = F_scl + (size_t)layer * NEXP * 2;
    { const bf16* kg = F_keys + (size_t)layer * 2 * 16384;
      for (int i = F.tid; i < 2 * 128 * 16; i += NTHR) { const int row = i >> 4, ch = i & 15; *(LAS u32x4*)(F.lds + row * RT_KROW + ch * 16) = *(const u32x4*)(kg + (size_t)row * 128 + ch * 8); }
      __syncthreads(); }
    ticket_reset(F);
    const int ngw_ = (ngrp - (int)blockIdx.x + (int)gridDim.x - 1) / (int)gridDim.x, nfull = ((ngw_ / 4) / 8) * 8;
    for (;;) {
        const int tk = ticket_next(F); const int k0 = tk < nfull ? 4 * tk : 4 * nfull + (tk - nfull), kn = tk < nfull ? 4 : 1; if ((int)blockIdx.x + k0 * (int)gridDim.x >= ngrp) break;
        float L1[16], L2[16];
#pragma unroll
        for (int i = 0; i < 16; ++i) { L1[i] = 0.f; L2[i] = 0.f; }
        int vmask = 0;
        bf16x8 qn1[4], qn2[4];
        { const int g0 = (int)blockIdx.x + k0 * (int)gridDim.x; const bf16* qp = F_pq + (size_t)(g0 < ngrp ? g0 : ngrp - 1) * 16 * 256; route_qload(qp, lane, qn1); route_qload(qp + 128, lane, qn2); }
#pragma unroll 1
        for (int g = 0; g < kn; ++g) { const int grp = (int)blockIdx.x + (k0 + g) * (int)gridDim.x;
            bf16x8 q1[4], q2[4];
#pragma unroll
            for (int ks = 0; ks < 4; ++ks) { q1[ks] = qn1[ks]; q2[ks] = qn2[ks]; }
            asm volatile("" ::: "memory");
            { const int gn = grp + (int)gridDim.x; const bf16* qp = F_pq + (size_t)(gn < ngrp ? gn : ngrp - 1) * 16 * 256; route_qload(qp, lane, qn1); route_qload(qp + 128, lane, qn2); }
            if (grp >= ngrp || (skip_ctx && ((grp * 2) % RB) < CTXL)) continue;
            vmask |= 1 << g;
            float A1[16], A2[16];
            route_half(q1, F.lds, lane, A1);
            route_half(q2, F.lds + RT_KHALF, lane, A2);
            const bool mine = (lane >> 4) == g;
#pragma unroll
            for (int i = 0; i < 16; ++i) { L1[i] = mine ? A1[i] : L1[i]; L2[i] = mine ? A2[i] : L2[i]; } }
        if (vmask == 0) continue;
#define CAND(i, j) __uint_as_float((__float_as_uint(L1[i] + L2[j]) & 0xffffff00u) | (unsigned)(16 * (i) + (j)))
        float T[16], U[16], W[16];
#pragma unroll
        for (int jj = 0; jj < 16; ++jj) T[jj] = CAND(0, jj);
        U[0] = CAND(1, 0); U[1] = CAND(1, 1); U[2] = CAND(1, 2); U[3] = CAND(1, 3); U[4] = CAND(1, 4); U[5] = CAND(1, 5); U[6] = CAND(1, 6); U[7] = CAND(1, 7); U[8] = CAND(2, 0); U[9] = CAND(2, 1); U[10] = CAND(2, 2); U[11] = CAND(2, 3); U[12] = CAND(2, 4); U[13] = CAND(3, 0); U[14] = CAND(3, 1); U[15] = CAND(3, 2);
        W[0] = CAND(3, 3); W[1] = CAND(4, 0); W[2] = CAND(4, 1); W[3] = CAND(4, 2); W[4] = CAND(5, 0); W[5] = CAND(5, 1); W[6] = CAND(6, 0); W[7] = CAND(6, 1); W[8] = CAND(7, 0); W[9] = CAND(7, 1); W[10] = CAND(8, 0); W[11] = CAND(9, 0); W[12] = CAND(10, 0); W[13] = CAND(11, 0); W[14] = CAND(12, 0); W[15] = CAND(13, 0);
        SORT16(U); SORT16(W);
        MERGE_LISTS(T, U); MERGE_LISTS(T, W);
        INS16(T, CAND(14, 0)); INS16(T, CAND(15, 0));
#undef CAND
        LAS unsigned char* lut = F.lds + RT_LUT + F.wave * 2048 + lane * 32;
#define PK4(L, m) ((__float_as_uint(L[4 * (m)]) & 127u) | ((__float_as_uint(L[4 * (m) + 1]) & 127u) << 8) | ((__float_as_uint(L[4 * (m) + 2]) & 127u) << 16) | ((__float_as_uint(L[4 * (m) + 3]) & 127u) << 24))
        *(LAS u32x4*)lut = (u32x4){PK4(L1, 0), PK4(L1, 1), PK4(L1, 2), PK4(L1, 3)};
        *(LAS u32x4*)(lut + 16) = (u32x4){PK4(L2, 0), PK4(L2, 1), PK4(L2, 2), PK4(L2, 3)};
#undef PK4
        int P[16];
#pragma unroll
        for (int k = 0; k < 16; ++k) { const unsigned code = __float_as_uint(T[k]) & 255u; P[k] = (int)lut[code >> 4] * 128 + (int)lut[16 + (code & 15u)]; }
        float sum = 0.f, ex[16];
#pragma unroll
        for (int k = 0; k < 16; ++k) { ex[k] = __expf(T[k] - T[0]); sum += ex[k]; }
        const float rs = 1.f / sum;
        if ((vmask >> (lane >> 4)) & 1) { const size_t pair = ((size_t)((int)blockIdx.x + (k0 + (lane >> 4)) * (int)gridDim.x)) * 16 + (lane & 15);
            u32x2* op = F_rt + pair * 16;
            typedef float f32x2r __attribute__((ext_vector_type(2))); f32x2r st[16];
#pragma unroll
            for (int k = 0; k < 16; ++k) st[k] = *(const f32x2r*)(scl + 2 * (size_t)P[k]);
#pragma unroll
            for (int k = 0; k < 16; k += 2) { u32x4 o; o.x = (unsigned)P[k] | (pk2(0.f, st[k].x) & 0xffff0000u); o.y = __float_as_uint(ex[k] * rs * st[k].y); o.z = (unsigned)P[k + 1] | (pk2(0.f, st[k + 1].x) & 0xffff0000u); o.w = __float_as_uint(ex[k + 1] * rs * st[k + 1].y);
                *(u32x4*)(op + k) = o; }
        }
    }
}

typedef _Float16 h2_t __attribute__((ext_vector_type(2)));
__device__ __forceinline__ unsigned q4o(float a, float b, float c, float d, float inv) {
    return ((unsigned)(int)rintf(a * inv + 8.f) & 255u) | (((unsigned)(int)rintf(b * inv + 8.f) & 255u) << 8) | (((unsigned)(int)rintf(c * inv + 8.f) & 255u) << 16) | (((unsigned)(int)rintf(d * inv + 8.f) & 255u) << 24);
}
__device__ __forceinline__ void glds16x4(const void* up, const void* up2, const void* vp, const void* vp2, unsigned l0, unsigned l1, unsigned l2, unsigned l3) { unsigned keep;
    asm volatile("s_mov_b32 %0, m0\n\ts_mov_b32 m0, %5\n\ts_nop 0\n\tglobal_load_lds_dwordx4 %1, off\n\ts_mov_b32 m0, %6\n\ts_nop 0\n\tglobal_load_lds_dwordx4 %2, off\n\ts_mov_b32 m0, %7\n\ts_nop 0\n\tglobal_load_lds_dwordx4 %3, off\n\ts_mov_b32 m0, %8\n\ts_nop 0\n\tglobal_load_lds_dwordx4 %4, off\n\ts_mov_b32 m0, %0"
                 : "=&s"(keep) : "v"(up), "v"(up2), "v"(vp), "v"(vp2), "s"(l0), "s"(l1), "s"(l2), "s"(l3) : "memory"); }
#define ROR_(x, c) __builtin_amdgcn_update_dpp(0, (x), (c), 0xf, 0xf, true)
__device__ __forceinline__ int row16_sum_i(int d) { d += ROR_(d, 0x128); d += ROR_(d, 0x124); d += ROR_(d, 0x122); d += ROR_(d, 0x121); return d; }
__device__ __forceinline__ float row16_sum_f(float v) {
    v += __int_as_float(ROR_(__float_as_int(v), 0x128)); v += __int_as_float(ROR_(__float_as_int(v), 0x124)); v += __int_as_float(ROR_(__float_as_int(v), 0x122)); v += __int_as_float(ROR_(__float_as_int(v), 0x121)); return v; }
__device__ __forceinline__ float row16_max_f(float v) {
    v = fmaxf(v, __int_as_float(ROR_(__float_as_int(v), 0x128))); v = fmaxf(v, __int_as_float(ROR_(__float_as_int(v), 0x124))); v = fmaxf(v, __int_as_float(ROR_(__float_as_int(v), 0x122))); v = fmaxf(v, __int_as_float(ROR_(__float_as_int(v), 0x121))); return v; }
#undef ROR_
__device__ __forceinline__ void gather_q8_phase(Frame& F, int layer, bool skip_ctx, bool last, bool nextn) {
    const unsigned char* tu = F_tabu + (size_t)layer * NEXP * (DM / 2); const unsigned char* tv = F_tabv + (size_t)layer * NEXP * (DM / 2);
    const int lane = F.lane, s = lane & 15, e4 = lane >> 4;
    ticket_reset(F);
    int mi_c = -1; u32x4 ga[2] = {}, sa[2] = {}, eg[2] = {}, en[4] = {};
    const int ccol = 32 * s + 512 * (e4 >> 1) + 16 * (e4 & 1);
    f32x4 fg[4] = {};
    if (last) {
#pragma unroll
        for (int hh = 0; hh < 4; ++hh) fg[hh] = *(const f32x4*)(F.in[I_FING] + ccol + 4 * hh); }
    for (;;) {
        const int r = (int)blockIdx.x + ticket_next(F) * (int)gridDim.x; if (r >= NR) break;
        int b, j; row_info(r, b, j); if (skip_ctx && j < CTXL) continue;
        unsigned xq[2][8]; float sx, hsx; u32x4 xkeep[2];
        {
            const int mi = j < CTXL ? 4 : b, q0 = e4 >> 1, p0 = 2 * (e4 & 1);
            const bf16* xr = F_xs + (size_t)r * DM + 32 * s + 512 * q0 + 8 * p0; const bf16* gp = F_gbs + ((size_t)layer * 5 + mi) * 2 * DM + 32 * s + 512 * q0 + 8 * p0;
            const u32x4 xa[2] = {*(const u32x4*)xr, *(const u32x4*)(xr + 8)}; xkeep[0] = xa[0]; xkeep[1] = xa[1];
            if (mi != mi_c) { ga[0] = *(const u32x4*)gp; ga[1] = *(const u32x4*)(gp + 8); sa[0] = *(const u32x4*)(gp + DM); sa[1] = *(const u32x4*)(gp + DM + 8); mi_c = mi;
                const bf16* g2 = F_g2b + ((size_t)layer * 5 + mi) * DM + ccol; eg[0] = *(const u32x4*)g2; eg[1] = *(const u32x4*)(g2 + 8);
                if (nextn) { const bf16* nb = F_n1b + (size_t)mi * 2 * DM + ccol; en[0] = *(const u32x4*)nb; en[1] = *(const u32x4*)(nb + 8); en[2] = *(const u32x4*)(nb + DM); en[3] = *(const u32x4*)(nb + DM + 8); } }
            float ssq = 0.f, mx = 0.f;
#pragma unroll
            for (int c = 0; c < 2; ++c)
#pragma unroll
                for (int w = 0; w < 4; ++w) { const float a = bflo(xa[c][w]), d = bfhi(xa[c][w]); ssq += a * a + d * d; }
            const float rstd = rsqrtf(wave_sum(ssq) * (1.f / DM) + EPS);
            float hv[2][8];
#pragma unroll
            for (int c = 0; c < 2; ++c)
#pragma unroll
                for (int w = 0; w < 4; ++w) { const float a = (bflo(xa[c][w]) * rstd) * bflo(ga[c][w]) + bflo(sa[c][w]), d = (bfhi(xa[c][w]) * rstd) * bfhi(ga[c][w]) + bfhi(sa[c][w]);
                    hv[c][2 * w] = a; hv[c][2 * w + 1] = d; mx = fmaxf(mx, fmaxf(fabsf(a), fabsf(d))); }
            mx = wave_max(mx);
            const float inv = mx > 0.f ? 119.f / mx : 0.f; sx = mx * (1.f / 119.f);
            int sumt = 0; unsigned own[2][2];
#pragma unroll
            for (int c = 0; c < 2; ++c) { const unsigned tlo = q4o(hv[c][0], hv[c][1], hv[c][2], hv[c][3], inv), thi = q4o(hv[c][4], hv[c][5], hv[c][6], hv[c][7], inv);
                own[c][0] = ((tlo >> 4) & 0x0f0f0f0fu) | (thi & 0xf0f0f0f0u);
                own[c][1] = ((tlo & 0x0f0f0f0fu) | ((thi & 0x0f0f0f0fu) << 4)) ^ 0x88888888u;
                sumt = __builtin_amdgcn_sdot4((int)tlo, 0x01010101, sumt, false); sumt = __builtin_amdgcn_sdot4((int)thi, 0x01010101, sumt, false); }
            sumt = wave_sum_i(sumt);
            hsx = 0.5f * (float)(sumt - 8 * DM);
            unsigned z[4][2];
#pragma unroll
            for (int c = 0; c < 2; ++c)
#pragma unroll
                for (int h = 0; h < 2; ++h) { const auto rr = __builtin_amdgcn_permlane16_swap(own[c][h], own[c][h], false, false); z[c][h] = rr[0]; z[2 + c][h] = rr[1]; }
#pragma unroll
            for (int p = 0; p < 4; ++p)
#pragma unroll
                for (int h = 0; h < 2; ++h) { const auto rr = __builtin_amdgcn_permlane32_swap(z[p][h], z[p][h], false, false); xq[0][2 * p + h] = rr[0]; xq[1][2 * p + h] = rr[1]; }
        }
        LAS int* tl_id = (LAS int*)(F.lds + 133120 + F.wave * 1536); LAS float* tl_g = (LAS float*)(tl_id + 128); LAS float* tl_u = tl_g + 128;
        { const size_t o = (size_t)r * 128 + lane;
          const u32x2 t0 = F_rt[o], t1 = F_rt[o + 64];
          tl_id[lane] = (int)(t0.x & 0xffffu); tl_id[64 + lane] = (int)(t1.x & 0xffffu); tl_g[lane] = __uint_as_float(t0.y); tl_g[64 + lane] = __uint_as_float(t1.y); tl_u[lane] = __uint_as_float(t0.x & 0xffff0000u) * sx; tl_u[64 + lane] = __uint_as_float(t1.x & 0xffff0000u) * sx; }
        h2_t hacc[2][4][4]; float wsum = 0.f;
#pragma unroll
        for (int q = 0; q < 2; ++q)
#pragma unroll
            for (int dd = 0; dd < 4; ++dd)
#pragma unroll
                for (int k = 0; k < 4; ++k) hacc[q][dd][k] = (h2_t){(_Float16)0.f, (_Float16)0.f};
        const unsigned lslice = (unsigned)(uintptr_t)F.lds + (unsigned)F.wave * 16384u; LAS unsigned char* lrd = F.lds + F.wave * 16384 + lane * 16;
#define GD_ISSUE(k, it) do { const int _id = tl_id[4 * (it) + e4]; \
            const unsigned char* _up = tu + (size_t)_id * (DM / 2) + 16 * s; const unsigned char* _vp = tv + (size_t)_id * (DM / 2) + 16 * s; \
            const unsigned _lb = (unsigned)__builtin_amdgcn_readfirstlane((int)(lslice + (k) * 4096u)); \
            glds16x4(_up, _up + 256, _vp, _vp + 256, _lb, _lb + 1024u, _lb + 2048u, _lb + 3072u); } while (0)
#define ROR16_(d) do { d += __builtin_amdgcn_update_dpp(0, d, 0x128, 0xf, 0xf, true); d += __builtin_amdgcn_update_dpp(0, d, 0x124, 0xf, 0xf, true); d += __builtin_amdgcn_update_dpp(0, d, 0x122, 0xf, 0xf, true); d += __builtin_amdgcn_update_dpp(0, d, 0x121, 0xf, 0xf, true); } while (0)
#define GD_BODY2(k, REFILL, WAITN) do { const int i = i0 + (k), ea = 4 * i + e4; \
            asm volatile("s_waitcnt vmcnt(" #WAITN ")" ::: "memory"); __builtin_amdgcn_sched_barrier(0);            \
            const u32x4 ua0 = *(const LAS u32x4*)(lrd + (k) * 4096), ua1 = *(const LAS u32x4*)(lrd + (k) * 4096 + 1024), va0 = *(const LAS u32x4*)(lrd + (k) * 4096 + 2048), va1 = *(const LAS u32x4*)(lrd + (k) * 4096 + 3072); \
            const u32x4 ub0 = *(const LAS u32x4*)(lrd + (k) * 4096 + 4096), ub1 = *(const LAS u32x4*)(lrd + (k) * 4096 + 5120), vb0 = *(const LAS u32x4*)(lrd + (k) * 4096 + 6144), vb1 = *(const LAS u32x4*)(lrd + (k) * 4096 + 7168); \
            asm volatile("s_waitcnt lgkmcnt(0)" : "+v"(*(u32x4*)&ua0), "+v"(*(u32x4*)&ua1), "+v"(*(u32x4*)&va0), "+v"(*(u32x4*)&va1), "+v"(*(u32x4*)&ub0), "+v"(*(u32x4*)&ub1), "+v"(*(u32x4*)&vb0), "+v"(*(u32x4*)&vb1) :: "memory"); __builtin_amdgcn_sched_barrier(0);     \
            if (REFILL) { GD_ISSUE(k, i + 4); GD_ISSUE((k) + 1, i + 5); } __builtin_amdgcn_sched_barrier(0); \
            int dla = 0, dha = 0, dlb = 0, dhb = 0; \
            _Pragma("unroll") for (int dd = 0; dd < 4; ++dd) { dha = __builtin_amdgcn_sdot8((int)ua0[dd], (int)xq[0][2 * dd], dha, false); dla = __builtin_amdgcn_sdot8((int)ua0[dd], (int)xq[0][2 * dd + 1], dla, false); } \
            _Pragma("unroll") for (int dd = 0; dd < 4; ++dd) { dha = __builtin_amdgcn_sdot8((int)ua1[dd], (int)xq[1][2 * dd], dha, false); dla = __builtin_amdgcn_sdot8((int)ua1[dd], (int)xq[1][2 * dd + 1], dla, false); } \
            _Pragma("unroll") for (int dd = 0; dd < 4; ++dd) { dhb = __builtin_amdgcn_sdot8((int)ub0[dd], (int)xq[0][2 * dd], dhb, false); dlb = __builtin_amdgcn_sdot8((int)ub0[dd], (int)xq[0][2 * dd + 1], dlb, false); } \
            _Pragma("unroll") for (int dd = 0; dd < 4; ++dd) { dhb = __builtin_amdgcn_sdot8((int)ub1[dd], (int)xq[1][2 * dd], dhb, false); dlb = __builtin_amdgcn_sdot8((int)ub1[dd], (int)xq[1][2 * dd + 1], dlb, false); } \
            int da = 16 * dha + dla, db = 16 * dhb + dlb;        \
            ROR16_(da); ROR16_(db); \
            const int odd = s & 1, es = ea + 4 * odd; const float g = tl_g[es], usc = tl_u[es]; \
            const float w = g * gelu_erf(((float)(odd ? db : da) + hsx) * usc); \
            const float wa = __int_as_float(__builtin_amdgcn_update_dpp(0, __float_as_int(w), 0xA0, 0xf, 0xf, true)), wb = __int_as_float(__builtin_amdgcn_update_dpp(0, __float_as_int(w), 0xF5, 0xf, 0xf, true));     \
            wsum += wa + wb; \
            const _Float16 wa16 = (_Float16)(wa * 8192.f), wa16b = (_Float16)(wa * 512.f), wb16 = (_Float16)(wb * 8192.f), wb16b = (_Float16)(wb * 512.f);     \
            const h2_t wha = (h2_t){wa16, wa16}, whab = (h2_t){wa16b, wa16b}, whb = (h2_t){wb16, wb16}, whbb = (h2_t){wb16b, wb16b}; \
            _Pragma("unroll") for (int dd = 0; dd < 4; ++dd) { const unsigned a0_ = va0[dd], a1_ = a0_ >> 8, b0_ = va1[dd], b1_ = b0_ >> 8; \
                hacc[0][dd][0] = __builtin_elementwise_fma(__builtin_bit_cast(h2_t, a0_ & 0x000f000fu), wha, hacc[0][dd][0]); hacc[0][dd][1] = __builtin_elementwise_fma(__builtin_bit_cast(h2_t, a0_ & 0x00f000f0u), whab, hacc[0][dd][1]); \
                hacc[0][dd][2] = __builtin_elementwise_fma(__builtin_bit_cast(h2_t, a1_ & 0x000f000fu), wha, hacc[0][dd][2]); hacc[0][dd][3] = __builtin_elementwise_fma(__builtin_bit_cast(h2_t, a1_ & 0x00f000f0u), whab, hacc[0][dd][3]); \
                hacc[1][dd][0] = __builtin_elementwise_fma(__builtin_bit_cast(h2_t, b0_ & 0x000f000fu), wha, hacc[1][dd][0]); hacc[1][dd][1] = __builtin_elementwise_fma(__builtin_bit_cast(h2_t, b0_ & 0x00f000f0u), whab, hacc[1][dd][1]); \
                hacc[1][dd][2] = __builtin_elementwise_fma(__builtin_bit_cast(h2_t, b1_ & 0x000f000fu), wha, hacc[1][dd][2]); hacc[1][dd][3] = __builtin_elementwise_fma(__builtin_bit_cast(h2_t, b1_ & 0x00f000f0u), whab, hacc[1][dd][3]); } \
            _Pragma("unroll") for (int dd = 0; dd < 4; ++dd) { const unsigned a0_ = vb0[dd], a1_ = a0_ >> 8, b0_ = vb1[dd], b1_ = b0_ >> 8; \
                hacc[0][dd][0] = __builtin_elementwise_fma(__builtin_bit_cast(h2_t, a0_ & 0x000f000fu), whb, hacc[0][dd][0]); hacc[0][dd][1] = __builtin_elementwise_fma(__builtin_bit_cast(h2_t, a0_ & 0x00f000f0u), whbb, hacc[0][dd][1]); \
                hacc[0][dd][2] = __builtin_elementwise_fma(__builtin_bit_cast(h2_t, a1_ & 0x000f000fu), whb, hacc[0][dd][2]); hacc[0][dd][3] = __builtin_elementwise_fma(__builtin_bit_cast(h2_t, a1_ & 0x00f000f0u), whbb, hacc[0][dd][3]); \
                hacc[1][dd][0] = __builtin_elementwise_fma(__builtin_bit_cast(h2_t, b0_ & 0x000f000fu), whb, hacc[1][dd][0]); hacc[1][dd][1] = __builtin_elementwise_fma(__builtin_bit_cast(h2_t, b0_ & 0x00f000f0u), whbb, hacc[1][dd][1]); \
                hacc[1][dd][2] = __builtin_elementwise_fma(__builtin_bit_cast(h2_t, b1_ & 0x000f000fu), whb, hacc[1][dd][2]); hacc[1][dd][3] = __builtin_elementwise_fma(__builtin_bit_cast(h2_t, b1_ & 0x00f000f0u), whbb, hacc[1][dd][3]); } \
            } while (0)
        GD_ISSUE(0, 0); GD_ISSUE(1, 1); GD_ISSUE(2, 2); GD_ISSUE(3, 3);
#pragma unroll 1
        for (int i0 = 0; i0 < 28; i0 += 4) { GD_BODY2(0, true, 8); GD_BODY2(2, true, 8); }
        { const int i0 = 28; GD_BODY2(0, false, 8); GD_BODY2(2, false, 0); }
#undef GD_BODY2
#undef ROR16_
#undef GD_ISSUE
        h2_t r1p[16], r2p[8];
#pragma unroll
        for (int k = 0; k < 16; ++k) { const auto rr = __builtin_amdgcn_permlane32_swap(__builtin_bit_cast(unsigned, hacc[0][k >> 2][k & 3]), __builtin_bit_cast(unsigned, hacc[1][k >> 2][k & 3]), false, false);
            r1p[k] = __builtin_bit_cast(h2_t, (unsigned)rr[0]) + __builtin_bit_cast(h2_t, (unsigned)rr[1]); }
#pragma unroll
        for (int k = 0; k < 8; ++k) { const auto rr = __builtin_amdgcn_permlane16_swap(__builtin_bit_cast(unsigned, r1p[k]), __builtin_bit_cast(unsigned, r1p[8 + k]), false, false);
            r2p[k] = __builtin_bit_cast(h2_t, (unsigned)rr[0]) + __builtin_bit_cast(h2_t, (unsigned)rr[1]); }
        float r2[16];
#pragma unroll
        for (int dd = 0; dd < 2; ++dd) { const int a0 = 8 * dd;
            r2[a0 + 0] = (float)r2p[4 * dd + 0].x * 2048.f; r2[a0 + 2] = (float)r2p[4 * dd + 0].y * 2048.f; r2[a0 + 4] = (float)r2p[4 * dd + 1].x * 2048.f; r2[a0 + 6] = (float)r2p[4 * dd + 1].y * 2048.f;
            r2[a0 + 1] = (float)r2p[4 * dd + 2].x * 2048.f; r2[a0 + 3] = (float)r2p[4 * dd + 2].y * 2048.f; r2[a0 + 5] = (float)r2p[4 * dd + 3].x * 2048.f; r2[a0 + 7] = (float)r2p[4 * dd + 3].y * 2048.f; }
        wsum = xrow_sum(wsum);
        const float corr = 7.5f * wsum;
        const int c0 = 32 * (s + 16 * (e4 >> 1)) + 16 * (e4 & 1);
        const int mi = j < CTXL ? 4 : b;
        bf16* xs = F_xs + (size_t)r * DM;
        f32x4 y[4]; float ss = 0.f;
        { const u32x4 wa = xkeep[0], wb = xkeep[1];
          const f32x4 xv[4] = {(f32x4){bflo(wa.x), bfhi(wa.x), bflo(wa.y), bfhi(wa.y)}, (f32x4){bflo(wa.z), bfhi(wa.z), bflo(wa.w), bfhi(wa.w)}, (f32x4){bflo(wb.x), bfhi(wb.x), bflo(wb.y), bfhi(wb.y)}, (f32x4){bflo(wb.z), bfhi(wb.z), bflo(wb.w), bfhi(wb.w)}};
          const u32x4 gA = eg[0], gB = eg[1];
          const f32x4 gq[4] = {(f32x4){bflo(gA.x), bfhi(gA.x), bflo(gA.y), bfhi(gA.y)}, (f32x4){bflo(gA.z), bfhi(gA.z), bflo(gA.w), bfhi(gA.w)}, (f32x4){bflo(gB.x), bfhi(gB.x), bflo(gB.y), bfhi(gB.y)}, (f32x4){bflo(gB.z), bfhi(gB.z), bflo(gB.w), bfhi(gB.w)}};
#pragma unroll
          for (int hh = 0; hh < 4; ++hh) { const f32x4 gv = gq[hh];
            const f32x4 yy = xv[hh] + gv * ((f32x4){r2[4 * hh], r2[4 * hh + 1], r2[4 * hh + 2], r2[4 * hh + 3]} - corr);
            y[hh] = yy; ss += (yy.x * yy.x + yy.y * yy.y) + (yy.z * yy.z + yy.w * yy.w); } }
        float rstd = 1.f;
        if (last || nextn) rstd = rsqrtf(wave_sum(ss) * (1.f / DM) + EPS);
        if (last) {
            float* orow = F.out + ((size_t)b * SEQ + (j - CTXL)) * DM;
#pragma unroll
            for (int hh = 0; hh < 4; ++hh) { const int c = c0 + 4 * hh; *(f32x4*)(orow + c) = y[hh] * rstd * fg[hh]; }
        } else {
            u32x4 oa, ob; oa.x = pk2(y[0].x, y[0].y); oa.y = pk2(y[0].z, y[0].w); oa.z = pk2(y[1].x, y[1].y); oa.w = pk2(y[1].z, y[1].w);
            ob.x = pk2(y[2].x, y[2].y); ob.y = pk2(y[2].z, y[2].w); ob.z = pk2(y[3].x, y[3].y); ob.w = pk2(y[3].z, y[3].w);
            *(u32x4*)(xs + c0) = oa; *(u32x4*)(xs + c0 + 8) = ob;
        }
        if (nextn) {
            bf16* orow = F_xn + (size_t)r * DM + c0;
            const u32x4 na = en[0], nbb = en[1], ha = en[2], hb = en[3];
            const f32x4 gq[4] = {(f32x4){bflo(na.x), bfhi(na.x), bflo(na.y), bfhi(na.y)}, (f32x4){bflo(na.z), bfhi(na.z), bflo(na.w), bfhi(na.w)}, (f32x4){bflo(nbb.x), bfhi(nbb.x), bflo(nbb.y), bfhi(nbb.y)}, (f32x4){bflo(nbb.z), bfhi(nbb.z), bflo(nbb.w), bfhi(nbb.w)}};
            const f32x4 hq[4] = {(f32x4){bflo(ha.x), bfhi(ha.x), bflo(ha.y), bfhi(ha.y)}, (f32x4){bflo(ha.z), bfhi(ha.z), bflo(ha.w), bfhi(ha.w)}, (f32x4){bflo(hb.x), bfhi(hb.x), bflo(hb.y), bfhi(hb.y)}, (f32x4){bflo(hb.z), bfhi(hb.z), bflo(hb.w), bfhi(hb.w)}};
            f32x4 z[4];
#pragma unroll
            for (int hh = 0; hh < 4; ++hh) z[hh] = (y[hh] * rstd) * gq[hh] + hq[hh];
            u32x4 oa, ob; oa.x = pk2(z[0].x, z[0].y); oa.y = pk2(z[0].z, z[0].w); oa.z = pk2(z[1].x, z[1].y); oa.w = pk2(z[1].z, z[1].w);
            ob.x = pk2(z[2].x, z[2].y); ob.y = pk2(z[2].z, z[2].w); ob.z = pk2(z[3].x, z[3].y); ob.w = pk2(z[3].z, z[3].w);
            *(u32x4*)orow = oa; *(u32x4*)(orow + 8) = ob;
        }
    }
}

#define RLX_AGENT __ATOMIC_RELAXED, __HIP_MEMORY_SCOPE_AGENT
#define XB_TMO      128
#define XB_XCNT(j)  (256  + 64 * (j))
#define XB_XSUB(j)  (1280 + 64 * (j))
#define XB_XGEN(j)  (2304 + 64 * (j))
#define XB_TOP      3328
#define XB_TOPGEN   3392
#define XCD_BAR_WORDS 3456
#define XB_SPIN_CAP (1u << 18)

__device__ __forceinline__ unsigned xb_ld(unsigned* p)              { return __hip_atomic_load(p, __ATOMIC_RELAXED, __HIP_MEMORY_SCOPE_AGENT); }
__device__ __forceinline__ unsigned xb_add(unsigned* p, unsigned v) { return __hip_atomic_fetch_add(p, v, __ATOMIC_RELAXED, __HIP_MEMORY_SCOPE_AGENT); }
__device__ __forceinline__ unsigned xb_xcc_id() { return (unsigned)__builtin_amdgcn_s_getreg((3 << 11) | 20) & 0xFu; }
#define XB_SPIN(cond, bar) do { unsigned _sp = 0; while (cond) { __builtin_amdgcn_s_sleep(1); \
    if ((++_sp & 255u) == 0u) { if (xb_ld(&(bar)[XB_TMO])) break; if (_sp > XB_SPIN_CAP) { atomicAdd(&(bar)[XB_TMO], 1u); break; } } } } while (0)

struct XcdBarrier {
    unsigned* bar; unsigned x;
    volatile LAS unsigned* st;
};

__device__ __forceinline__ XcdBarrier xcd_barrier_post(unsigned* bar, volatile LAS unsigned* st) {
    XcdBarrier b; b.bar = bar; b.x = xb_xcc_id(); b.st = st;
    if (threadIdx.x == 0) (void)xb_add(&bar[XB_XCNT(b.x)], 1u);
    return b;
}
__device__ __forceinline__ void xcd_barrier_complete(unsigned* bar, unsigned x, unsigned& nloc, unsigned& nx) {
    const unsigned G = gridDim.x * gridDim.y * gridDim.z;
    unsigned sum, cnt, mine, sp = 0u;
    for (;;) {
        sum = 0u; cnt = 0u; mine = 0u;
#pragma unroll
        for (unsigned j = 0; j < 16; ++j) { const unsigned c = xb_ld(&bar[XB_XCNT(j)]); sum += c; cnt += (c > 0u) ? 1u : 0u; mine = (j == x) ? c : mine; }
        if (sum == G) break;
        __builtin_amdgcn_s_sleep(1);
        if ((++sp & 255u) == 0u) { if (xb_ld(&bar[XB_TMO])) break; if (sp > XB_SPIN_CAP) { atomicAdd(&bar[XB_TMO], 1u); break; } }
    }
    nloc = mine > 0u ? mine : 1u; nx = cnt > 0u ? cnt : 1u;
}

__device__ __forceinline__ void xcd_barrier(const XcdBarrier& b) {
    asm volatile("s_waitcnt vmcnt(0)" ::: "memory");
    __syncthreads();
    if (threadIdx.x == 0) {
        unsigned* bar = b.bar;
        __builtin_amdgcn_s_waitcnt(0);
        unsigned nloc = b.st[0], nx = b.st[1];
        if (nloc == 0u) { xcd_barrier_complete(bar, b.x, nloc, nx); b.st[0] = nloc; b.st[1] = nx; }
        const unsigned old = xb_add(&bar[XB_XSUB(b.x)], 1u);
        const unsigned gen = old / nloc;
        if (old + 1u == (gen + 1u) * nloc) {
            __builtin_amdgcn_fence(__ATOMIC_RELEASE, "agent");
            asm volatile("s_waitcnt vmcnt(0)" ::: "memory");
            const unsigned og = xb_add(&bar[XB_TOP], 1u);
            const unsigned tg = og / nx;
            if (og + 1u == (tg + 1u) * nx) xb_add(&bar[XB_TOPGEN], 1u);
            else XB_SPIN(xb_ld(&bar[XB_TOPGEN]) == tg, bar);
            __builtin_amdgcn_fence(__ATOMIC_ACQUIRE, "agent");
            xb_add(&bar[XB_XGEN(b.x)], 1u);
            asm volatile("s_waitcnt vmcnt(0)" ::: "memory");
        } else {
            XB_SPIN(xb_ld(&bar[XB_XGEN(b.x)]) == gen, bar);
            __builtin_amdgcn_fence(__ATOMIC_ACQUIRE, "agent");
            asm volatile("s_waitcnt vmcnt(0)" ::: "memory");
        }
    }
    __syncthreads();
}


#define IN(k) (lo <= (k) && (k) < hi)
#define SEAM(k) do { if (IN(k) && IN((k) + 1)) xcd_barrier(bar); } while (0)
template <int LAYER> __device__ __forceinline__ void layer_phases(Frame& F, char* shm, const int lo, const int hi, cg::grid_group& grid, const XcdBarrier& bar) {
    constexpr int P = 1 + 9 * LAYER; constexpr bool lastl = LAYER == 1;
    if (LAYER == 0) { if (IN(P + 0)) norm_phase<0>(F, LAYER, true, false, true); SEAM(P + 0); }
    if (IN(P + 1)) { if (LAYER == 0) fold_norm2(F);
        const pg8::Gemm g{F_xn, F_winT + (size_t)LAYER * DIN * DM, NR, DIN, DM}; pg8::Order S; S.init(132, DIN, gridDim.x, blockIdx.x, 0); S.kfix = F_qkvu; S.kg = LAYER == 0 ? F.in[I_EKG] : nullptr; const pg8::EpiBf16 E{F_qkvu, DIN};
        pg8::gemm_phase<pg8::EpiBf16, pg8::Order, true, true>(F.lds, g, S, E);
        if (LAYER == 0) tables_tail(F, 0); }
    SEAM(P + 1);
    if (IN(P + 3)) { attn_fast_phase<LAYER>(F, shm); if (LAYER == 0) pool_phase(F); }
    SEAM(P + 3);
    if (IN(P + 4)) { const pg8::Gemm g{F_mix, F_woutT + (size_t)LAYER * DM * DM, NR, DM, DM}; pg8::Order S; S.init(lastl ? 128 : 132, DM, gridDim.x, blockIdx.x, lastl ? 1 : 0);
        const pg8::EpiResid16T<LAYER == 0> E{F.in[I_X], F.in[I_CTX], F_xs, F_mod + (size_t)LAYER * 5 * MODW + 2 * DM, F_ssp};
        pg8::gemm_phase<pg8::EpiResid16T<LAYER == 0>, pg8::Order, true, true>(F.lds, g, S, E);
        if (LAYER == 0) tables_tail(F, 1); }
    SEAM(P + 4);
    if (IN(P + 6)) { const pg8::Gemm g{F_xs, F_wqb + (size_t)LAYER * 5 * DPQ * DM, NR, DPQ, DM, (size_t)DPQ * DM * 2}; pg8::Order S; S.init(lastl ? 128 : 132, DPQ, gridDim.x, blockIdx.x, lastl ? 1 : 0);
        const pg8::EpiPQ E{F_pq, DPQ, F_ssp, F_pqbias + (size_t)LAYER * 5 * DPQ, (LAS float*)(F.lds + 135168)};
        pg8::gemm_phase<pg8::EpiPQ, pg8::Order, true, true>(F.lds, g, S, E);
        if (LAYER == 0) tables_tail(F, 2); }
    SEAM(P + 6);
    if (IN(P + 7)) route_fast_phase(F, LAYER, lastl);
    SEAM(P + 7);
    if (IN(P + 8)) gather_q8_phase(F, LAYER, lastl, lastl, !lastl);
}
#undef IN
#undef SEAM

constexpr int PH_PER_LAYER = 9, N_PHASES = 1 + 2 * PH_PER_LAYER;
__global__ void __launch_bounds__(NTHR, 2) mk_fwd(Args args) {
    extern __shared__ __attribute__((aligned(16))) unsigned char lds_raw[];
    Frame F;
    F.in = args.in; F.out = args.out; F.ws = args.ws; F.lds = (LAS unsigned char*)lds_raw;
    F.tid = threadIdx.x; F.lane = F.tid & 63; F.wave = __builtin_amdgcn_readfirstlane(F.tid >> 6);
    F.gw = blockIdx.x * NWAVES + F.wave; F.ngw = gridDim.x * NWAVES; F.gtid = blockIdx.x * NTHR + F.tid; F.ngt = gridDim.x * NTHR;
    cg::grid_group grid = cg::this_grid();
    volatile LAS unsigned* bst = (volatile LAS unsigned*)(F.lds + 131072 + 512);
    if (F.tid < 2) bst[F.tid] = 0u;
    __syncthreads();
    const XcdBarrier bar = xcd_barrier_post((unsigned*)(F.ws + WS_CTL) + 4096, bst);
    const int lo = args.ph_lo, hi = args.ph_hi;
#define IN(k) (lo <= (k) && (k) < hi)
#define SEAM(k) do { if (IN(k) && IN((k) + 1)) xcd_barrier(bar); } while (0)
    if (lo < 0) grid.sync();
    if (IN(0)) prep_phase(F);
    SEAM(0);
    layer_phases<0>(F, (char*)lds_raw, lo, hi, grid, bar);
    SEAM(PH_PER_LAYER);
    layer_phases<1>(F, (char*)lds_raw, lo, hi, grid, bar);
}

extern "C" void kernel_launch(void* const* d_in, const int* in_sizes, int n_in, void* d_out, int out_size, void* d_ws, size_t ws_size, hipStream_t stream) {
    static int grid = 0;
    if (grid == 0) {
        if (n_in != N_IN || out_size != NB * SEQ * DM || ws_size < WS_END) { fprintf(stderr, "kernel_launch: unexpected problem (n_in %d out %d ws %zu)\n", n_in, out_size, ws_size); grid = -1; return; }
        int dev = 0, cus = 0, per_cu = 0;
        hipGetDevice(&dev); hipDeviceGetAttribute(&cus, hipDeviceAttributeMultiprocessorCount, dev);
        hipFuncSetAttribute((const void*)mk_fwd, hipFuncAttributeMaxDynamicSharedMemorySize, LDS_BYTES);
        hipOccupancyMaxActiveBlocksPerMultiprocessor(&per_cu, (const void*)mk_fwd, NTHR, LDS_BYTES);
        if (per_cu < 1) { fprintf(stderr, "kernel_launch: occupancy query says %d blocks per CU\n", per_cu); per_cu = 1; }
        if (per_cu > 1) per_cu = 1;
        grid = cus * per_cu;
        (void)hipGetLastError();
    }
    if (grid < 0) return;
    hipMemsetAsync((char*)d_ws + WS_CTL, 0, 65536, stream);
    Args a{};
    for (int i = 0; i < N_IN; ++i) a.in[i] = (const float*)d_in[i];
    a.out = (float*)d_out; a.ws = (unsigned char*)d_ws;
#if MK_ONE_LAUNCH
    a.ph_lo = 0; a.ph_hi = N_PHASES;
    void* kargs[] = {&a};
    hipError_t e = hipLaunchCooperativeKernel((const void*)mk_fwd, dim3(grid), dim3(NTHR), kargs, LDS_BYTES, stream);
    if (e != hipSuccess) fprintf(stderr, "cooperative launch failed: %s (grid %d)\n", hipGetErrorString(e), grid);
#else
    for (int ph = 0; ph < N_PHASES; ++ph) { a.ph_lo = ph; a.ph_hi = ph + 1; hipLaunchKernelGGL(mk_fwd, dim3(grid), dim3(NTHR), LDS_BYTES, stream, a); }
#endif
}
```

```cpp
#include <hip/hip_runtime.h>
#include <hip/hip_cooperative_groups.h>
#include <cstdio>
#include <cstdint>
namespace cg = cooperative_groups;

#ifndef MK_ONE_LAUNCH
#define MK_ONE_LAUNCH 1
#endif

#define LAS __attribute__((address_space(3)))
typedef unsigned short bf16;
typedef short bf16x8 __attribute__((ext_vector_type(8)));
typedef float f32x4 __attribute__((ext_vector_type(4)));
typedef unsigned u32x4 __attribute__((ext_vector_type(4)));
typedef unsigned u32x2 __attribute__((ext_vector_type(2)));

constexpr int NB = 4, SEQ = 8192, DM = 1024, CTXL = 256, RB = SEQ + CTXL, NR = NB * RB;
constexpr int DIN = 1536, DPQ = 2048, NEXP = 16384;
constexpr int MODW = 6 * DM;
constexpr float EPS = 1e-6f;
constexpr float C2 = 0.125f * 1.4426950408889634f;
constexpr float LOG2E = 1.4426950408889634f;
constexpr int NWAVES = 8, NTHR = 512;
constexpr int LDS_BYTES = 147456;

constexpr size_t MiB = 1u << 20;
constexpr size_t WS_CTL = 0, WS_MOD = 1 * MiB, WS_XCTX = 2 * MiB, WS_WINT = 6 * MiB, WS_WOUTT = 12 * MiB, WS_WQT = 16 * MiB, WS_KEYS = 24 * MiB;
constexpr size_t WS_XN = 26 * MiB, WS_QKVU = 92 * MiB, WS_MIX = 191 * MiB, WS_PQ = 92 * MiB  ;
constexpr size_t WS_IDX = 257 * MiB, WS_GW = 274 * MiB, WS_TABU = 291 * MiB, WS_TABV = 323 * MiB, WS_SCL = 355 * MiB, WS_XS = 357 * MiB, WS_WQB = 423 * MiB, WS_PQAUX = 463 * MiB, WS_SSP = 464 * MiB, WS_US = 467 * MiB, WS_END = 485 * MiB;
static_assert(WS_XN + (size_t)NR * DM * 2 <= WS_QKVU && WS_QKVU + (size_t)NR * DIN * 2 <= WS_MIX && WS_MIX + (size_t)NR * DM * 2 <= WS_IDX, "ws map");
static_assert(WS_PQ + (size_t)NR * DPQ * 2 <= WS_IDX && WS_IDX + (size_t)NR * 128 * 8 <= WS_TABU, "ws map 2");
static_assert(WS_TABU + (size_t)2 * NEXP * DM <= WS_TABV && WS_TABV + (size_t)2 * NEXP * DM <= WS_SCL && WS_SCL + (size_t)4 * NEXP * 4 <= WS_END, "ws map 3");

enum { I_X = 0, I_C, I_CTX, I_CCTX, I_ADAW, I_ADAB, I_N1G, I_N2G, I_FING, I_EWIN, I_EQG, I_EKG, I_EPW, I_EPS, I_EWOUT, I_OWIN, I_OSINK, I_OWOUT, I_PWQ, I_PK1, I_PK2, I_PU, I_PV, N_IN };

struct Args { const float* in[N_IN]; float* out; unsigned char* ws; int ph_lo, ph_hi; };

struct Frame {
    const float* const* in;
    float* out; unsigned char* ws;
    LAS unsigned char* lds;
    int tid, lane, wave, gw, ngw, gtid, ngt;
};
#define F_mod   ((float*)(F.ws + WS_MOD))
#define F_wqb   ((bf16*)(F.ws + WS_WQB))
#define F_pqbias ((float*)(F.ws + WS_PQAUX))
#define F_gbs   ((bf16*)(F.ws + WS_PQAUX + 131072))
#define F_g2b   ((bf16*)(F.ws + WS_PQAUX + 196608))
#define F_n1b   ((bf16*)(F.ws + WS_PQAUX + 229376))
#define F_ssp   ((float*)(F.ws + WS_SSP))
#define F_xs    ((bf16*)(F.ws + WS_XS))
#define F_winT  ((bf16*)(F.ws + WS_WINT))
#define F_woutT ((bf16*)(F.ws + WS_WOUTT))
#define F_wqT   ((bf16*)(F.ws + WS_WQT))
#define F_keys  ((bf16*)(F.ws + WS_KEYS))
#define F_xn    ((bf16*)(F.ws + WS_XN))
#define F_qkvu  ((bf16*)(F.ws + WS_QKVU))
#define F_mix   ((bf16*)(F.ws + WS_MIX))
#define F_pq    ((bf16*)(F.ws + WS_PQ))
#define F_idx   ((int*)(F.ws + WS_IDX))
#define F_rt    ((u32x2*)(F.ws + WS_IDX))
#define F_gwt   ((float*)(F.ws + WS_GW))
#define F_ust   ((float*)(F.ws + WS_US))
#define F_tabu  ((unsigned char*)(F.ws + WS_TABU))
#define F_tabv  ((unsigned char*)(F.ws + WS_TABV))
#define F_scl   ((float*)(F.ws + WS_SCL))
#define F_part  ((float*)(F.ws + WS_IDX))
#define F_pwT   ((bf16*)(F.ws + WS_KEYS + 131072))

__device__ __forceinline__ float bf2f(unsigned v) { return __uint_as_float(v << 16); }
__device__ __forceinline__ float bflo(unsigned w) { return __uint_as_float(w << 16); }
__device__ __forceinline__ float bfhi(unsigned w) { return __uint_as_float(w & 0xffff0000u); }
__device__ __forceinline__ unsigned f2bf(float f) { unsigned u = __float_as_uint(f); return (u + 0x7fffu + ((u >> 16) & 1u)) >> 16; }
__device__ __forceinline__ unsigned pk2(float lo, float hi) { unsigned r; asm("v_cvt_pk_bf16_f32 %0, %1, %2" : "=v"(r) : "v"(lo), "v"(hi)); return r; }
__device__ __forceinline__ float xrow_sum(float v) {
    { const auto rr = __builtin_amdgcn_permlane16_swap(__float_as_uint(v), __float_as_uint(v), false, false); v = __uint_as_float(rr[0]) + __uint_as_float(rr[1]); }
    { const auto rr = __builtin_amdgcn_permlane32_swap(__float_as_uint(v), __float_as_uint(v), false, false); v = __uint_as_float(rr[0]) + __uint_as_float(rr[1]); }
    return v;
}
__device__ __forceinline__ float wave_max(float v) {
#define ROR_(x, c) __int_as_float(__builtin_amdgcn_update_dpp(0, __float_as_int(x), (c), 0xf, 0xf, true))
    v = fmaxf(v, ROR_(v, 0x128)); v = fmaxf(v, ROR_(v, 0x124)); v = fmaxf(v, ROR_(v, 0x122)); v = fmaxf(v, ROR_(v, 0x121));
#undef ROR_
    { const auto rr = __builtin_amdgcn_permlane16_swap(__float_as_uint(v), __float_as_uint(v), false, false); v = fmaxf(__uint_as_float(rr[0]), __uint_as_float(rr[1])); }
    { const auto rr = __builtin_amdgcn_permlane32_swap(__float_as_uint(v), __float_as_uint(v), false, false); v = fmaxf(__uint_as_float(rr[0]), __uint_as_float(rr[1])); }
    return v;
}
__device__ __forceinline__ int wave_sum_i(int d) {
    d += __builtin_amdgcn_update_dpp(0, d, 0x128, 0xf, 0xf, true); d += __builtin_amdgcn_update_dpp(0, d, 0x124, 0xf, 0xf, true); d += __builtin_amdgcn_update_dpp(0, d, 0x122, 0xf, 0xf, true); d += __builtin_amdgcn_update_dpp(0, d, 0x121, 0xf, 0xf, true);
    { const auto rr = __builtin_amdgcn_permlane16_swap((unsigned)d, (unsigned)d, false, false); d = (int)rr[0] + (int)rr[1]; }
    { const auto rr = __builtin_amdgcn_permlane32_swap((unsigned)d, (unsigned)d, false, false); d = (int)rr[0] + (int)rr[1]; }
    return d;
}
__device__ __forceinline__ float wave_sum(float v) {
#define ROR_(x, c) __int_as_float(__builtin_amdgcn_update_dpp(0, __float_as_int(x), (c), 0xf, 0xf, true))
    v += ROR_(v, 0x128); v += ROR_(v, 0x124); v += ROR_(v, 0x122); v += ROR_(v, 0x121);
#undef ROR_
    return xrow_sum(v);
}
__device__ __forceinline__ void row_info(int r, int& b, int& j) { b = r / RB; j = r - b * RB; }
__device__ __forceinline__ const float* in_row(const Frame& F, int b, int j) { return j < CTXL ? F.in[I_CTX] + (size_t)(b * CTXL + j) * DM : F.in[I_X] + (size_t)(b * SEQ + (j - CTXL)) * DM; }
__device__ __forceinline__ float silu_f(float x) { return x / (1.f + __expf(-x)); }
__device__ __forceinline__ float gelu_erf(float v) {
    const float t = __builtin_amdgcn_rcpf(fabsf(v) * 0.2316418882f + 1.0f);
    float q = t * 0.5307027145f + (-0.7265760135f); q = q * t + 0.7107068705f; q = q * t + (-0.142248368f); q = q * t + 0.127414796f; q = q * t;
    const float m = v * (q * __builtin_amdgcn_exp2f((v * v) * (-0.72134752044f)));
    return v < 0.f ? m : v - m;
}

constexpr int TICKET_OFF = 145408;
__device__ __forceinline__ void ticket_reset(Frame& F) { __syncthreads(); if (F.tid == 0) *(LAS int*)(F.lds + TICKET_OFF) = 0; __syncthreads(); }
__device__ __forceinline__ int ticket_next(Frame& F) { int k = 0; if (F.lane == 0) k = __hip_atomic_fetch_add((LAS int*)(F.lds + TICKET_OFF), 1, __ATOMIC_RELAXED, __HIP_MEMORY_SCOPE_WORKGROUP); return __builtin_amdgcn_readfirstlane(k); }
__device__ __forceinline__ void transpose_item(const float* W, int K, int N, bf16* WT, LAS float* scr, int item, int lane) {
    const int nblk = N / 32, kb = item / nblk, nb = item % nblk, k0 = 64 * kb, n0 = 32 * nb;
    f32x4 t[8];
#pragma unroll
    for (int i = 0; i < 8; ++i) t[i] = *(const f32x4*)(W + (size_t)(k0 + (lane >> 3) + 8 * i) * N + n0 + 4 * (lane & 7));
#pragma unroll
    for (int i = 0; i < 8; ++i) { LAS float* d = scr + ((lane >> 3) + 8 * i) * 33 + 4 * (lane & 7); d[0] = t[i].x; d[1] = t[i].y; d[2] = t[i].z; d[3] = t[i].w; }
    asm volatile("s_waitcnt lgkmcnt(0)" ::: "memory");
    const int c = lane & 7;
#pragma unroll
    for (int j = 0; j < 4; ++j) { const int n = (lane >> 3) + 8 * j; const LAS float* s = scr + (8 * c) * 33 + n;
        u32x4 o; o.x = pk2(s[0 * 33], s[1 * 33]); o.y = pk2(s[2 * 33], s[3 * 33]); o.z = pk2(s[4 * 33], s[5 * 33]); o.w = pk2(s[6 * 33], s[7 * 33]);
        *(u32x4*)(WT + (size_t)(n0 + n) * K + k0 + 8 * c) = o; }
    asm volatile("s_waitcnt lgkmcnt(0)" ::: "memory");
}
__device__ __forceinline__ void cvt_stream(const float* src, bf16* dst, size_t n, size_t gt, size_t ngt) {
    for (size_t i = gt * 8; i < n; i += ngt * 8) { const f32x4 a = *(const f32x4*)(src + i), b = *(const f32x4*)(src + i + 4);
        u32x4 o; o.x = pk2(a.x, a.y); o.y = pk2(a.z, a.w); o.z = pk2(b.x, b.y); o.w = pk2(b.z, b.w); *(u32x4*)(dst + i) = o; }
}
__device__ __forceinline__ void tab_row(Frame& F, int it, const f32x4 (&v)[4]) {
    const int tbl = it / (2 * NEXP), rr = it % (2 * NEXP);
    float ss = 0.f;
#pragma unroll
    for (int q = 0; q < 4; ++q) ss += (v[q].x * v[q].x + v[q].y * v[q].y) + (v[q].z * v[q].z + v[q].w * v[q].w);
    const float step = 0.3352f * sqrtf(wave_sum(ss) * (1.f / DM)), inv = step > 0.f ? 1.f / step : 0.f;
    unsigned nb[16];
#pragma unroll
    for (int q = 0; q < 4; ++q) {
        const int n0 = (int)floorf(v[q].x * inv), n1 = (int)floorf(v[q].y * inv), n2 = (int)floorf(v[q].z * inv), n3 = (int)floorf(v[q].w * inv);
        const int ob = tbl == 1 ? 8 : 0;
        nb[4 * q] = (unsigned)((n0 < -8 ? -8 : n0 > 7 ? 7 : n0) + ob) & 15u; nb[4 * q + 1] = (unsigned)((n1 < -8 ? -8 : n1 > 7 ? 7 : n1) + ob) & 15u; nb[4 * q + 2] = (unsigned)((n2 < -8 ? -8 : n2 > 7 ? 7 : n2) + ob) & 15u; nb[4 * q + 3] = (unsigned)((n3 < -8 ? -8 : n3 > 7 ? 7 : n3) + ob) & 15u; }
    u32x2 o2;
#pragma unroll
    for (int d = 0; d < 2; ++d) { unsigned w = 0;
#pragma unroll
        for (int jj = 0; jj < 4; ++jj) w |= (nb[8 * d + jj] | (nb[8 * d + 4 + jj] << 4)) << (8 * jj);
        o2[d] = w; }
    *(u32x2*)((tbl == 0 ? F_tabu : F_tabv) + (size_t)rr * (DM / 2) + 8 * F.lane) = o2;
    if (F.lane == 0) F_scl[(size_t)rr * 2 + tbl] = step;
}
struct TailSlots { int idle[3], total, rps; };
__device__ __forceinline__ TailSlots tail_slots(int G) {
    TailSlots t; const int nw[3] = {132 * (DIN / 256), 132 * (DM / 256), 132 * (DPQ / 256)}; t.total = 0;
#pragma unroll
    for (int k = 0; k < 3; ++k) { const int rem = nw[k] % G; t.idle[k] = (rem != 0 && nw[k] > G) ? G - rem : 0; t.total += t.idle[k]; }
    t.rps = t.total > 0 ? (((4 * NEXP + t.total - 1) / t.total + 7) / 8) * 8 : 0;
    return t;
}
__device__ __forceinline__ void tables_rows(Frame& F, int r0, int r1) {
    for (int base = r0 + F.wave * 6; base < r1; base += 48) {
        f32x4 v[6][4];
#pragma unroll
        for (int k = 0; k < 6; ++k) { const int it = base + k < r1 ? base + k : r1 - 1; const float* src = F.in[it < 2 * NEXP ? I_PU : I_PV] + (size_t)(it % (2 * NEXP)) * DM + 16 * F.lane;
#pragma unroll
            for (int q = 0; q < 4; ++q) v[k][q] = *(const f32x4*)(src + 4 * q); }
#pragma unroll
        for (int k = 0; k < 6; ++k) if (base + k < r1) tab_row(F, base + k, v[k]);
    }
}
__device__ __forceinline__ void tables_tail(Frame& F, int k, int when) {
    const TailSlots t = tail_slots((int)gridDim.x);
    if (t.total == 0) { if (k == 0 && when == 1) for (int c = blockIdx.x; c < 4 * NEXP / 256; c += gridDim.x) tables_rows(F, c * 256, c * 256 + 256); return; }
    if (t.idle[k] == 0) return;
    const int first_idle = (int)gridDim.x - t.idle[k]; if ((int)blockIdx.x < first_idle) return;
    if ((((int)blockIdx.x >> 3) & 1) != (when == 0 ? 1 : 0)) return;
    int s = (int)blockIdx.x - first_idle; for (int j = 0; j < k; ++j) s += t.idle[j];
    const int r0 = s * t.rps, r1 = r0 + t.rps < 4 * NEXP ? r0 + t.rps : 4 * NEXP;
    if (r0 < r1) tables_rows(F, r0, r1);
}
__device__ __forceinline__ void prep_phase(Frame& F) {
    if (F.wave < 3) {
        for (int item = blockIdx.x * 3 + F.wave; item < 768; item += gridDim.x * 3) {
            const int l = item / 384, rem = item % 384, cc = rem / 16, kc = rem % 16, col = cc * 256 + 4 * F.lane, k = kc * 64 + F.lane;
            float sv[5];
#pragma unroll
            for (int m = 0; m < 5; ++m) sv[m] = silu_f(m < 4 ? F.in[I_C][m * DM + k] : F.in[I_CCTX][k]);
            const float* w = F.in[I_ADAW] + ((size_t)l * DM + kc * 64) * MODW + col;
            f32x4 acc[5];
#pragma unroll
            for (int m = 0; m < 5; ++m) acc[m] = (f32x4){0.f, 0.f, 0.f, 0.f};
#pragma unroll 8
            for (int kk = 0; kk < 64; ++kk) { const f32x4 wv = *(const f32x4*)(w + (size_t)kk * MODW);
#pragma unroll
                for (int m = 0; m < 5; ++m) acc[m] += wv * __uint_as_float(__builtin_amdgcn_readlane(__float_as_uint(sv[m]), kk)); }
#pragma unroll
            for (int m = 0; m < 5; ++m) *(f32x4*)(F_part + ((size_t)(kc * 2 + l) * 5 + m) * MODW + col) = acc[m];
        }
    }
    for (int i = F.gtid; i < 4 * 64 * 64; i += F.ngt) { const int g = i >> 12, d = (i >> 6) & 63, c = i & 63; F_pwT[i] = (bf16)f2bf(F.in[I_EPW][(g * 64 + c) * 64 + d]); }
    LAS float* scr = (LAS float*)(F.lds + 32768 + F.wave * 12288);
    constexpr int I_IN = 16 * (DIN / 32), I_OUT = 16 * (DM / 32), I_Q = 16 * (DPQ / 32), I_L = I_IN + I_OUT + I_Q;
    for (int it = (F.wave >= 3 ? (int)blockIdx.x * 5 + F.wave - 3 : 2 * I_L); it < 2 * I_L; it += (int)gridDim.x * 5) {
        const int l = it / I_L; int r = it % I_L;
        if (r < I_IN) { transpose_item(l == 0 ? F.in[I_EWIN] : F.in[I_OWIN], DM, DIN, F_winT + (size_t)l * DIN * DM, scr, r, F.lane); continue; } r -= I_IN;
        if (r < I_OUT) { transpose_item(l == 0 ? F.in[I_EWOUT] : F.in[I_OWOUT], DM, DM, F_woutT + (size_t)l * DM * DM, scr, r, F.lane); continue; } r -= I_OUT;
        transpose_item(F.in[I_PWQ] + (size_t)l * DM * DPQ, DM, DPQ, F_wqT + (size_t)l * DPQ * DM, scr, r, F.lane);
    }
    for (int l = 0; l < 2; ++l) { cvt_stream(F.in[I_PK1] + l * 16384, F_keys + (l * 2 + 0) * 16384, 16384, F.gtid, F.ngt); cvt_stream(F.in[I_PK2] + l * 16384, F_keys + (l * 2 + 1) * 16384, 16384, F.gtid, F.ngt); }
}

__device__ __forceinline__ void fold_items(Frame& F, int l, int wi, int nw, int n0 = 0, int n1 = DPQ) {
    for (int n = n0 + wi; n < n1; n += nw) {
        const bf16* wr = F_wqT + ((size_t)l * DPQ + n) * DM; const float* gam = F.in[I_N2G] + l * DM;
        float wg[2][8], w[2][8];
#pragma unroll
        for (int q = 0; q < 2; ++q) { const int c = 8 * F.lane + 512 * q; const u32x4 ww = *(const u32x4*)(wr + c); const f32x4 g0 = *(const f32x4*)(gam + c), g1 = *(const f32x4*)(gam + c + 4);
            w[q][0] = bflo(ww.x); w[q][1] = bfhi(ww.x); w[q][2] = bflo(ww.y); w[q][3] = bfhi(ww.y); w[q][4] = bflo(ww.z); w[q][5] = bfhi(ww.z); w[q][6] = bflo(ww.w); w[q][7] = bfhi(ww.w);
#pragma unroll
            for (int k = 0; k < 4; ++k) { wg[q][k] = w[q][k] * g0[k]; wg[q][4 + k] = w[q][4 + k] * g1[k]; } }
#pragma unroll
        for (int m = 0; m < 5; ++m) { const float* sh = F_mod + ((size_t)l * 5 + m) * MODW + 3 * DM; const float* sc = sh + DM; float bs = 0.f;
#pragma unroll
            for (int q = 0; q < 2; ++q) { const int c = 8 * F.lane + 512 * q; const f32x4 s0a = *(const f32x4*)(sh + c), s0b = *(const f32x4*)(sh + c + 4), s1a = *(const f32x4*)(sc + c) + 1.f, s1b = *(const f32x4*)(sc + c + 4) + 1.f;
                u32x4 o; o.x = pk2(wg[q][0] * s1a[0], wg[q][1] * s1a[1]); o.y = pk2(wg[q][2] * s1a[2], wg[q][3] * s1a[3]); o.z = pk2(wg[q][4] * s1b[0], wg[q][5] * s1b[1]); o.w = pk2(wg[q][6] * s1b[2], wg[q][7] * s1b[3]);
                *(u32x4*)(F_wqb + (((size_t)l * 5 + m) * DPQ + n) * DM + c) = o;
#pragma unroll
                for (int k = 0; k < 4; ++k) bs += w[q][k] * s0a[k] + w[q][4 + k] * s0b[k]; }
            bs = wave_sum(bs);
            if (F.lane == 0) F_pqbias[((size_t)l * 5 + m) * DPQ + n] = bs; }
    }
}
__device__ __forceinline__ int octet_rank(int x, int bit) { const int r = x & 15; return (x >> 4) * 8 + (bit ? (r > 8 ? r - 8 : 0) : (r < 8 ? r : 8)); }
__device__ __forceinline__ int first_idle_wg(int ncol_tiles) { const int G = (int)gridDim.x, nw = 132 * ncol_tiles, rem = nw % G; return (rem != 0 && nw > G) ? rem : -1; }
__device__ __forceinline__ void fold_norm2(Frame& F) {
    if (first_idle_wg(DIN / 256) < 0) { fold_items(F, 0, F.gw, F.ngw); fold_items(F, 1, F.gw, F.ngw); }
    for (int i = ((int)gridDim.x - 1 - (int)blockIdx.x) * NTHR + F.tid; i < 2 * 5 * (DM / 8); i += F.ngt) {
        const int lm = i / (DM / 8), c = (i % (DM / 8)) * 8, l = lm / 5; const float* gam = F.in[I_N2G] + l * DM + c; const float* sh = F_mod + (size_t)lm * MODW + 3 * DM + c; const float* sc = sh + DM;
        const f32x4 g0 = *(const f32x4*)gam, g1 = *(const f32x4*)(gam + 4), a0 = *(const f32x4*)sc + 1.f, a1 = *(const f32x4*)(sc + 4) + 1.f, h0 = *(const f32x4*)sh, h1 = *(const f32x4*)(sh + 4);
        u32x4 og, oh; og.x = pk2(g0[0] * a0[0], g0[1] * a0[1]); og.y = pk2(g0[2] * a0[2], g0[3] * a0[3]); og.z = pk2(g1[0] * a1[0], g1[1] * a1[1]); og.w = pk2(g1[2] * a1[2], g1[3] * a1[3]);
        oh.x = pk2(h0[0], h0[1]); oh.y = pk2(h0[2], h0[3]); oh.z = pk2(h1[0], h1[1]); oh.w = pk2(h1[2], h1[3]);
        *(u32x4*)(F_gbs + (size_t)lm * 2 * DM + c) = og; *(u32x4*)(F_gbs + (size_t)lm * 2 * DM + DM + c) = oh;
        { const float* gt = F_mod + (size_t)lm * MODW + 5 * DM + c; const f32x4 t0 = *(const f32x4*)gt, t1 = *(const f32x4*)(gt + 4);
          u32x4 o; o.x = pk2(t0[0], t0[1]); o.y = pk2(t0[2], t0[3]); o.z = pk2(t1[0], t1[1]); o.w = pk2(t1[2], t1[3]); *(u32x4*)(F_g2b + (size_t)lm * DM + c) = o; }
        if (l == 1) { const int m = lm - 5; const float* g1 = F.in[I_N1G] + DM + c; const float* s0 = F_mod + (size_t)lm * MODW + c; const float* s1 = s0 + DM;
          const f32x4 p0 = *(const f32x4*)g1 * (*(const f32x4*)s1 + 1.f), p1 = *(const f32x4*)(g1 + 4) * (*(const f32x4*)(s1 + 4) + 1.f), q0 = *(const f32x4*)s0, q1 = *(const f32x4*)(s0 + 4);
          u32x4 o; o.x = pk2(p0[0], p0[1]); o.y = pk2(p0[2], p0[3]); o.z = pk2(p1[0], p1[1]); o.w = pk2(p1[2], p1[3]); *(u32x4*)(F_n1b + (size_t)m * 2 * DM + c) = o;
          o.x = pk2(q0[0], q0[1]); o.y = pk2(q0[2], q0[3]); o.z = pk2(q1[0], q1[1]); o.w = pk2(q1[2], q1[3]); *(u32x4*)(F_n1b + (size_t)m * 2 * DM + DM + c) = o; } }
}

template <int WHICH> __device__ __forceinline__ void norm_phase(Frame& F, int layer, bool from_input, bool skip_ctx, bool finalize_mod) {
    const float* gam = F.in[WHICH == 0 ? I_N1G : I_N2G] + layer * DM;
    LAS float* lmod = (LAS float*)F.lds;
    if (finalize_mod) {
        for (int i = F.tid * 4; i < 5 * 2048; i += NTHR * 4) { const int m = i >> 11, c = i & 2047; f32x4 a = *(const f32x4*)(F.in[I_ADAB] + c);
#pragma unroll
            for (int kc = 0; kc < 16; ++kc) a += *(const f32x4*)(F_part + ((size_t)(kc * 2) * 5 + m) * MODW + c);
            *(LAS f32x4*)(lmod + i) = a; }
        for (int o = F.gtid * 4; o < 2 * 5 * MODW; o += F.ngt * 4) { const int l = o / (5 * MODW), rem = o % (5 * MODW); f32x4 a = *(const f32x4*)(F.in[I_ADAB] + l * MODW + rem % MODW);
#pragma unroll
            for (int kc = 0; kc < 16; ++kc) a += *(const f32x4*)(F_part + (size_t)(kc * 2 + l) * 5 * MODW + rem);
            *(f32x4*)(F_mod + o) = a; }
        __syncthreads();
    }
    f32x4 gin[2][2] = {};
    if (from_input) {
#pragma unroll
        for (int q = 0; q < 2; ++q)
#pragma unroll
            for (int h = 0; h < 2; ++h) gin[q][h] = *(const f32x4*)(gam + 8 * F.lane + 512 * q + 4 * h); }
    if (from_input && finalize_mod && !skip_ctx) {
        ticket_reset(F);
        int r = (int)blockIdx.x + ticket_next(F) * (int)gridDim.x; f32x4 v[2][2] = {};
        if (r < NR) { int b, j; row_info(r, b, j); const float* xr = in_row(F, b, j);
#pragma unroll
            for (int q = 0; q < 2; ++q)
#pragma unroll
                for (int h = 0; h < 2; ++h) v[q][h] = *(const f32x4*)(xr + 8 * F.lane + 512 * q + 4 * h); }
        while (r < NR) {
            const int rn = (int)blockIdx.x + ticket_next(F) * (int)gridDim.x; f32x4 vn[2][2] = {};
            if (rn < NR) { int bn, jn; row_info(rn, bn, jn); const float* xr = in_row(F, bn, jn);
#pragma unroll
                for (int q = 0; q < 2; ++q)
#pragma unroll
                    for (int h = 0; h < 2; ++h) vn[q][h] = *(const f32x4*)(xr + 8 * F.lane + 512 * q + 4 * h); }
            int b, j; row_info(r, b, j); const int mi = j < CTXL ? 4 : b; bf16* orow = F_xn + (size_t)r * DM; float ss = 0.f;
#pragma unroll
            for (int q = 0; q < 2; ++q)
#pragma unroll
                for (int h = 0; h < 2; ++h) ss += (v[q][h].x * v[q][h].x + v[q][h].y * v[q][h].y) + (v[q][h].z * v[q][h].z + v[q][h].w * v[q][h].w);
            const float rstd = rsqrtf(wave_sum(ss) * (1.f / DM) + EPS);
#pragma unroll
            for (int q = 0; q < 2; ++q) { u32x4 o;
#pragma unroll
                for (int h = 0; h < 2; ++h) { const int c = 8 * F.lane + 512 * q + 4 * h; const f32x4 s0 = *(const LAS f32x4*)(lmod + mi * 2048 + c), s1 = *(const LAS f32x4*)(lmod + mi * 2048 + DM + c);
                    const f32x4 y = (v[q][h] * rstd * gin[q][h]) * (s1 + 1.f) + s0; o[2 * h] = pk2(y.x, y.y); o[2 * h + 1] = pk2(y.z, y.w); }
                *(u32x4*)(orow + 8 * F.lane + 512 * q) = o; }
            r = rn;
#pragma unroll
            for (int q = 0; q < 2; ++q)
#pragma unroll
                for (int h = 0; h < 2; ++h) v[q][h] = vn[q][h];
        }
        return;
    }
    ticket_reset(F);
    for (;;) {
        const int r = (int)blockIdx.x + ticket_next(F) * (int)gridDim.x; if (r >= NR) break;
        int b, j; row_info(r, b, j); if (skip_ctx && j < CTXL) continue;
        const int mi = j < CTXL ? 4 : b;
        const float* sh = F_mod + ((size_t)layer * 5 + mi) * MODW + (WHICH ? 3 * DM : 0); const float* sc = sh + DM;
        bf16* orow = F_xn + (size_t)r * DM;
        if (from_input) {
            const float* xr = in_row(F, b, j);
            f32x4 v[2][2]; float ss = 0.f;
#pragma unroll
            for (int q = 0; q < 2; ++q)
#pragma unroll
                for (int h = 0; h < 2; ++h) { v[q][h] = *(const f32x4*)(xr + 8 * F.lane + 512 * q + 4 * h); ss += (v[q][h].x * v[q][h].x + v[q][h].y * v[q][h].y) + (v[q][h].z * v[q][h].z + v[q][h].w * v[q][h].w); }
            const float rstd = rsqrtf(wave_sum(ss) * (1.f / DM) + EPS);
#pragma unroll
            for (int q = 0; q < 2; ++q) { u32x4 o;
#pragma unroll
                for (int h = 0; h < 2; ++h) { const int c = 8 * F.lane + 512 * q + 4 * h; f32x4 s1, s0;
                    if (finalize_mod) { s0 = *(const LAS f32x4*)(lmod + mi * 2048 + c); s1 = *(const LAS f32x4*)(lmod + mi * 2048 + DM + c); }
                    else { s1 = *(const f32x4*)(sc + c); s0 = *(const f32x4*)(sh + c); }
                    const f32x4 y = (v[q][h] * rstd * gin[q][h]) * (s1 + 1.f) + s0; o[2 * h] = pk2(y.x, y.y); o[2 * h + 1] = pk2(y.z, y.w); }
                *(u32x4*)(orow + 8 * F.lane + 512 * q) = o; }
        } else {
            const bf16* xr = F_xs + (size_t)r * DM;
            float v[2][8]; float ss = 0.f;
#pragma unroll
            for (int q = 0; q < 2; ++q) { const u32x4 w = *(const u32x4*)(xr + 8 * F.lane + 512 * q);
                v[q][0] = bflo(w.x); v[q][1] = bfhi(w.x); v[q][2] = bflo(w.y); v[q][3] = bfhi(w.y); v[q][4] = bflo(w.z); v[q][5] = bfhi(w.z); v[q][6] = bflo(w.w); v[q][7] = bfhi(w.w);
#pragma unroll
                for (int k = 0; k < 8; ++k) ss += v[q][k] * v[q][k]; }
            const float rstd = rsqrtf(wave_sum(ss) * (1.f / DM) + EPS);
#pragma unroll
            for (int q = 0; q < 2; ++q) { const int c = 8 * F.lane + 512 * q; u32x4 o;
#pragma unroll
                for (int hh = 0; hh < 2; ++hh) { const f32x4 g = *(const f32x4*)(gam + c + 4 * hh), s1 = *(const f32x4*)(sc + c + 4 * hh), s0 = *(const f32x4*)(sh + c + 4 * hh);
                    const f32x4 x4 = (f32x4){v[q][4 * hh], v[q][4 * hh + 1], v[q][4 * hh + 2], v[q][4 * hh + 3]}; const f32x4 y = (x4 * rstd * g) * (s1 + 1.f) + s0;
                    o[2 * hh] = pk2(y.x, y.y); o[2 * hh + 1] = pk2(y.z, y.w); }
                *(u32x4*)(orow + c) = o; }
        }
    }
}

__device__ __forceinline__ void khead_finish(bf16* p, const float* g, int t) {
    float x[64];
#pragma unroll
    for (int c = 0; c < 8; ++c) { const u32x4 w = *(const u32x4*)(p + 8 * c); x[8 * c] = bflo(w.x); x[8 * c + 1] = bfhi(w.x); x[8 * c + 2] = bflo(w.y); x[8 * c + 3] = bfhi(w.y); x[8 * c + 4] = bflo(w.z); x[8 * c + 5] = bfhi(w.z); x[8 * c + 6] = bflo(w.w); x[8 * c + 7] = bfhi(w.w); }
    if (g) { float ss = 0.f;
#pragma unroll
        for (int c = 0; c < 64; ++c) ss += x[c] * x[c];
        const float rs = rsqrtf(ss * (1.f / 64.f) + EPS);
#pragma unroll
        for (int c = 0; c < 64; ++c) x[c] = x[c] * rs * g[c]; }
    if (t >= 0) { const float pr = (float)(t >> 6), pc = (float)(t & 63);
#pragma unroll
        for (int c = 0; c < 16; ++c) {
            const float inv = exp2f(-(float)c * (13.287712379549449f / 16.f)) * 0.15915494309189535f;
            float rr = pr * inv, rc = pc * inv; rr -= floorf(rr); rc -= floorf(rc);
            const float sr = __builtin_amdgcn_sinf(rr), cr = __builtin_amdgcn_cosf(rr), sc_ = __builtin_amdgcn_sinf(rc), cc = __builtin_amdgcn_cosf(rc);
            const float a1 = x[c], a2 = x[16 + c]; x[c] = a1 * cr - a2 * sr; x[16 + c] = a1 * sr + a2 * cr;
            const float b1 = x[32 + c], b2 = x[48 + c]; x[32 + c] = b1 * cc - b2 * sc_; x[48 + c] = b1 * sc_ + b2 * cc; } }
#pragma unroll
    for (int c = 0; c < 8; ++c) { u32x4 w; w.x = pk2(x[8 * c], x[8 * c + 1]); w.y = pk2(x[8 * c + 2], x[8 * c + 3]); w.z = pk2(x[8 * c + 4], x[8 * c + 5]); w.w = pk2(x[8 * c + 6], x[8 * c + 7]); *(u32x4*)(p + 8 * c) = w; }
}
__device__ __forceinline__ void khead_finish8(bf16* p, const f32x4 g0, const f32x4 g1, bool hasg, int t, int j) {
#define KH_DPP(x, c) __int_as_float(__builtin_amdgcn_update_dpp(0, __float_as_int(x), (c), 0xf, 0xf, true))
    const u32x4 w = *(const u32x4*)p;
    float x[8] = {bflo(w.x), bfhi(w.x), bflo(w.y), bfhi(w.y), bflo(w.z), bfhi(w.z), bflo(w.w), bfhi(w.w)};
    if (hasg) { float ss = 0.f;
#pragma unroll
        for (int k = 0; k < 8; ++k) ss += x[k] * x[k];
        ss += KH_DPP(ss, 0xB1); ss += KH_DPP(ss, 0x4E); ss += KH_DPP(ss, 0x141);
        const float rs = rsqrtf(ss * (1.f / 64.f) + EPS);
#pragma unroll
        for (int k = 0; k < 4; ++k) { x[k] = x[k] * rs * g0[k]; x[4 + k] = x[4 + k] * rs * g1[k]; } }
    if (t >= 0) { const float pos = (j & 4) ? (float)(t & 63) : (float)(t >> 6), fsc = (j & 1) ? 0.01f : 1.f; const bool second = (j & 2) != 0;
#pragma unroll
        for (int k = 0; k < 8; ++k) {
            const float inv = exp2f(-(float)k * (13.287712379549449f / 16.f)) * 0.15915494309189535f;
            float r = pos * (inv * fsc); r -= floorf(r);
            const float sn = __builtin_amdgcn_sinf(r), cs = __builtin_amdgcn_cosf(r), pth = KH_DPP(x[k], 0x4E);
            x[k] = x[k] * cs + (second ? pth : -pth) * sn; } }
    u32x4 o; o.x = pk2(x[0], x[1]); o.y = pk2(x[2], x[3]); o.z = pk2(x[4], x[5]); o.w = pk2(x[6], x[7]); *(u32x4*)p = o;
#undef KH_DPP
}
namespace pg8 {
#define PG8_LAS __attribute__((address_space(3)))
typedef unsigned short bf16_t;
constexpr int BM = 256, BK = 64, HALF = 128, HTB = HALF * BK * 2, STAGE_BYTES = 8 * HTB, NXCD = 8, WGM = 8;
__host__ __device__ __forceinline__ int lds_byte(int r, int c) { const int st = (r >> 4) * 2 + (c >> 5), rr = r & 15, cc = c & 31, ob = rr * 64 + cc * 2; return st * 1024 + (ob ^ (((ob >> 9) & 1) << 5)); }
__host__ __device__ __forceinline__ void stage_rc(int b, int& R, int& C) { const int st = b / 1024, sb = b % 1024, swz = sb ^ (((sb >> 9) & 1) << 5); R = (st >> 1) * 16 + swz / 64; C = (st & 1) * 32 + (swz % 64) / 2; }
__host__ __device__ __forceinline__ int perm32(int rho) { const int n = rho >> 4, i = rho & 15; return 8 * (i >> 2) + 4 * n + (i & 3); }
struct Unit { int pm, pn, idx; };
struct Gemm { const bf16_t* A; const bf16_t* Bt; int M, N, K; size_t bstride; };
__device__ __forceinline__ size_t bvar(const Gemm& g, int pm) { return g.bstride ? (size_t)(pm % 33 == 0 ? 4 : pm / 33) * g.bstride : (size_t)0; }
struct Order {
    int nM, nN, nwg, G, c, skip; bf16_t* kfix; const float* kg;
    __device__ void init(int nM_, int N, int G_, int c_, int skip_) { nM = nM_; nN = N / BM; nwg = nM * nN; G = G_; c = c_; skip = skip_; kfix = nullptr; kg = nullptr; }
    __device__ bool next(int i, Unit& u) const {
        const long L = (long)i * G + c; if (L >= nwg) return false;
        int wgid = (int)L; { const int q = nwg / NXCD, r = nwg % NXCD, xcd = wgid % NXCD, off = wgid / NXCD; wgid = (xcd < r ? xcd * (q + 1) : r * (q + 1) + (xcd - r) * q) + off; }
        const int nig = WGM * nN, gid = wgid / nig, fm = gid * WGM, gsz = (nM - fm) < WGM ? (nM - fm) : WGM;
        u.pm = fm + ((wgid % nig) % gsz); u.pn = (wgid % nig) / gsz; u.idx = i;
        if (skip) u.pm += u.pm / 32 + 1;
        return true;
    }
    __device__ __forceinline__ void a_ready(const Unit&) const {}
    __device__ __forceinline__ void done(const Unit& u) const {
        if (kfix == nullptr || u.pn != 4) return;
        asm volatile("s_waitcnt vmcnt(0)" ::: "memory"); __builtin_amdgcn_s_barrier(); asm volatile("" ::: "memory");
        const int jt = u.pm % 33, j = threadIdx.x & 7; f32x4 g0 = (f32x4){1.f, 1.f, 1.f, 1.f}, g1 = g0; if (kg) { g0 = *(const f32x4*)(kg + 8 * j); g1 = *(const f32x4*)(kg + 8 * j + 4); }
#pragma unroll 4
        for (int it = threadIdx.x >> 3; it < 1024; it += 64) { const int rl = it >> 2, hh = it & 3; khead_finish8((bf16*)kfix + (size_t)(u.pm * BM + rl) * DIN + 1024 + hh * 64 + 8 * j, g0, g1, kg != nullptr, jt == 0 ? -1 : (jt - 1) * 256 + rl, j); }
    }
};
__device__ __forceinline__ unsigned cvt_pk_bf16(float lo, float hi) { unsigned r; asm volatile("v_cvt_pk_bf16_f32 %0, %1, %2" : "=v"(r) : "v"(lo), "v"(hi)); return r; }
__device__ __forceinline__ void line_pair(const u32x4& w0, const u32x4& w1, u32x4& lo8, u32x4& hi8) {
#pragma unroll
    for (int k = 0; k < 4; ++k) { lo8[k] = (unsigned)__builtin_amdgcn_update_dpp((int)w0[k], (int)w1[k], 0x128, 0xf, 0xc, false);
                                  hi8[k] = (unsigned)__builtin_amdgcn_update_dpp((int)w1[k], (int)w0[k], 0x128, 0xf, 0x3, false); }
}
struct EpiBf16 {
    static constexpr bool PERM = true, AFTER_DRAIN = false;
    bf16_t* O; int ldc;
    __device__ __forceinline__ void operator()(const f32x4 (&acc)[2][2][4][2], const Unit& u, int wr, int wc, int fr, int fq) const {
        const int rowA = u.pm * BM + wr * 64 + (fr & 7), colx = u.pn * BM + wc * 64 + 32 * (fr >> 3) + 8 * fq;
#pragma unroll
        for (int ai = 0; ai < 2; ++ai)
#pragma unroll
            for (int m = 0; m < 4; ++m) { u32x4 w[2];
#pragma unroll
                for (int bj = 0; bj < 2; ++bj) { const f32x4 v0 = acc[ai][bj][m][0], v1 = acc[ai][bj][m][1];
                    w[bj].x = cvt_pk_bf16(v0[0], v0[1]); w[bj].y = cvt_pk_bf16(v0[2], v0[3]); w[bj].z = cvt_pk_bf16(v1[0], v1[1]); w[bj].w = cvt_pk_bf16(v1[2], v1[3]); }
                u32x4 lo8, hi8; line_pair(w[0], w[1], lo8, hi8);
                bf16_t* rowp = O + (size_t)(rowA + ai * HALF + m * 16) * ldc + colx;
                *(u32x4*)rowp = lo8; *(u32x4*)(rowp + (size_t)8 * ldc) = hi8; }
    }
};
template <bool FROM_INPUT> struct EpiResid16T {
    static constexpr bool PERM = true, AFTER_DRAIN = false;
    const float* x_in; const float* ctx_in; bf16_t* xs; const float* gate; float* ssp;
    __device__ __forceinline__ void operator()(const f32x4 (&acc)[2][2][4][2], const Unit& u, int wr, int wc, int fr, int fq) const {
        const int b = u.pm / 33, jt = u.pm - b * 33; const bool isc = jt == 0;
        const float* g = gate + (size_t)(isc ? 4 : b) * MODW; const int col0 = u.pn * BM + wc * 64 + 8 * fq;
        const float* srcb = isc ? ctx_in + (size_t)b * CTXL * DM : x_in + ((size_t)b * SEQ + (size_t)(jt - 1) * 256) * DM;
        f32x4 gv[2][2];
#pragma unroll
        for (int bj = 0; bj < 2; ++bj)
#pragma unroll
            for (int n = 0; n < 2; ++n) gv[bj][n] = *(const f32x4*)(g + col0 + bj * 32 + 4 * n);
        f32x4 nf[2][2]; u32x4 nw[2];
#define RESID_LOAD(blk) do { const int _rl = ((blk) >> 2) * HALF + wr * 64 + ((blk) & 3) * 16 + fr; \
            if (FROM_INPUT) { const float* _sp = srcb + (size_t)_rl * DM + col0; nf[0][0] = *(const f32x4*)_sp; nf[0][1] = *(const f32x4*)(_sp + 4); nf[1][0] = *(const f32x4*)(_sp + 32); nf[1][1] = *(const f32x4*)(_sp + 36); } \
            else { const bf16_t* _xp = xs + ((size_t)u.pm * BM + _rl) * DM + col0; nw[0] = *(const u32x4*)_xp; nw[1] = *(const u32x4*)(_xp + 32); } } while (0)
        RESID_LOAD(0);
#pragma unroll
        for (int blk = 0; blk < 8; ++blk) { const int ai = blk >> 2, m = blk & 3; float ssq = 0.f; u32x4 ow[2];
            f32x4 cf[2][2]; u32x4 cw[2];
#pragma unroll
            for (int bj = 0; bj < 2; ++bj) { cf[bj][0] = nf[bj][0]; cf[bj][1] = nf[bj][1]; cw[bj] = nw[bj]; }
            if (blk < 7) RESID_LOAD(blk + 1);
#pragma unroll
            for (int bj = 0; bj < 2; ++bj) { f32x4 b0, b1;
                if (FROM_INPUT) { b0 = cf[bj][0]; b1 = cf[bj][1]; }
                else { const u32x4 w = cw[bj]; b0 = (f32x4){__uint_as_float(w.x << 16), __uint_as_float(w.x & 0xffff0000u), __uint_as_float(w.y << 16), __uint_as_float(w.y & 0xffff0000u)};
                    b1 = (f32x4){__uint_as_float(w.z << 16), __uint_as_float(w.z & 0xffff0000u), __uint_as_float(w.w << 16), __uint_as_float(w.w & 0xffff0000u)}; }
                const f32x4 v0 = b0 + gv[bj][0] * acc[ai][bj][m][0], v1 = b1 + gv[bj][1] * acc[ai][bj][m][1];
                u32x4 o; o.x = cvt_pk_bf16(v0[0], v0[1]); o.y = cvt_pk_bf16(v0[2], v0[3]); o.z = cvt_pk_bf16(v1[0], v1[1]); o.w = cvt_pk_bf16(v1[2], v1[3]);
                ow[bj] = o;
                const f32x4 r0 = (f32x4){__uint_as_float(o.x << 16), __uint_as_float(o.x & 0xffff0000u), __uint_as_float(o.y << 16), __uint_as_float(o.y & 0xffff0000u)}, r1 = (f32x4){__uint_as_float(o.z << 16), __uint_as_float(o.z & 0xffff0000u), __uint_as_float(o.w << 16), __uint_as_float(o.w & 0xffff0000u)};
                ssq += ((r0[0] * r0[0] + r0[1] * r0[1]) + (r0[2] * r0[2] + r0[3] * r0[3])) + ((r1[0] * r1[0] + r1[1] * r1[1]) + (r1[2] * r1[2] + r1[3] * r1[3])); }
            { u32x4 lo8, hi8; line_pair(ow[0], ow[1], lo8, hi8);
              bf16_t* sp8 = xs + ((size_t)u.pm * BM + ai * HALF + wr * 64 + m * 16 + (fr & 7)) * DM + col0 + 32 * (fr >> 3); *(u32x4*)sp8 = lo8; *(u32x4*)(sp8 + (size_t)8 * DM) = hi8; }
            ssq = xrow_sum(ssq);
            if (fq == 0) *(float*)((char*)ssp + ((unsigned)(((u.pm * BM + wr * 64 + fr) * 16 + 4 * u.pn + wc) * 4) + (unsigned)((ai * HALF + m * 16) * 64))) = ssq; }
#undef RESID_LOAD
    }
};
struct EpiPQ {
    static constexpr bool PERM = true, AFTER_DRAIN = false;
    bf16_t* O; int ldc; const float* bias; PG8_LAS float* rl;
    __device__ __forceinline__ void operator()(const f32x4 (&acc)[2][2][4][2], const Unit& u, int wr, int wc, int fr, int fq) const {
        const int b = u.pm / 33, jt = u.pm - b * 33; const float* bb = bias + (size_t)(jt == 0 ? 4 : b) * 2048 + u.pn * BM + wc * 64 + 8 * fq;
        f32x4 bv[2][2];
#pragma unroll
        for (int bj = 0; bj < 2; ++bj) { bv[bj][0] = *(const f32x4*)(bb + bj * 32); bv[bj][1] = *(const f32x4*)(bb + bj * 32 + 4); }
        const int rowA = u.pm * BM + wr * 64 + (fr & 7), colx = u.pn * BM + wc * 64 + 32 * (fr >> 3) + 8 * fq; const PG8_LAS float* rlu = rl + u.idx * BM;
#pragma unroll
        for (int ai = 0; ai < 2; ++ai)
#pragma unroll
            for (int m = 0; m < 4; ++m) { const int rloc = wr * 64 + fr + ai * HALF + m * 16; const float rstd = rlu[rloc]; bf16_t* rowp = O + (size_t)(rowA + ai * HALF + m * 16) * ldc + colx; u32x4 ww[2];
#pragma unroll
                for (int bj = 0; bj < 2; ++bj) { const f32x4 v0 = acc[ai][bj][m][0] * rstd + bv[bj][0], v1 = acc[ai][bj][m][1] * rstd + bv[bj][1];
                    u32x4 w; w.x = cvt_pk_bf16(v0[0], v0[1]); w.y = cvt_pk_bf16(v0[2], v0[3]); w.z = cvt_pk_bf16(v1[0], v1[1]); w.w = cvt_pk_bf16(v1[2], v1[3]);
                    ww[bj] = w; }
                u32x4 lo8, hi8; line_pair(ww[0], ww[1], lo8, hi8); *(u32x4*)rowp = lo8; *(u32x4*)(rowp + (size_t)8 * ldc) = hi8; }
    }
};
constexpr int PQ_RL_UNITS = 9;
template <class Sched> __device__ __forceinline__ void pq_rstd_fill(PG8_LAS float* rl, const float* ssp, const Sched& S) {
    const int tid = threadIdx.x; Unit u;
    if (tid < BM) {
#pragma unroll
        for (int i = 0; i < PQ_RL_UNITS; ++i) { if (!S.next(i, u)) break; const float* sp = ssp + ((size_t)u.pm * BM + tid) * 16;
            const f32x4 s0 = *(const f32x4*)sp, s1 = *(const f32x4*)(sp + 4), s2 = *(const f32x4*)(sp + 8), s3 = *(const f32x4*)(sp + 12);
            const float ss = (((s0[0] + s0[1]) + (s0[2] + s0[3])) + ((s1[0] + s1[1]) + (s1[2] + s1[3]))) + (((s2[0] + s2[1]) + (s2[2] + s2[3])) + ((s3[0] + s3[1]) + (s3[2] + s3[3])));
            rl[i * BM + tid] = rsqrtf(ss * (1.f / DM) + EPS); } }
    __syncthreads();
}
template <class Epi, class Sched, bool ALIGN_EPI = false, bool SP2 = false>
__device__ __forceinline__ void gemm_phase(PG8_LAS unsigned char* lds, const Gemm g, const Sched& S, const Epi& E) {
    const int tid = threadIdx.x, wid = __builtin_amdgcn_readfirstlane(tid >> 6), lane = tid & 63, wr = wid >> 2, wc = wid & 3, fr = lane & 15, fq = lane >> 4;
    const int K = g.K, nt = K / BK;
    unsigned voffA[2], voffB[2];
#pragma unroll
    for (int i = 0; i < 2; ++i) { int R, C; stage_rc(tid * 16 + i * 8192, R, C); const int Rb = Epi::PERM ? (64 * (R >> 5) + perm32(R & 31)) : R;
        voffA[i] = (unsigned)(R * K + C) * 2u; voffB[i] = (unsigned)(Rb * K + C) * 2u; }
    const size_t kstep = (size_t)(BK * 2);
    const size_t hstep = (size_t)HALF * K * 2;
    const size_t tstep = 2 * hstep;
    const size_t hstepB = Epi::PERM ? (size_t)32 * K * 2 : hstep;
    const unsigned ldsw = (unsigned)wid * 1024u;
    const int aoff = lds_byte(wr * 64 + fr, fq * 8), boff = lds_byte(wc * 32 + fr, fq * 8);
#define PG8_SA(b, h) (((b) * 2 + (h)) * HTB)
#define PG8_SB(b, h) ((4 + (b) * 2 + (h)) * HTB)
#define PG8_STAGE(bufoff, gbase, voff) do { _Pragma("unroll") for (int _i = 0; _i < 2; ++_i) \
        __builtin_amdgcn_global_load_lds((const unsigned*)((const char*)(gbase) + (voff)[_i]), (PG8_LAS unsigned*)(lds + (bufoff) + ldsw + _i * 8192), 16, 0, 0); } while (0)
#define PG8_LDA(dst, b, h) do { _Pragma("unroll") for (int m = 0; m < 4; ++m) _Pragma("unroll") for (int k = 0; k < 2; ++k) dst[m][k] = *(const PG8_LAS bf16x8*)(lds + PG8_SA(b, h) + aoff + m * 2048 + k * 1024); } while (0)
#define PG8_LDB(dst, b, h) do { _Pragma("unroll") for (int n = 0; n < 2; ++n) _Pragma("unroll") for (int k = 0; k < 2; ++k) dst[n][k] = *(const PG8_LAS bf16x8*)(lds + PG8_SB(b, h) + boff + n * 2048 + k * 1024); } while (0)
#define PG8_MMA(ai, bj, At, Bt) do { __builtin_amdgcn_s_setprio(1); _Pragma("unroll") for (int m = 0; m < 4; ++m) _Pragma("unroll") for (int n = 0; n < 2; ++n) _Pragma("unroll") for (int k = 0; k < 2; ++k) \
        acc[ai][bj][m][n] = __builtin_amdgcn_mfma_f32_16x16x32_bf16(Bt[n][k], At[m][k], acc[ai][bj][m][n], 0, 0, 0); __builtin_amdgcn_s_setprio(0); } while (0)
#define PG8_WAIT_V(n) asm volatile("s_waitcnt vmcnt(" #n ")" ::: "memory")
#define PG8_WAIT_L(n) asm volatile("s_waitcnt lgkmcnt(" #n ")" ::: "memory")
#define PG8_BAR __builtin_amdgcn_s_barrier()
#define PG8_SCHED __builtin_amdgcn_sched_barrier(0)
    Unit cur, nxt; int ui = 0;
    if (!S.next(0, cur)) return;
    f32x4 acc[2][2][4][2];
#pragma unroll
    for (int a = 0; a < 2; ++a)
#pragma unroll
        for (int b = 0; b < 2; ++b)
#pragma unroll
            for (int m = 0; m < 4; ++m)
#pragma unroll
                for (int n = 0; n < 2; ++n) acc[a][b][m][n] = (f32x4){0.f, 0.f, 0.f, 0.f};
    bf16x8 At[4][2], B0[2][2], B1[2][2];
    const char* cA = (const char*)g.A + (size_t)cur.pm * tstep; const char* cB = (const char*)g.Bt + (size_t)cur.pn * tstep + bvar(g, cur.pm);
    S.a_ready(cur);
    if constexpr (SP2) {
        PG8_STAGE(PG8_SB(0, 0), cB, voffB); PG8_STAGE(PG8_SB(0, 1), cB + hstepB, voffB); PG8_STAGE(PG8_SA(0, 0), cA, voffA); PG8_STAGE(PG8_SA(0, 1), cA + hstep, voffA);
        if (wr == 1) PG8_BAR;
        PG8_WAIT_V(2); PG8_BAR;
        PG8_STAGE(PG8_SB(1, 0), cB + kstep, voffB); PG8_STAGE(PG8_SA(1, 0), cA + kstep, voffA); PG8_STAGE(PG8_SB(1, 1), cB + hstepB + kstep, voffB);
        PG8_WAIT_V(6); PG8_BAR;
    } else {
        PG8_STAGE(PG8_SB(0, 0), cB, voffB); PG8_STAGE(PG8_SA(0, 0), cA, voffA); PG8_STAGE(PG8_SB(0, 1), cB + hstepB, voffB); PG8_STAGE(PG8_SA(0, 1), cA + hstep, voffA);
        if (wr == 1) PG8_BAR;
        PG8_WAIT_V(4); PG8_BAR;
        PG8_STAGE(PG8_SB(1, 0), cB + kstep, voffB); PG8_STAGE(PG8_SA(1, 0), cA + kstep, voffA); PG8_STAGE(PG8_SB(1, 1), cB + hstepB + kstep, voffB);
        PG8_WAIT_V(6); PG8_BAR;
    }
    for (;;) {
        const bool has_next = S.next(ui + 1, nxt);
        const char* nA = has_next ? (const char*)g.A + (size_t)nxt.pm * tstep : cA; const char* nB = has_next ? (const char*)g.Bt + (size_t)nxt.pn * tstep + bvar(g, nxt.pm) : cB;
        for (int t = 0; t < nt; t += 2) {
            const bool last = (t == nt - 2);
            const char* a1 = cA + (size_t)(t + 1) * kstep;
            const char* a2 = last ? nA : cA + (size_t)(t + 2) * kstep; const char* b2 = last ? nB : cB + (size_t)(t + 2) * kstep;
            const char* a3 = a2 + kstep; const char* b3 = b2 + kstep;
            if (last && has_next) S.a_ready(nxt);
            if constexpr (SP2) {
            PG8_LDB(B0, 0, 0); PG8_LDB(B1, 0, 1); PG8_SCHED; PG8_LDA(At, 0, 0); PG8_STAGE(PG8_SA(1, 1), a1 + hstep, voffA);
            PG8_WAIT_V(8); PG8_WAIT_L(0); PG8_BAR; PG8_MMA(0, 0, At, B0); PG8_MMA(0, 1, At, B1); PG8_BAR; PG8_SCHED;
            PG8_LDA(At, 0, 1); PG8_STAGE(PG8_SB(0, 0), b2, voffB); PG8_STAGE(PG8_SB(0, 1), b2 + hstepB, voffB); PG8_STAGE(PG8_SA(0, 0), a2, voffA);
            PG8_WAIT_V(8); PG8_WAIT_L(0); PG8_BAR; PG8_MMA(1, 0, At, B0); PG8_MMA(1, 1, At, B1); PG8_BAR; PG8_SCHED;
            PG8_LDB(B0, 1, 0); PG8_LDB(B1, 1, 1); PG8_SCHED; PG8_LDA(At, 1, 0); PG8_STAGE(PG8_SA(0, 1), a2 + hstep, voffA);
            PG8_WAIT_V(8); PG8_WAIT_L(0); PG8_BAR; PG8_MMA(0, 0, At, B0); PG8_MMA(0, 1, At, B1); PG8_BAR; PG8_SCHED;
            PG8_LDA(At, 1, 1); PG8_STAGE(PG8_SB(1, 0), b3, voffB); PG8_STAGE(PG8_SB(1, 1), b3 + hstepB, voffB); PG8_STAGE(PG8_SA(1, 0), a3, voffA);
            PG8_WAIT_V(8); PG8_WAIT_L(0); PG8_BAR; PG8_MMA(1, 0, At, B0); PG8_MMA(1, 1, At, B1); PG8_BAR; PG8_SCHED;
            } else {
            PG8_LDB(B0, 0, 0); PG8_SCHED; PG8_LDA(At, 0, 0); PG8_STAGE(PG8_SA(1, 1), a1 + hstep, voffA);
            PG8_WAIT_L(8); PG8_BAR; PG8_WAIT_L(0); PG8_MMA(0, 0, At, B0); PG8_BAR; PG8_SCHED;
            PG8_LDB(B1, 0, 1); PG8_STAGE(PG8_SB(0, 0), b2, voffB);
            PG8_BAR; PG8_WAIT_L(0); PG8_MMA(0, 1, At, B1); PG8_BAR;
            PG8_LDA(At, 0, 1); PG8_STAGE(PG8_SA(0, 0), a2, voffA);
            PG8_BAR; PG8_WAIT_L(0); PG8_MMA(1, 0, At, B0); PG8_BAR; PG8_SCHED;
            PG8_STAGE(PG8_SB(0, 1), b2 + hstepB, voffB);
            PG8_WAIT_V(6); PG8_BAR; PG8_MMA(1, 1, At, B1); PG8_BAR;
            PG8_LDB(B0, 1, 0); PG8_SCHED; PG8_LDA(At, 1, 0); PG8_STAGE(PG8_SA(0, 1), a2 + hstep, voffA);
            PG8_WAIT_L(8); PG8_BAR; PG8_WAIT_L(0); PG8_MMA(0, 0, At, B0); PG8_BAR; PG8_SCHED;
            PG8_LDB(B1, 1, 1); PG8_STAGE(PG8_SB(1, 0), b3, voffB);
            PG8_BAR; PG8_WAIT_L(0); PG8_MMA(0, 1, At, B1); PG8_BAR;
            PG8_LDA(At, 1, 1); PG8_STAGE(PG8_SA(1, 0), a3, voffA);
            PG8_BAR; PG8_WAIT_L(0); PG8_MMA(1, 0, At, B0); PG8_BAR; PG8_SCHED;
            PG8_STAGE(PG8_SB(1, 1), b3 + hstepB, voffB);
            PG8_WAIT_V(6); PG8_BAR; PG8_MMA(1, 1, At, B1); PG8_BAR;
            }
        }
        if constexpr (ALIGN_EPI) { if (wr == 0) PG8_BAR; }
        if constexpr (!Epi::AFTER_DRAIN) { E(acc, cur, wr, wc, fr, fq); S.done(cur); }
        if (!has_next) break;
#pragma unroll
        for (int a = 0; a < 2; ++a)
#pragma unroll
            for (int b = 0; b < 2; ++b)
#pragma unroll
                for (int m = 0; m < 4; ++m)
#pragma unroll
                    for (int n = 0; n < 2; ++n) acc[a][b][m][n] = (f32x4){0.f, 0.f, 0.f, 0.f};
        cur = nxt; cA = nA; cB = nB; ++ui;
        if constexpr (ALIGN_EPI) { if (wr == 1) PG8_BAR; }
    }
    PG8_WAIT_V(0);
    if constexpr (!ALIGN_EPI) { if (wr == 0) PG8_BAR; }
    PG8_BAR;
    if constexpr (Epi::AFTER_DRAIN) { E.fused(acc, cur, wr, wc, fr, fq, lds, wid, lane); S.done(cur); }
#undef PG8_SA
#undef PG8_SB
#undef PG8_STAGE
#undef PG8_LDA
#undef PG8_LDB
#undef PG8_MMA
#undef PG8_WAIT_V
#undef PG8_WAIT_L
#undef PG8_BAR
#undef PG8_SCHED
}
}

#include <hip/hip_bf16.h>
#include <cmath>
namespace attn_body {
using bf16=__hip_bfloat16;
using bf16x8=__attribute__((ext_vector_type(8)))short;
using s16x4=__attribute__((ext_vector_type(4)))short;
using f32x16=__attribute__((ext_vector_type(16)))float;
using u32x4=__attribute__((ext_vector_type(4)))unsigned;
constexpr int D=64,PQKV=1536,PO=1024;
constexpr int NW=8,QBLK=32,QB=QBLK*NW,KVBLK=64;
__device__ __forceinline__ int crow(int r,int hi){return (r&3)+8*(r>>2)+4*hi;}
#define SBAR() __builtin_amdgcn_sched_barrier(0)
__device__ __forceinline__ void wmask(f32x16&p0,f32x16&p1,int dq,int hi){
  const float NEG=-INFINITY; const int d0=dq+4*hi;
  #pragma unroll
  for(int r=0;r<16;++r){const int d=d0+(r&3)+8*(r>>2); if(d>128||d<-128)p0[r]=NEG; if(d+32>128||d+32<-128)p1[r]=NEG;}
}

constexpr int NSLOT=3, SLOTB=8192;
constexpr int LDS_K=0, LDS_V=NSLOT*SLOTB, LDS_WS=2*NSLOT*SLOTB, LDS_OST=LDS_WS+NW*64*4, LDS_BYTES=LDS_OST+NW*4096;
constexpr float C2=0.125f*1.4426950408889634f;
__device__ __forceinline__ void glds16(const void*gsrc,unsigned lds_dst){unsigned keep;
  asm volatile("s_mov_b32 %0, m0\n\ts_mov_b32 m0, %2\n\ts_nop 0\n\tglobal_load_lds_dwordx4 %1, off\n\ts_mov_b32 m0, %0":"=&s"(keep):"v"(gsrc),"s"(lds_dst):"memory");}
__device__ __forceinline__ float max3f(float a,float b,float c){float r;asm("v_max3_f32 %0, %1, %2, %3":"=v"(r):"v"(a),"v"(b),"v"(c));return r;}
__device__ __forceinline__ float max2f(float a,float b){float r;asm("v_max_f32_e32 %0, %1, %2":"=v"(r):"v"(a),"v"(b));return r;}
__device__ __forceinline__ float fadd_s(float a,float b){float r;asm("v_add_f32_e32 %0, %1, %2":"=v"(r):"v"(a),"v"(b));return r;}
__device__ __forceinline__ float fsub_s(float a,float b){float r;asm("v_sub_f32_e32 %0, %1, %2":"=v"(r):"v"(a),"v"(b));return r;}
typedef float f32x2_t __attribute__((ext_vector_type(2))); typedef __bf16 bf16x2_t __attribute__((ext_vector_type(2)));
__device__ __forceinline__ unsigned cvtpk_s(float lo,float hi){f32x2_t v={lo,hi};bf16x2_t b=__builtin_convertvector(v,bf16x2_t);return __builtin_bit_cast(unsigned,b);}
#define WAIT_BAR(N) asm volatile("s_waitcnt vmcnt(" #N ") lgkmcnt(0)\n\ts_barrier":::"memory")

__device__ __forceinline__ void qkt(f32x16&p0,f32x16&p1,const char*Kslot,const bf16x8*qr,const f32x16&negm,int r32,int hi){
  const char*kb=Kslot+r32*128; const int sw=r32&7;
  #pragma unroll
  for(int d0=0;d0<4;++d0){
    const int off=((2*d0+hi)^sw)<<4;
    const bf16x8 b0=*reinterpret_cast<const bf16x8*>(kb+off);
    const bf16x8 b1=*reinterpret_cast<const bf16x8*>(kb+off+4096);
    if(d0==0){p0=__builtin_amdgcn_mfma_f32_32x32x16_bf16(b0,qr[0],negm,0,0,0);p1=__builtin_amdgcn_mfma_f32_32x32x16_bf16(b1,qr[0],negm,0,0,0);}
    else{p0=__builtin_amdgcn_mfma_f32_32x32x16_bf16(b0,qr[d0],p0,0,0,0);p1=__builtin_amdgcn_mfma_f32_32x32x16_bf16(b1,qr[d0],p1,0,0,0);}}
}
typedef __attribute__((address_space(3))) const char* lds_cptr;
typedef short v4i16_t __attribute__((ext_vector_type(4)));
__device__ __forceinline__ void kload2(bf16x8*kf,lds_cptr kp,const int*koff,int j){ kf[2*j]=*(const __attribute__((address_space(3))) bf16x8*)(kp+koff[j]); kf[2*j+1]=*(const __attribute__((address_space(3))) bf16x8*)(kp+koff[j]+4096); }
__device__ __forceinline__ void kload8(bf16x8*kf,lds_cptr kp,const int*koff){ kload2(kf,kp,koff,0); kload2(kf,kp,koff,1); kload2(kf,kp,koff,2); kload2(kf,kp,koff,3); }
__device__ __forceinline__ s16x4 vtr(lds_cptr p){ return __builtin_bit_cast(s16x4,__builtin_amdgcn_ds_read_tr16_b64_v4i16((__attribute__((address_space(3))) v4i16_t*)p)); }
__device__ __forceinline__ float rowmax(const f32x16&p0,const f32x16&p1){
  float a=max3f(p0[0],p0[1],p1[0]),b=max3f(p0[2],p0[3],p1[1]);a=max3f(a,p1[2],p1[3]);
  #pragma unroll
  for(int r=4;r<16;r+=4){a=max3f(a,p0[r],p0[r+1]);b=max3f(b,p0[r+2],p0[r+3]);a=max3f(a,p1[r],p1[r+1]);b=max3f(b,p1[r+2],p1[r+3]);}
  const float m=max2f(a,b);
  auto rr=__builtin_amdgcn_permlane32_swap(__float_as_uint(m),__float_as_uint(m),false,false);
  return max2f(__uint_as_float(rr[0]),__uint_as_float(rr[1]));
}
__device__ __forceinline__ void pv(f32x16*o,int vbA,int vbB,bf16x8 pa0,bf16x8 pa1,bf16x8 pa2,bf16x8 pa3){
  #pragma unroll
  for(int d0=0;d0<2;++d0){s16x4 lo[4],hi[4]; const int vb=d0?vbB:vbA;
    #pragma unroll
    for(int ks=0;ks<4;++ks){
      asm volatile("ds_read_b64_tr_b16 %0,%1 offset:%c2":"=&v"(lo[ks]):"v"(vb),"i"(ks*2048):"memory");
      asm volatile("ds_read_b64_tr_b16 %0,%1 offset:%c2":"=&v"(hi[ks]):"v"(vb),"i"(ks*2048+1024):"memory");}
    asm volatile("s_waitcnt lgkmcnt(0)":::"memory");SBAR();
    #define PK(k) (bf16x8){lo[k][0],lo[k][1],lo[k][2],lo[k][3],hi[k][0],hi[k][1],hi[k][2],hi[k][3]}
    o[d0]=__builtin_amdgcn_mfma_f32_32x32x16_bf16(pa0,PK(0),o[d0],0,0,0);
    o[d0]=__builtin_amdgcn_mfma_f32_32x32x16_bf16(pa1,PK(1),o[d0],0,0,0);
    o[d0]=__builtin_amdgcn_mfma_f32_32x32x16_bf16(pa2,PK(2),o[d0],0,0,0);
    o[d0]=__builtin_amdgcn_mfma_f32_32x32x16_bf16(pa3,PK(3),o[d0],0,0,0);
    #undef PK
  }
}

#ifndef ATTN_STORE16
#define ATTN_STORE16(p,v) (*(u32x4*)(p)=(v))
#endif
template<int THRL,bool WIN,int QMODE,bool FAST=false,bool GQ4=false> __device__ __forceinline__ void attn_unit(const bf16*Qu,const bf16*__restrict__ Kh,const bf16*__restrict__ Vh,bf16*Ou,const int NT,const int jump,const int qpos0,float sink2,const float*qg,const bool qrope,char*shm,const float*sinks=nullptr,const bf16*Knext=nullptr,const bool kpre=false){
  const int tid=threadIdx.x,lane=tid&63,r32=lane&31,hi=lane>>5; const int wid=__builtin_amdgcn_readfirstlane(tid>>6);
  const int qb_=GQ4?(wid&1):wid, hoff_=GQ4?(wid>>1)*64:0;
  if(GQ4)sink2=sinks[wid>>1]*1.4426950408889634f;
  const bf16*Qw=Qu+(long)(qb_*QBLK)*PQKV+hoff_;
  const unsigned lds0=(unsigned)(uintptr_t)shm;
  float*wsf=(float*)(shm+LDS_WS)+wid*64;
  const int krow_=8*wid+(lane>>3); const bf16*ksrc=Kh+(long)krow_*PQKV+(((lane&7)^(krow_&7))*8);
  const bf16*vsrc=Vh+(long)krow_*PQKV+(((lane&7)^(krow_&7))*8);
  const unsigned kdst=lds0+LDS_K+wid*1024, vdst=lds0+LDS_V+wid*1024;
  #define KROW(t) ((long)(t)*KVBLK+((t)>=4?jump:0))
  #define DMA_K(t,slot) glds16(ksrc+KROW(t)*PQKV,(unsigned)__builtin_amdgcn_readfirstlane(kdst+(slot)))
  #define DMA_V(t,slot) glds16(vsrc+KROW(t)*PQKV,(unsigned)__builtin_amdgcn_readfirstlane(vdst+(slot)))
  const int vrs_=4*hi+((lane&15)>>2), vch_=((lane>>4)&1)*2+((lane&3)>>1);
  const int voffA_=vrs_*128+(((vch_)^vrs_)<<4)+(lane&1)*8, voffB_=vrs_*128+(((4+vch_)^vrs_)<<4)+(lane&1)*8;
  const int vb0A=(int)(lds0+LDS_V)+voffA_, vb0B=(int)(lds0+LDS_V)+voffB_;
  const char*Kbase=shm+LDS_K; bf16x8 kf[8];
  const lds_cptr shm3=(lds_cptr)shm; const lds_cptr kp0=shm3+LDS_K+r32*128; const int koff[4]={((0+hi)^(r32&7))<<4,((2+hi)^(r32&7))<<4,((4+hi)^(r32&7))<<4,((6+hi)^(r32&7))<<4}; const lds_cptr vp0A=shm3+LDS_V+voffA_, vp0B=shm3+LDS_V+voffB_;
  if(!kpre){DMA_K(0,0);} DMA_V(0,0); if(!kpre){DMA_K(1,SLOTB);}
  bf16x8 qr[4];
  #pragma unroll
  for(int d0=0;d0<4;++d0)qr[d0]=*reinterpret_cast<const bf16x8*>(&Qw[(long)r32*PQKV+d0*16+hi*8]);
  if(!kpre){DMA_K(2,2*SLOTB);}
  if(QMODE){ float x[32];
    #pragma unroll
    for(int d0=0;d0<4;++d0){
      #pragma unroll
      for(int j=0;j<8;++j)x[8*d0+j]=__uint_as_float(((unsigned)(unsigned short)qr[d0][j])<<16);}
    if(QMODE==2){ float ss=0.f;
      #pragma unroll
      for(int i=0;i<32;++i)ss+=x[i]*x[i];
      ss+=__shfl_xor(ss,32); const float rs=rsqrtf(ss*(1.f/64.f)+1e-6f);
      #pragma unroll
      for(int d0=0;d0<4;++d0){
        #pragma unroll
        for(int j=0;j<8;++j)x[8*d0+j]*=rs*qg[16*d0+8*hi+j];} }
    if(qrope){ const int t=qpos0+qb_*QBLK+r32; const float pr=(float)(t>>6),pc=(float)(t&63);
      #pragma unroll
      for(int j=0;j<8;++j){ const float inv=exp2f(-(float)(8*hi+j)*(13.287712379549449f/16.f))*0.15915494309189535f;
        float rr=pr*inv,rc=pc*inv; rr-=floorf(rr); rc-=floorf(rc);
        const float sr=__builtin_amdgcn_sinf(rr),cr=__builtin_amdgcn_cosf(rr),sc=__builtin_amdgcn_sinf(rc),cc=__builtin_amdgcn_cosf(rc);
        const float a1=x[j],a2=x[8+j]; x[j]=a1*cr-a2*sr; x[8+j]=a1*sr+a2*cr;
        const float b1=x[16+j],b2=x[24+j]; x[16+j]=b1*cc-b2*sc; x[24+j]=b1*sc+b2*cc; } }
    #pragma unroll
    for(int d0=0;d0<4;++d0){ u32x4 w; w.x=cvtpk_s(x[8*d0]*C2,x[8*d0+1]*C2); w.y=cvtpk_s(x[8*d0+2]*C2,x[8*d0+3]*C2); w.z=cvtpk_s(x[8*d0+4]*C2,x[8*d0+5]*C2); w.w=cvtpk_s(x[8*d0+6]*C2,x[8*d0+7]*C2); qr[d0]=__builtin_bit_cast(bf16x8,w); } }
  float mhat=0.f,l_reg=0.f;f32x16 o[2];o[0]=f32x16{};o[1]=f32x16{};f32x16 negm=f32x16{};if(!WIN&&!FAST)asm volatile("":"+v"(negm)); f32x16 o2=f32x16{}; const bf16x8 ones8=(bf16x8){(short)0x3F80,(short)0x3F80,(short)0x3F80,(short)0x3F80,(short)0x3F80,(short)0x3F80,(short)0x3F80,(short)0x3F80};
  const int qrel=qpos0+qb_*QBLK+r32;
  #define CMASK(P0,P1,t) do{ if(WIN){ if((t)>=4) wmask(P0,P1,(int)KROW(t)-256-qrel,hi); } }while(0)
  bool resc=false;
  #define START(P0,P1) do{ resc=false; if(!FAST){ const float rm=rowmax(P0,P1); \
    { const float dl=rm; mhat=fadd_s(mhat,dl); \
      _Pragma("unroll") for(int r=0;r<16;++r){P0[r]=fsub_s(P0[r],dl);P1[r]=fsub_s(P1[r],dl);} \
      if(!WIN){ _Pragma("unroll") for(int r=0;r<16;++r)negm[r]=-mhat; asm volatile("":"+v"(negm)); } } } \
    _Pragma("unroll") for(int r=0;r<16;++r)P0[r]=__builtin_amdgcn_exp2f(P0[r]); }while(0)
  #define RESC() do{ if(resc){ asm volatile("s_waitcnt lgkmcnt(0)":::"memory"); \
      _Pragma("unroll") for(int d_=0;d_<2;++d_) _Pragma("unroll") for(int r=0;r<16;++r)o[d_][r]*=wsf[crow(r,hi)]; } }while(0)
  f32x16 pA0,pA1,pB0,pB1;
  int sl_prev=0,sl_cur=0,sl_next=SLOTB;
  #define ROT() do{sl_prev=sl_cur;sl_cur=sl_next;sl_next=(sl_next==(NSLOT-1)*SLOTB)?0:sl_next+SLOTB;}while(0)
  WAIT_BAR(3);
  qkt(pA0,pA1,Kbase,qr,negm,r32,hi);asm volatile("s_nop 15\n\ts_nop 7":"+v"(pA0),"+v"(pA1));CMASK(pA0,pA1,0);
  START(pA0,pA1);
  _Pragma("unroll") for(int r=0;r<16;++r)pA1[r]=__builtin_amdgcn_exp2f(pA1[r]);
  WAIT_BAR(0);
  DMA_K(3,0);DMA_V(1,SLOTB);
  ROT();
  kload8(kf,kp0+sl_cur,koff);
  WAIT_BAR(2);
  s16x4 vlo[8],vhi[8]; u32x4 pw0,pw1,pw2,pw3;
  #define PKW(P,B) cvtpk_s(P[B],P[B+1])
  #define PAF(k) __builtin_bit_cast(bf16x8,pw##k)
  #define VFR(i) (bf16x8){vlo[i][0],vlo[i][1],vlo[i][2],vlo[i][3],vhi[i][0],vhi[i][1],vhi[i][2],vhi[i][3]}
  #define PIN(x) asm volatile("":"+v"(x))
  #define MX3(a,b,c) __builtin_fmaxf(__builtin_fmaxf((a),(b)),(c))
  #define GAPA(MF,A0,A1,A2,A3,W0,W1,PW) do{ MF; if(!FAST){ sacc+=A0; sacc+=A1; sacc+=A2; sacc+=A3; PIN(sacc); } W0; W1; PIN(PW); SBAR(); }while(0)
  #define EX(v) __builtin_amdgcn_exp2f(v)
  #define GAPB(MF,X,B) do{ MF; X[B]=EX(X[B]); X[B+1]=EX(X[B+1]); X[B+2]=EX(X[B+2]); X[B+3]=EX(X[B+3]); PIN(X); SBAR(); }while(0)
  #define VRD(i) do{ vlo[i]=vtr((((i)>>2)?vpB_:vpA_)+((i)&3)*2048); vhi[i]=vtr((((i)>>2)?vpB_:vpA_)+((i)&3)*2048+1024); }while(0)
  #define ONESMF(k) do{ if(FAST){ o2=__builtin_amdgcn_mfma_f32_32x32x16_bf16(PAF(k),ones8,o2,0,0,0); SBAR(); } }while(0)
  #define KRD(G,j) do{ if(G){ kload2(kf,kp0+sl_next,koff,j); SBAR(); } }while(0)
  #define STEP(C0,C1,P0,P1,t,GK,GV,GL) do{ SBAR(); \
    const lds_cptr vpA_=vp0A+sl_prev, vpB_=vp0B+sl_prev; \
    VRD(0); SBAR(); float sacc=FAST?0.f:(P0[0]+P0[1]); \
    GAPA(C0=__builtin_amdgcn_mfma_f32_32x32x16_bf16(kf[0],qr[0],negm,0,0,0), P0[2],P0[3],P0[4],P0[5],     pw0[0]=PKW(P0,0), pw0[1]=PKW(P0,2), pw0); \
    VRD(4); SBAR(); GAPA(C1=__builtin_amdgcn_mfma_f32_32x32x16_bf16(kf[1],qr[0],negm,0,0,0), P0[6],P0[7],P0[8],P0[9],     pw0[2]=PKW(P0,4), pw0[3]=PKW(P0,6), pw0); \
    VRD(1); SBAR(); GAPA(C0=__builtin_amdgcn_mfma_f32_32x32x16_bf16(kf[2],qr[1],C0,0,0,0),   P0[10],P0[11],P0[12],P0[13], pw1[0]=PKW(P0,8), pw1[1]=PKW(P0,10), pw1); \
    VRD(5); SBAR(); GAPA(C1=__builtin_amdgcn_mfma_f32_32x32x16_bf16(kf[3],qr[1],C1,0,0,0),   P0[14],P0[15],P1[0],P1[1],   pw1[2]=PKW(P0,12),pw1[3]=PKW(P0,14), pw1); \
    VRD(2); SBAR(); GAPA(C0=__builtin_amdgcn_mfma_f32_32x32x16_bf16(kf[4],qr[2],C0,0,0,0),   P1[2],P1[3],P1[4],P1[5],     pw2[0]=PKW(P1,0), pw2[1]=PKW(P1,2), pw2); \
    VRD(6); SBAR(); GAPA(C1=__builtin_amdgcn_mfma_f32_32x32x16_bf16(kf[5],qr[2],C1,0,0,0),   P1[6],P1[7],P1[8],P1[9],     pw2[2]=PKW(P1,4), pw2[3]=PKW(P1,6), pw2); \
    VRD(3); SBAR(); GAPA(C0=__builtin_amdgcn_mfma_f32_32x32x16_bf16(kf[6],qr[3],C0,0,0,0),   P1[10],P1[11],P1[12],P1[13], pw3[0]=PKW(P1,8), pw3[1]=PKW(P1,10), pw3); \
    VRD(7); SBAR(); GAPA(C1=__builtin_amdgcn_mfma_f32_32x32x16_bf16(kf[7],qr[3],C1,0,0,0),   P1[14],P1[15],0.f,0.f,       pw3[2]=PKW(P1,12),pw3[3]=PKW(P1,14), pw3); \
    if(!FAST)l_reg+=sacc; \
    if(GK){DMA_K((t)+3,sl_cur);} if(GV){DMA_V((t)+1,sl_next);} \
    if(WIN){ _Pragma("unroll") for(int r=0;r<16;++r){C0[r]-=mhat;C1[r]-=mhat;} } \
    CMASK(C0,C1,t); \
    if(!FAST){ float a=MX3(C0[0],C0[1],C1[0]),b=MX3(C0[2],C0[3],C1[1]); a=MX3(a,C1[2],C1[3]); \
      _Pragma("unroll") for(int r=4;r<16;r+=4){a=MX3(a,C0[r],C0[r+1]);b=MX3(b,C0[r+2],C0[r+3]);a=MX3(a,C1[r],C1[r+1]);b=MX3(b,C1[r+2],C1[r+3]);} \
      float rm=__builtin_fmaxf(a,b); { auto rr=__builtin_amdgcn_permlane32_swap(__float_as_uint(rm),__float_as_uint(rm),false,false); rm=__builtin_fmaxf(__uint_as_float(rr[0]),__uint_as_float(rr[1])); } \
      resc=false; \
      if(__builtin_expect(__any(rm>(float)THRL),0)){ const float dl=__builtin_fmaxf(rm,0.f); mhat+=dl; \
        _Pragma("unroll") for(int r=0;r<16;++r){C0[r]-=dl;C1[r]-=dl;} \
        if(!WIN){ _Pragma("unroll") for(int r=0;r<16;++r)negm[r]=-mhat; asm volatile("":"+v"(negm)); } \
        const float f=__builtin_amdgcn_exp2f(-dl); l_reg*=f; if(hi==0)wsf[r32]=f; resc=true; } } \
    SBAR(); \
    GAPB(o[0]=__builtin_amdgcn_mfma_f32_32x32x16_bf16(PAF(0),VFR(0),o[0],0,0,0), C0,0); \
    GAPB(o[1]=__builtin_amdgcn_mfma_f32_32x32x16_bf16(PAF(0),VFR(4),o[1],0,0,0), C0,4); ONESMF(0); \
    KRD(GL,0); GAPB(o[0]=__builtin_amdgcn_mfma_f32_32x32x16_bf16(PAF(1),VFR(1),o[0],0,0,0), C0,8); \
    KRD(GL,1); GAPB(o[1]=__builtin_amdgcn_mfma_f32_32x32x16_bf16(PAF(1),VFR(5),o[1],0,0,0), C0,12); ONESMF(1); \
    KRD(GL,2); GAPB(o[0]=__builtin_amdgcn_mfma_f32_32x32x16_bf16(PAF(2),VFR(2),o[0],0,0,0), C1,0); \
    KRD(GL,3); GAPB(o[1]=__builtin_amdgcn_mfma_f32_32x32x16_bf16(PAF(2),VFR(6),o[1],0,0,0), C1,4); ONESMF(2); \
    GAPB(o[0]=__builtin_amdgcn_mfma_f32_32x32x16_bf16(PAF(3),VFR(3),o[0],0,0,0), C1,8); \
    GAPB(o[1]=__builtin_amdgcn_mfma_f32_32x32x16_bf16(PAF(3),VFR(7),o[1],0,0,0), C1,12); ONESMF(3); \
    }while(0)
  int t=1; const int NE=NT&~1;
  for(;t+5<NE;t+=2){
    STEP(pB0,pB1,pA0,pA1,t,true,true,true);     WAIT_BAR(2); RESC(); ROT();
    STEP(pA0,pA1,pB0,pB1,t+1,true,true,true);   WAIT_BAR(2); RESC(); ROT();
  }
  #define ENDW(tt) do{ if((tt)+3<NT){WAIT_BAR(2);} else if((tt)+2<NT){WAIT_BAR(1);} else {WAIT_BAR(0);} }while(0)
  for(;t+1<NE;t+=2){
    STEP(pB0,pB1,pA0,pA1,t,(t+3<NT),(t+1<NT),(t+1<NT));       ENDW(t);   RESC(); ROT();
    STEP(pA0,pA1,pB0,pB1,t+1,(t+4<NT),(t+2<NT),(t+2<NT));     ENDW(t+1); RESC(); ROT();
  }
  if(NT&1){
    STEP(pB0,pB1,pA0,pA1,NT-2,false,true,true); WAIT_BAR(0); RESC(); ROT();
    { const f32x16 x0=pA0,x1=pA1; pA0=pB0; pA1=pB1; pB0=x0; pB1=x1; }
  }
  if(Knext){ const bf16*kn=Knext+(long)krow_*PQKV+(((lane&7)^(krow_&7))*8); glds16(kn,(unsigned)__builtin_amdgcn_readfirstlane(kdst)); glds16(kn+(long)KVBLK*PQKV,(unsigned)__builtin_amdgcn_readfirstlane(kdst+SLOTB)); glds16(kn+(long)2*KVBLK*PQKV,(unsigned)__builtin_amdgcn_readfirstlane(kdst+2*SLOTB)); }
  STEP(pB0,pB1,pA0,pA1,NT-1,false,false,false); RESC();
  { if(!FAST){ float sacc=pB0[0]+pB0[1]; _Pragma("unroll") for(int r=2;r<16;++r)sacc+=pB0[r]; _Pragma("unroll") for(int r=0;r<16;++r)sacc+=pB1[r]; l_reg+=sacc; }
    pw0=(u32x4){PKW(pB0,0),PKW(pB0,2),PKW(pB0,4),PKW(pB0,6)};pw1=(u32x4){PKW(pB0,8),PKW(pB0,10),PKW(pB0,12),PKW(pB0,14)};pw2=(u32x4){PKW(pB1,0),PKW(pB1,2),PKW(pB1,4),PKW(pB1,6)};pw3=(u32x4){PKW(pB1,8),PKW(pB1,10),PKW(pB1,12),PKW(pB1,14)};
    SBAR(); pv(o,vb0A+sl_cur,vb0B+sl_cur,PAF(0),PAF(1),PAF(2),PAF(3)); ONESMF(0); ONESMF(1); ONESMF(2); ONESMF(3); }
  #undef PKW
  #undef PAF
  #undef VFR
  #undef PIN
  #undef MX3
  #undef GAPA
  #undef GAPB
  #undef EX
  #undef VRD
  #undef KRD
  #undef ONESMF
  #undef STEP
  #undef ENDW
  float rli[16];
  if(FAST){
    #pragma unroll
    for(int r=0;r<16;++r)rli[r]=__builtin_amdgcn_rcpf(o2[r]);
  } else {
  {auto rr=__builtin_amdgcn_permlane32_swap(__float_as_uint(l_reg),__float_as_uint(l_reg),false,false);l_reg=__uint_as_float(rr[0])+__uint_as_float(rr[1]);}
  if(WIN)l_reg+=__builtin_amdgcn_exp2f(sink2-mhat);
  if(hi==0)wsf[32+r32]=l_reg;asm volatile("s_waitcnt lgkmcnt(0)":::"memory");
  #pragma unroll
  for(int r=0;r<16;++r)rli[r]=__builtin_amdgcn_rcpf(wsf[32+crow(r,hi)]);
  }
  bf16*Ow=Ou+(long)(qb_*QBLK)*PO+hoff_;
  { bf16*stg=(bf16*)(shm+LDS_OST)+wid*2048;
    #pragma unroll
    for(int r=0;r<16;++r){const int orow=crow(r,hi);
      #pragma unroll
      for(int d0=0;d0<2;++d0)stg[orow*64+d0*32+r32]=__float2bfloat16(o[d0][r]*rli[r]);}
    asm volatile("s_waitcnt lgkmcnt(0)":::"memory");
    #pragma unroll
    for(int i=0;i<4;++i){const int row=i*8+(lane>>3),ch=lane&7; const u32x4 v=*(const u32x4*)(stg+row*64+ch*8); ATTN_STORE16(Ow+(long)row*PO+ch*8,v);} }
  asm volatile("s_waitcnt lgkmcnt(0)\n\ts_barrier":::"memory");
  #undef DMA_K
  #undef KROW
  #undef DMA_V
  #undef CMASK
  #undef START
  #undef RESC
  #undef ROT
}
constexpr int ATTN_LDS_BYTES=LDS_BYTES;
#undef SBAR
#undef WAIT_BAR
}

template <int LAYER> __device__ __forceinline__ void attn_fast_phase(Frame& F, char* shm) {
    using attn_body::bf16;
    const int G = gridDim.x, bx = blockIdx.x, vcu = (G % 8 == 0) ? (bx % 8) * (G / 8) + bx / 8 : bx;
    constexpr int NQH = LAYER == 0 ? 12 : 16, GQ = LAYER == 0 ? 3 : 4, QC0 = LAYER == 0 ? 256 : 0;
    constexpr int NLAT = NB * NQH * 32, NUN = NLAT + (LAYER == 0 ? NB * NQH : 0);
    const bf16* QKV = (const bf16*)F_qkvu; bf16* MIXO = (bf16*)F_mix;
    bool fast = false;
    if (LAYER == 0) { float gq = fabsf(F.in[I_EQG][F.lane]), gk = fabsf(F.in[I_EKG][F.lane]);
#pragma unroll
        for (int o = 1; o < 64; o <<= 1) { gq = fmaxf(gq, __shfl_xor(gq, o)); gk = fmaxf(gk, __shfl_xor(gk, o)); }
        fast = __builtin_amdgcn_readfirstlane((int)(64.f * 1.05f * attn_body::C2 * gq * gk < 60.f)) != 0; }
    if (LAYER == 1) {
        constexpr int NU1 = NB * 4 * (SEQ / 64);
        bool kpre = false;
        for (int id = vcu; id < NU1; id += G) {
            const int chunk = id % (SEQ / 64), hg = id / (SEQ / 64), kvh = hg & 3, b = hg >> 2, q0 = chunk * 64;
            const int idn = id + G; const bf16* Kn = idn < NU1 ? QKV + (size_t)((idn / (SEQ / 64)) >> 2) * RB * DIN + 1024 + ((idn / (SEQ / 64)) & 3) * 64 : nullptr;
            const size_t brow = (size_t)b * RB, qrow = brow + CTXL + (size_t)q0;
            int ws = q0 >= 128 ? q0 - 128 : 0; const int we = q0 + 192 <= SEQ ? q0 + 192 : SEQ; int n = (we - ws) / 64;
            attn_body::attn_unit<8, true, 1, false, true>(QKV + qrow * DIN + kvh * 256, QKV + brow * DIN + 1024 + kvh * 64, QKV + brow * DIN + 1280 + kvh * 64, MIXO + qrow * DM + kvh * 256, 4 + n, ws, q0, 0.f, nullptr, true, shm, F.in[I_OSINK] + kvh * 4, Kn, kpre); kpre = Kn != nullptr;
        }
        return;
    }
    bool kpre = false;
    for (int id = vcu; id < NUN; id += G) {
        const bf16* Kn = nullptr;
        { const int idn = id + G; if (idn < NUN) { const int hgn = idn < NLAT ? idn >> 5 : idn - NLAT; Kn = QKV + (size_t)(hgn / NQH) * RB * DIN + 1024 + ((hgn % NQH) / GQ) * 64; } }
        if (id < NLAT) {
            const int chunk = id & 31, hg = id >> 5, h = hg % NQH, b = hg / NQH;
            const size_t brow = (size_t)b * RB, qrow = brow + CTXL + (size_t)chunk * 256;
            const bf16* Qu = QKV + qrow * DIN + QC0 + h * 64; const bf16* Kh = QKV + brow * DIN + 1024 + (h / GQ) * 64; bf16* Ou = MIXO + qrow * DM + QC0 + h * 64;
            if (LAYER == 0) { if (fast) attn_body::attn_unit<8, false, 2, true>(Qu, Kh, Kh + 256, Ou, RB / 64, 0, chunk * 256, 0.f, F.in[I_EQG], true, shm, nullptr, Kn, kpre); else attn_body::attn_unit<8, false, 2, false>(Qu, Kh, Kh + 256, Ou, RB / 64, 0, chunk * 256, 0.f, F.in[I_EQG], true, shm, nullptr, Kn, kpre); }
        } else if (LAYER == 0) {
            const int cu = id - NLAT, h = cu % NQH, b = cu / NQH; const size_t brow = (size_t)b * RB;
            if (fast) attn_body::attn_unit<8, false, 2, true>(QKV + brow * DIN + QC0 + h * 64, QKV + brow * DIN + 1024 + (h / GQ) * 64, QKV + brow * DIN + 1280 + (h / GQ) * 64, MIXO + brow * DM + QC0 + h * 64, 4, 0, 0, 0.f, F.in[I_EQG], false, shm, nullptr, Kn, kpre);
            else attn_body::attn_unit<8, false, 2, false>(QKV + brow * DIN + QC0 + h * 64, QKV + brow * DIN + 1024 + (h / GQ) * 64, QKV + brow * DIN + 1280 + (h / GQ) * 64, MIXO + brow * DM + QC0 + h * 64, 4, 0, 0, 0.f, F.in[I_EQG], false, shm, nullptr, Kn, kpre);
        }
        kpre = Kn != nullptr;
    }
}

template <int G> __device__ __forceinline__ void pool_group(const bf16* ub, int t, int L, int lane, const bf16* pwT, const float* ps, bf16* orow) {
    constexpr int W = 2 << G; const int fr = lane & 15, kq = lane >> 4;
    int lo = t - W / 2; if (lo < 0) lo = 0; int hi = t + W - W / 2; if (hi > L) hi = L; const float rc = 1.f / (float)(hi - lo);
    f32x4 acc[4];
#pragma unroll
    for (int nb = 0; nb < 4; ++nb) acc[nb] = (f32x4){0.f, 0.f, 0.f, 0.f};
#pragma unroll
    for (int ks = 0; ks < 2; ++ks) {
        const bf16* up = ub + G * 64 + 32 * ks + 8 * kq;
        float sm[8], self[8];
#pragma unroll
        for (int c = 0; c < 8; ++c) { sm[c] = 0.f; self[c] = 0.f; }
#pragma unroll
        for (int i = 0; i < W; ++i) { const int p = t - W / 2 + i; const bool ok = p >= 0 && p < L; const int pc = ok ? p : t;
            const u32x4 w = *(const u32x4*)(up + (size_t)pc * DIN); const float f = ok ? 1.f : 0.f;
            const float e0 = bflo(w.x), e1 = bfhi(w.x), e2 = bflo(w.y), e3 = bfhi(w.y), e4 = bflo(w.z), e5 = bfhi(w.z), e6 = bflo(w.w), e7 = bfhi(w.w);
            sm[0] += f * e0; sm[1] += f * e1; sm[2] += f * e2; sm[3] += f * e3; sm[4] += f * e4; sm[5] += f * e5; sm[6] += f * e6; sm[7] += f * e7;
            if (i == W / 2) { self[0] = e0; self[1] = e1; self[2] = e2; self[3] = e3; self[4] = e4; self[5] = e5; self[6] = e6; self[7] = e7; } }
        u32x4 pb; pb.x = pk2(sm[0] * rc - self[0], sm[1] * rc - self[1]); pb.y = pk2(sm[2] * rc - self[2], sm[3] * rc - self[3]); pb.z = pk2(sm[4] * rc - self[4], sm[5] * rc - self[5]); pb.w = pk2(sm[6] * rc - self[6], sm[7] * rc - self[7]);
        const bf16x8 bfr = __builtin_bit_cast(bf16x8, pb);
#pragma unroll
        for (int nb = 0; nb < 4; ++nb) { const bf16x8 afr = *(const bf16x8*)(pwT + (size_t)(G * 64 + 16 * nb + fr) * 64 + 32 * ks + 8 * kq); acc[nb] = __builtin_amdgcn_mfma_f32_16x16x32_bf16(afr, bfr, acc[nb], 0, 0, 0); }
    }
#pragma unroll
    for (int nb = 0; nb < 4; ++nb) { const int d = G * 64 + 16 * nb + 4 * kq; const f32x4 sc = *(const f32x4*)(ps + d);
        u32x2 o; o.x = pk2(acc[nb][0] * sc.x, acc[nb][1] * sc.y); o.y = pk2(acc[nb][2] * sc.z, acc[nb][3] * sc.w); *(u32x2*)(orow + d) = o; }
}
__device__ __forceinline__ void pool_phase(Frame& F) {
    const int lane = F.lane, fr = lane & 15;
    constexpr int NIT = NR / 16; const int ngw = F.ngw, nex = NIT - ngw;
    const bool split = nex > 0 && 4 * nex <= (int)gridDim.x;
    for (int rg = F.gw; rg < (split ? ngw : NIT); rg += ngw) {
        const int r = rg * 16 + fr; int b, j; row_info(r, b, j);
        const int L = j < CTXL ? CTXL : SEQ, t = j < CTXL ? j : j - CTXL;
        const bf16* ub = F_qkvu + (size_t)(r - t) * DIN; bf16* orow = F_mix + (size_t)r * DM;
        pool_group<0>(ub, t, L, lane, F_pwT, F.in[I_EPS], orow); pool_group<1>(ub, t, L, lane, F_pwT, F.in[I_EPS], orow);
        pool_group<2>(ub, t, L, lane, F_pwT, F.in[I_EPS], orow); pool_group<3>(ub, t, L, lane, F_pwT, F.in[I_EPS], orow);
    }
    if (split && F.wave == 0 && (int)blockIdx.x < 4 * nex) {
        const int rg = ngw + ((int)blockIdx.x >> 2), g = (int)blockIdx.x & 3;
        const int r = rg * 16 + fr; int b, j; row_info(r, b, j);
        const int L = j < CTXL ? CTXL : SEQ, t = j < CTXL ? j : j - CTXL;
        const bf16* ub = F_qkvu + (size_t)(r - t) * DIN; bf16* orow = F_mix + (size_t)r * DM;
        if (g == 0) pool_group<0>(ub, t, L, lane, F_pwT, F.in[I_EPS], orow); else if (g == 1) pool_group<1>(ub, t, L, lane, F_pwT, F.in[I_EPS], orow);
        else if (g == 2) pool_group<2>(ub, t, L, lane, F_pwT, F.in[I_EPS], orow); else pool_group<3>(ub, t, L, lane, F_pwT, F.in[I_EPS], orow);
    }
}

#define INS16(L, v) do { float _v = (v); _Pragma("unroll") for (int _i = 0; _i < 16; ++_i) { const float _m = fmaxf(L[_i], _v); _v = fminf(L[_i], _v); L[_i] = _m; } } while (0)
#define BSORT16(L) do { _Pragma("unroll") for (int _st = 8; _st >= 1; _st >>= 1) { _Pragma("unroll") for (int _i = 0; _i < 16; ++_i) { if ((_i & _st) == 0) { const float _a = L[_i], _b = L[_i + _st]; L[_i] = fmaxf(_a, _b); L[_i + _st] = fminf(_a, _b); } } } } while (0)
#define CE16_(V, i, j) do { const float _a = V[i], _b = V[j]; V[i] = fmaxf(_a, _b); V[j] = fminf(_a, _b); } while (0)
#define SORT16(V) do { \
    CE16_(V,0,13); CE16_(V,1,12); CE16_(V,2,15); CE16_(V,3,14); CE16_(V,4,8); CE16_(V,5,6); CE16_(V,7,11); CE16_(V,9,10); \
    CE16_(V,0,5); CE16_(V,1,7); CE16_(V,2,9); CE16_(V,3,4); CE16_(V,6,13); CE16_(V,8,14); CE16_(V,10,15); CE16_(V,11,12); \
    CE16_(V,0,1); CE16_(V,2,3); CE16_(V,4,5); CE16_(V,6,8); CE16_(V,7,9); CE16_(V,10,11); CE16_(V,12,13); CE16_(V,14,15); \
    CE16_(V,0,2); CE16_(V,1,3); CE16_(V,4,10); CE16_(V,5,11); CE16_(V,6,7); CE16_(V,8,9); CE16_(V,12,14); CE16_(V,13,15); \
    CE16_(V,1,2); CE16_(V,3,12); CE16_(V,4,6); CE16_(V,5,7); CE16_(V,8,10); CE16_(V,9,11); CE16_(V,13,14); \
    CE16_(V,1,4); CE16_(V,2,6); CE16_(V,5,8); CE16_(V,7,10); CE16_(V,9,13); CE16_(V,11,14); \
    CE16_(V,2,4); CE16_(V,3,6); CE16_(V,9,12); CE16_(V,11,13); \
    CE16_(V,3,5); CE16_(V,6,8); CE16_(V,7,9); CE16_(V,10,12); \
    CE16_(V,3,4); CE16_(V,5,6); CE16_(V,7,8); CE16_(V,9,10); CE16_(V,11,12); \
    CE16_(V,6,7); CE16_(V,8,9); } while (0)
#define MERGE_LISTS(L, B) do { _Pragma("unroll") for (int _i = 0; _i < 16; ++_i) L[_i] = fmaxf(L[_i], B[15 - _i]); BSORT16(L); } while (0)
#define MERGE16(L, X) do { float _o[16]; _Pragma("unroll") for (int _i = 0; _i < 16; ++_i) _o[_i] = __shfl_xor(L[15 - _i], X); _Pragma("unroll") for (int _i = 0; _i < 16; ++_i) L[_i] = fmaxf(L[_i], _o[_i]); BSORT16(L); } while (0)
constexpr int RT_KROW = 272, RT_KHALF = 128 * RT_KROW, RT_LUT = 73728;
__device__ __forceinline__ void route_qload(const bf16* qp, int lane, bf16x8 (&qf)[4]) {
    const int c = lane & 15, kq = lane >> 4;
#pragma unroll
    for (int ks = 0; ks < 4; ++ks) qf[ks] = *(const bf16x8*)(qp + (size_t)c * 256 + 32 * ks + 8 * kq);
}
__device__ __forceinline__ void route_half(const bf16x8 (&qf)[4], const LAS unsigned char* kl, int lane, float (&L)[16]) {
    const int c = lane & 15, kq = lane >> 4;
    float va[16], vb[16];
#pragma unroll
    for (int rb = 0; rb < 8; ++rb) {
        f32x4 acc = (f32x4){0.f, 0.f, 0.f, 0.f};
#pragma unroll
        for (int ks = 0; ks < 4; ++ks) { const bf16x8 kf = *(const LAS bf16x8*)(kl + (16 * rb + c) * RT_KROW + (32 * ks + 8 * kq) * 2); acc = __builtin_amdgcn_mfma_f32_16x16x32_bf16(kf, qf[ks], acc, 0, 0, 0); }
#pragma unroll
        for (int i = 0; i < 4; ++i) { const float v = __uint_as_float((__float_as_uint(acc[i]) & 0xffffff80u) | (unsigned)(16 * rb + 4 * kq + i)); if (rb < 4) va[4 * rb + i] = v; else vb[4 * (rb - 4) + i] = v; }
    }
    SORT16(va); SORT16(vb);
#pragma unroll
    for (int i = 0; i < 16; ++i) L[i] = va[i];
    MERGE_LISTS(L, vb);
    MERGE16(L, 16); MERGE16(L, 32);
}
__device__ __forceinline__ void route_fast_phase(Frame& F, int layer, bool skip_ctx) {
    const int lane = F.lane, ngrp = NR * 8 / 16;
    const float* scl = F_scl + (size_t)layer * NEXP * 2;
    { const bf16* kg = F_keys + (size_t)layer * 2 * 16384;
      for (int i = F.tid; i < 2 * 128 * 16; i += NTHR) { const int row = i >> 4, ch = i & 15; *(LAS u32x4*)(F.lds + row * RT_KROW + ch * 16) = *(const u32x4*)(kg + (size_t)row * 128 + ch * 8); }
      __syncthreads(); }
    ticket_reset(F);
    const int ngw_ = (ngrp - (int)blockIdx.x + (int)gridDim.x - 1) / (int)gridDim.x, nfull = ((ngw_ / 4) / 8) * 8;
    for (;;) {
        const int tk = ticket_next(F); const int k0 = tk < nfull ? 4 * tk : 4 * nfull + (tk - nfull), kn = tk < nfull ? 4 : 1; if ((int)blockIdx.x + k0 * (int)gridDim.x >= ngrp) break;
        float L1[16], L2[16];
#pragma unroll
        for (int i = 0; i < 16; ++i) { L1[i] = 0.f; L2[i] = 0.f; }
        int vmask = 0;
        bf16x8 qn1[4], qn2[4];
        { const int g0 = (int)blockIdx.x + k0 * (int)gridDim.x; const bf16* qp = F_pq + (size_t)(g0 < ngrp ? g0 : ngrp - 1) * 16 * 256; route_qload(qp, lane, qn1); route_qload(qp + 128, lane, qn2); }
#pragma unroll 1
        for (int g = 0; g < kn; ++g) { const int grp = (int)blockIdx.x + (k0 + g) * (int)gridDim.x;
            bf16x8 q1[4], q2[4];
#pragma unroll
            for (int ks = 0; ks < 4; ++ks) { q1[ks] = qn1[ks]; q2[ks] = qn2[ks]; }
            asm volatile("" ::: "memory");
            { const int gn = grp + (int)gridDim.x; const bf16* qp = F_pq + (size_t)(gn < ngrp ? gn : ngrp - 1) * 16 * 256; route_qload(qp, lane, qn1); route_qload(qp + 128, lane, qn2); }
            if (grp >= ngrp || (skip_ctx && ((grp * 2) % RB) < CTXL)) continue;
            vmask |= 1 << g;
            float A1[16], A2[16];
            route_half(q1, F.lds, lane, A1);
            route_half(q2, F.lds + RT_KHALF, lane, A2);
            const bool mine = (lane >> 4) == g;
#pragma unroll
            for (int i = 0; i < 16; ++i) { L1[i] = mine ? A1[i] : L1[i]; L2[i] = mine ? A2[i] : L2[i]; } }
        if (vmask == 0) continue;
#define CAND(i, j) __uint_as_float((__float_as_uint(L1[i] + L2[j]) & 0xffffff00u) | (unsigned)(16 * (i) + (j)))
        float T[16], U[16], W[16];
#pragma unroll
        for (int jj = 0; jj < 16; ++jj) T[jj] = CAND(0, jj);
        U[0] = CAND(1, 0); U[1] = CAND(1, 1); U[2] = CAND(1, 2); U[3] = CAND(1, 3); U[4] = CAND(1, 4); U[5] = CAND(1, 5); U[6] = CAND(1, 6); U[7] = CAND(1, 7); U[8] = CAND(2, 0); U[9] = CAND(2, 1); U[10] = CAND(2, 2); U[11] = CAND(2, 3); U[12] = CAND(2, 4); U[13] = CAND(3, 0); U[14] = CAND(3, 1); U[15] = CAND(3, 2);
        W[0] = CAND(3, 3); W[1] = CAND(4, 0); W[2] = CAND(4, 1); W[3] = CAND(4, 2); W[4] = CAND(5, 0); W[5] = CAND(5, 1); W[6] = CAND(6, 0); W[7] = CAND(6, 1); W[8] = CAND(7, 0); W[9] = CAND(7, 1); W[10] = CAND(8, 0); W[11] = CAND(9, 0); W[12] = CAND(10, 0); W[13] = CAND(11, 0); W[14] = CAND(12, 0); W[15] = CAND(13, 0);
        SORT16(U); SORT16(W);
        MERGE_LISTS(T, U); MERGE_LISTS(T, W);
        INS16(T, CAND(14, 0)); INS16(T, CAND(15, 0));
#undef CAND
        LAS unsigned char* lut = F.lds + RT_LUT + F.wave * 2048 + lane * 32;
#define PK4(L, m) ((__float_as_uint(L[4 * (m)]) & 127u) | ((__float_as_uint(L[4 * (m) + 1]) & 127u) << 8) | ((__float_as_uint(L[4 * (m) + 2]) & 127u) << 16) | ((__float_as_uint(L[4 * (m) + 3]) & 127u) << 24))
        *(LAS u32x4*)lut = (u32x4){PK4(L1, 0), PK4(L1, 1), PK4(L1, 2), PK4(L1, 3)};
        *(LAS u32x4*)(lut + 16) = (u32x4){PK4(L2, 0), PK4(L2, 1), PK4(L2, 2), PK4(L2, 3)};
#undef PK4
        int P[16];
#pragma unroll
        for (int k = 0; k < 16; ++k) { const unsigned code = __float_as_uint(T[k]) & 255u; P[k] = (int)lut[code >> 4] * 128 + (int)lut[16 + (code & 15u)]; }
        float sum = 0.f, ex[16];
#pragma unroll
        for (int k = 0; k < 16; ++k) { ex[k] = __expf(T[k] - T[0]); sum += ex[k]; }
        const float rs = 1.f / sum;
        if ((vmask >> (lane >> 4)) & 1) { const size_t pair = ((size_t)((int)blockIdx.x + (k0 + (lane >> 4)) * (int)gridDim.x)) * 16 + (lane & 15);
            u32x2* op = F_rt + pair * 16;
            typedef float f32x2r __attribute__((ext_vector_type(2))); f32x2r st[16];
#pragma unroll
            for (int k = 0; k < 16; ++k) st[k] = *(const f32x2r*)(scl + 2 * (size_t)P[k]);
#pragma unroll
            for (int k = 0; k < 16; k += 2) { u32x4 o; o.x = (unsigned)P[k] | (pk2(0.f, st[k].x) & 0xffff0000u); o.y = __float_as_uint(ex[k] * rs * st[k].y); o.z = (unsigned)P[k + 1] | (pk2(0.f, st[k + 1].x) & 0xffff0000u); o.w = __float_as_uint(ex[k + 1] * rs * st[k + 1].y);
                *(u32x4*)(op + k) = o; }
        }
    }
}

typedef _Float16 h2_t __attribute__((ext_vector_type(2)));
__device__ __forceinline__ unsigned q4o(float a, float b, float c, float d, float inv) {
    return ((unsigned)(int)rintf(a * inv + 8.f) & 255u) | (((unsigned)(int)rintf(b * inv + 8.f) & 255u) << 8) | (((unsigned)(int)rintf(c * inv + 8.f) & 255u) << 16) | (((unsigned)(int)rintf(d * inv + 8.f) & 255u) << 24);
}
__device__ __forceinline__ void glds16x4(const void* up, const void* up2, const void* vp, const void* vp2, unsigned l0, unsigned l1, unsigned l2, unsigned l3) { unsigned keep;
    asm volatile("s_mov_b32 %0, m0\n\ts_mov_b32 m0, %5\n\ts_nop 0\n\tglobal_load_lds_dwordx4 %1, off\n\ts_mov_b32 m0, %6\n\ts_nop 0\n\tglobal_load_lds_dwordx4 %2, off\n\ts_mov_b32 m0, %7\n\ts_nop 0\n\tglobal_load_lds_dwordx4 %3, off\n\ts_mov_b32 m0, %8\n\ts_nop 0\n\tglobal_load_lds_dwordx4 %4, off\n\ts_mov_b32 m0, %0"
                 : "=&s"(keep) : "v"(up), "v"(up2), "v"(vp), "v"(vp2), "s"(l0), "s"(l1), "s"(l2), "s"(l3) : "memory"); }
#define ROR_(x, c) __builtin_amdgcn_update_dpp(0, (x), (c), 0xf, 0xf, true)
__device__ __forceinline__ int row16_sum_i(int d) { d += ROR_(d, 0x128); d += ROR_(d, 0x124); d += ROR_(d, 0x122); d += ROR_(d, 0x121); return d; }
__device__ __forceinline__ float row16_sum_f(float v) {
    v += __int_as_float(ROR_(__float_as_int(v), 0x128)); v += __int_as_float(ROR_(__float_as_int(v), 0x124)); v += __int_as_float(ROR_(__float_as_int(v), 0x122)); v += __int_as_float(ROR_(__float_as_int(v), 0x121)); return v; }
__device__ __forceinline__ float row16_max_f(float v) {
    v = fmaxf(v, __int_as_float(ROR_(__float_as_int(v), 0x128))); v = fmaxf(v, __int_as_float(ROR_(__float_as_int(v), 0x124))); v = fmaxf(v, __int_as_float(ROR_(__float_as_int(v), 0x122))); v = fmaxf(v, __int_as_float(ROR_(__float_as_int(v), 0x121))); return v; }
#undef ROR_
__device__ __forceinline__ void gather_q8_phase(Frame& F, int layer, bool skip_ctx, bool last, bool nextn) {
    const unsigned char* tu = F_tabu + (size_t)layer * NEXP * (DM / 2); const unsigned char* tv = F_tabv + (size_t)layer * NEXP * (DM / 2);
    const int lane = F.lane, s = lane & 15, e4 = lane >> 4;
    ticket_reset(F);
    int mi_c = -1; u32x4 ga[2] = {}, sa[2] = {}, eg[2] = {}, en[4] = {};
    const int ccol = 32 * s + 512 * (e4 >> 1) + 16 * (e4 & 1);
    f32x4 fg[4] = {};
    if (last) {
#pragma unroll
        for (int hh = 0; hh < 4; ++hh) fg[hh] = *(const f32x4*)(F.in[I_FING] + ccol + 4 * hh); }
    for (;;) {
        const int tk_ = ticket_next(F); const int r = 2 * ((int)blockIdx.x + (tk_ >> 1) * (int)gridDim.x) + (tk_ & 1); if (r >= NR) break;
        int b, j; row_info(r, b, j); if (skip_ctx && j < CTXL) continue;
        unsigned xq[2][8]; float sx, hsx; u32x4 xkeep[2];
        {
            const int mi = j < CTXL ? 4 : b, q0 = e4 >> 1, p0 = 2 * (e4 & 1);
            const bf16* xr = F_xs + (size_t)r * DM + 32 * s + 512 * q0 + 8 * p0; const bf16* gp = F_gbs + ((size_t)layer * 5 + mi) * 2 * DM + 32 * s + 512 * q0 + 8 * p0;
            const u32x4 xa[2] = {*(const u32x4*)xr, *(const u32x4*)(xr + 8)}; xkeep[0] = xa[0]; xkeep[1] = xa[1];
            if (mi != mi_c) { ga[0] = *(const u32x4*)gp; ga[1] = *(const u32x4*)(gp + 8); sa[0] = *(const u32x4*)(gp + DM); sa[1] = *(const u32x4*)(gp + DM + 8); mi_c = mi;
                const bf16* g2 = F_g2b + ((size_t)layer * 5 + mi) * DM + ccol; eg[0] = *(const u32x4*)g2; eg[1] = *(const u32x4*)(g2 + 8);
                if (nextn) { const bf16* nb = F_n1b + (size_t)mi * 2 * DM + ccol; en[0] = *(const u32x4*)nb; en[1] = *(const u32x4*)(nb + 8); en[2] = *(const u32x4*)(nb + DM); en[3] = *(const u32x4*)(nb + DM + 8); } }
            float ssq = 0.f, mx = 0.f;
#pragma unroll
            for (int c = 0; c < 2; ++c)
#pragma unroll
                for (int w = 0; w < 4; ++w) { const float a = bflo(xa[c][w]), d = bfhi(xa[c][w]); ssq += a * a + d * d; }
            const float rstd = rsqrtf(wave_sum(ssq) * (1.f / DM) + EPS);
            float hv[2][8];
#pragma unroll
            for (int c = 0; c < 2; ++c)
#pragma unroll
                for (int w = 0; w < 4; ++w) { const float a = (bflo(xa[c][w]) * rstd) * bflo(ga[c][w]) + bflo(sa[c][w]), d = (bfhi(xa[c][w]) * rstd) * bfhi(ga[c][w]) + bfhi(sa[c][w]);
                    hv[c][2 * w] = a; hv[c][2 * w + 1] = d; mx = fmaxf(mx, fmaxf(fabsf(a), fabsf(d))); }
            mx = wave_max(mx);
            const float inv = mx > 0.f ? 119.f / mx : 0.f; sx = mx * (1.f / 119.f);
            int sumt = 0; unsigned own[2][2];
#pragma unroll
            for (int c = 0; c < 2; ++c) { const unsigned tlo = q4o(hv[c][0], hv[c][1], hv[c][2], hv[c][3], inv), thi = q4o(hv[c][4], hv[c][5], hv[c][6], hv[c][7], inv);
                own[c][0] = ((tlo >> 4) & 0x0f0f0f0fu) | (thi & 0xf0f0f0f0u);
                own[c][1] = ((tlo & 0x0f0f0f0fu) | ((thi & 0x0f0f0f0fu) << 4)) ^ 0x88888888u;
                sumt = __builtin_amdgcn_sdot4((int)tlo, 0x01010101, sumt, false); sumt = __builtin_amdgcn_sdot4((int)thi, 0x01010101, sumt, false); }
            sumt = wave_sum_i(sumt);
            hsx = 0.5f * (float)(sumt - 8 * DM);
            unsigned z[4][2];
#pragma unroll
            for (int c = 0; c < 2; ++c)
#pragma unroll
                for (int h = 0; h < 2; ++h) { const auto rr = __builtin_amdgcn_permlane16_swap(own[c][h], own[c][h], false, false); z[c][h] = rr[0]; z[2 + c][h] = rr[1]; }
#pragma unroll
            for (int p = 0; p < 4; ++p)
#pragma unroll
                for (int h = 0; h < 2; ++h) { const auto rr = __builtin_amdgcn_permlane32_swap(z[p][h], z[p][h], false, false); xq[0][2 * p + h] = rr[0]; xq[1][2 * p + h] = rr[1]; }
        }
        LAS int* tl_id = (LAS int*)(F.lds + 133120 + F.wave * 1536); LAS float* tl_g = (LAS float*)(tl_id + 128); LAS float* tl_u = tl_g + 128;
        { const size_t o = (size_t)r * 128 + lane;
          const u32x2 t0 = F_rt[o], t1 = F_rt[o + 64];
          tl_id[lane] = (int)(t0.x & 0xffffu); tl_id[64 + lane] = (int)(t1.x & 0xffffu); tl_g[lane] = __uint_as_float(t0.y); tl_g[64 + lane] = __uint_as_float(t1.y); tl_u[lane] = __uint_as_float(t0.x & 0xffff0000u) * sx; tl_u[64 + lane] = __uint_as_float(t1.x & 0xffff0000u) * sx; }
        h2_t hacc[2][4][4]; float wsum = 0.f;
#pragma unroll
        for (int q = 0; q < 2; ++q)
#pragma unroll
            for (int dd = 0; dd < 4; ++dd)
#pragma unroll
                for (int k = 0; k < 4; ++k) hacc[q][dd][k] = (h2_t){(_Float16)0.f, (_Float16)0.f};
        const unsigned lslice = (unsigned)(uintptr_t)F.lds + (unsigned)F.wave * 16384u; LAS unsigned char* lrd = F.lds + F.wave * 16384 + lane * 16;
#define GD_ISSUE(k, it) do { const int _id = tl_id[4 * (it) + e4]; \
            const unsigned char* _up = tu + (size_t)_id * (DM / 2) + 16 * s; const unsigned char* _vp = tv + (size_t)_id * (DM / 2) + 16 * s; \
            const unsigned _lb = (unsigned)__builtin_amdgcn_readfirstlane((int)(lslice + (k) * 4096u)); \
            glds16x4(_up, _up + 256, _vp, _vp + 256, _lb, _lb + 1024u, _lb + 2048u, _lb + 3072u); } while (0)
#define ROR16_(d) do { d += __builtin_amdgcn_update_dpp(0, d, 0x128, 0xf, 0xf, true); d += __builtin_amdgcn_update_dpp(0, d, 0x124, 0xf, 0xf, true); d += __builtin_amdgcn_update_dpp(0, d, 0x122, 0xf, 0xf, true); d += __builtin_amdgcn_update_dpp(0, d, 0x121, 0xf, 0xf, true); } while (0)
#define GD_BODY2(k, REFILL, WAITN) do { const int i = i0 + (k), ea = 4 * i + e4; \
            asm volatile("s_waitcnt vmcnt(" #WAITN ")" ::: "memory"); __builtin_amdgcn_sched_barrier(0);            \
            const u32x4 ua0 = *(const LAS u32x4*)(lrd + (k) * 4096), ua1 = *(const LAS u32x4*)(lrd + (k) * 4096 + 1024), va0 = *(const LAS u32x4*)(lrd + (k) * 4096 + 2048), va1 = *(const LAS u32x4*)(lrd + (k) * 4096 + 3072); \
            const u32x4 ub0 = *(const LAS u32x4*)(lrd + (k) * 4096 + 4096), ub1 = *(const LAS u32x4*)(lrd + (k) * 4096 + 5120), vb0 = *(const LAS u32x4*)(lrd + (k) * 4096 + 6144), vb1 = *(const LAS u32x4*)(lrd + (k) * 4096 + 7168); \
            asm volatile("s_waitcnt lgkmcnt(0)" : "+v"(*(u32x4*)&ua0), "+v"(*(u32x4*)&ua1), "+v"(*(u32x4*)&va0), "+v"(*(u32x4*)&va1), "+v"(*(u32x4*)&ub0), "+v"(*(u32x4*)&ub1), "+v"(*(u32x4*)&vb0), "+v"(*(u32x4*)&vb1) :: "memory"); __builtin_amdgcn_sched_barrier(0);     \
            if (REFILL) { GD_ISSUE(k, i + 4); GD_ISSUE((k) + 1, i + 5); } __builtin_amdgcn_sched_barrier(0); \
            int dla = 0, dha = 0, dlb = 0, dhb = 0; \
            _Pragma("unroll") for (int dd = 0; dd < 4; ++dd) { dha = __builtin_amdgcn_sdot8((int)ua0[dd], (int)xq[0][2 * dd], dha, false); dla = __builtin_amdgcn_sdot8((int)ua0[dd], (int)xq[0][2 * dd + 1], dla, false); } \
            _Pragma("unroll") for (int dd = 0; dd < 4; ++dd) { dha = __builtin_amdgcn_sdot8((int)ua1[dd], (int)xq[1][2 * dd], dha, false); dla = __builtin_amdgcn_sdot8((int)ua1[dd], (int)xq[1][2 * dd + 1], dla, false); } \
            _Pragma("unroll") for (int dd = 0; dd < 4; ++dd) { dhb = __builtin_amdgcn_sdot8((int)ub0[dd], (int)xq[0][2 * dd], dhb, false); dlb = __builtin_amdgcn_sdot8((int)ub0[dd], (int)xq[0][2 * dd + 1], dlb, false); } \
            _Pragma("unroll") for (int dd = 0; dd < 4; ++dd) { dhb = __builtin_amdgcn_sdot8((int)ub1[dd], (int)xq[1][2 * dd], dhb, false); dlb = __builtin_amdgcn_sdot8((int)ub1[dd], (int)xq[1][2 * dd + 1], dlb, false); } \
            int da = 16 * dha + dla, db = 16 * dhb + dlb;        \
            ROR16_(da); ROR16_(db); \
            const int odd = s & 1, es = ea + 4 * odd; const float g = tl_g[es], usc = tl_u[es]; \
            const float w = g * gelu_erf(((float)(odd ? db : da) + hsx) * usc); \
            const float wa = __int_as_float(__builtin_amdgcn_update_dpp(0, __float_as_int(w), 0xA0, 0xf, 0xf, true)), wb = __int_as_float(__builtin_amdgcn_update_dpp(0, __float_as_int(w), 0xF5, 0xf, 0xf, true));     \
            wsum += wa + wb; \
            const _Float16 wa16 = (_Float16)(wa * 8192.f), wa16b = (_Float16)(wa * 512.f), wb16 = (_Float16)(wb * 8192.f), wb16b = (_Float16)(wb * 512.f);     \
            const h2_t wha = (h2_t){wa16, wa16}, whab = (h2_t){wa16b, wa16b}, whb = (h2_t){wb16, wb16}, whbb = (h2_t){wb16b, wb16b}; \
            _Pragma("unroll") for (int dd = 0; dd < 4; ++dd) { const unsigned a0_ = va0[dd], a1_ = a0_ >> 8, b0_ = va1[dd], b1_ = b0_ >> 8; \
                hacc[0][dd][0] = __builtin_elementwise_fma(__builtin_bit_cast(h2_t, a0_ & 0x000f000fu), wha, hacc[0][dd][0]); hacc[0][dd][1] = __builtin_elementwise_fma(__builtin_bit_cast(h2_t, a0_ & 0x00f000f0u), whab, hacc[0][dd][1]); \
                hacc[0][dd][2] = __builtin_elementwise_fma(__builtin_bit_cast(h2_t, a1_ & 0x000f000fu), wha, hacc[0][dd][2]); hacc[0][dd][3] = __builtin_elementwise_fma(__builtin_bit_cast(h2_t, a1_ & 0x00f000f0u), whab, hacc[0][dd][3]); \
                hacc[1][dd][0] = __builtin_elementwise_fma(__builtin_bit_cast(h2_t, b0_ & 0x000f000fu), wha, hacc[1][dd][0]); hacc[1][dd][1] = __builtin_elementwise_fma(__builtin_bit_cast(h2_t, b0_ & 0x00f000f0u), whab, hacc[1][dd][1]); \
                hacc[1][dd][2] = __builtin_elementwise_fma(__builtin_bit_cast(h2_t, b1_ & 0x000f000fu), wha, hacc[1][dd][2]); hacc[1][dd][3] = __builtin_elementwise_fma(__builtin_bit_cast(h2_t, b1_ & 0x00f000f0u), whab, hacc[1][dd][3]); } \
            _Pragma("unroll") for (int dd = 0; dd < 4; ++dd) { const unsigned a0_ = vb0[dd], a1_ = a0_ >> 8, b0_ = vb1[dd], b1_ = b0_ >> 8; \
                hacc[0][dd][0] = __builtin_elementwise_fma(__builtin_bit_cast(h2_t, a0_ & 0x000f000fu), whb, hacc[0][dd][0]); hacc[0][dd][1] = __builtin_elementwise_fma(__builtin_bit_cast(h2_t, a0_ & 0x00f000f0u), whbb, hacc[0][dd][1]); \
                hacc[0][dd][2] = __builtin_elementwise_fma(__builtin_bit_cast(h2_t, a1_ & 0x000f000fu), whb, hacc[0][dd][2]); hacc[0][dd][3] = __builtin_elementwise_fma(__builtin_bit_cast(h2_t, a1_ & 0x00f000f0u), whbb, hacc[0][dd][3]); \
                hacc[1][dd][0] = __builtin_elementwise_fma(__builtin_bit_cast(h2_t, b0_ & 0x000f000fu), whb, hacc[1][dd][0]); hacc[1][dd][1] = __builtin_elementwise_fma(__builtin_bit_cast(h2_t, b0_ & 0x00f000f0u), whbb, hacc[1][dd][1]); \
                hacc[1][dd][2] = __builtin_elementwise_fma(__builtin_bit_cast(h2_t, b1_ & 0x000f000fu), whb, hacc[1][dd][2]); hacc[1][dd][3] = __builtin_elementwise_fma(__builtin_bit_cast(h2_t, b1_ & 0x00f000f0u), whbb, hacc[1][dd][3]); } \
            } while (0)
        GD_ISSUE(0, 0); GD_ISSUE(1, 1); GD_ISSUE(2, 2); GD_ISSUE(3, 3);
#pragma unroll 1
        for (int i0 = 0; i0 < 28; i0 += 4) { GD_BODY2(0, true, 8); GD_BODY2(2, true, 8); }
        { const int i0 = 28; GD_BODY2(0, false, 8); GD_BODY2(2, false, 0); }
#undef GD_BODY2
#undef ROR16_
#undef GD_ISSUE
        h2_t r1p[16], r2p[8];
#pragma unroll
        for (int k = 0; k < 16; ++k) { const auto rr = __builtin_amdgcn_permlane32_swap(__builtin_bit_cast(unsigned, hacc[0][k >> 2][k & 3]), __builtin_bit_cast(unsigned, hacc[1][k >> 2][k & 3]), false, false);
            r1p[k] = __builtin_bit_cast(h2_t, (unsigned)rr[0]) + __builtin_bit_cast(h2_t, (unsigned)rr[1]); }
#pragma unroll
        for (int k = 0; k < 8; ++k) { const auto rr = __builtin_amdgcn_permlane16_swap(__builtin_bit_cast(unsigned, r1p[k]), __builtin_bit_cast(unsigned, r1p[8 + k]), false, false);
            r2p[k] = __builtin_bit_cast(h2_t, (unsigned)rr[0]) + __builtin_bit_cast(h2_t, (unsigned)rr[1]); }
        float r2[16];
#pragma unroll
        for (int dd = 0; dd < 2; ++dd) { const int a0 = 8 * dd;
            r2[a0 + 0] = (float)r2p[4 * dd + 0].x * 2048.f; r2[a0 + 2] = (float)r2p[4 * dd + 0].y * 2048.f; r2[a0 + 4] = (float)r2p[4 * dd + 1].x * 2048.f; r2[a0 + 6] = (float)r2p[4 * dd + 1].y * 2048.f;
            r2[a0 + 1] = (float)r2p[4 * dd + 2].x * 2048.f; r2[a0 + 3] = (float)r2p[4 * dd + 2].y * 2048.f; r2[a0 + 5] = (float)r2p[4 * dd + 3].x * 2048.f; r2[a0 + 7] = (float)r2p[4 * dd + 3].y * 2048.f; }
        wsum = xrow_sum(wsum);
        const float corr = 7.5f * wsum;
        const int c0 = 32 * (s + 16 * (e4 >> 1)) + 16 * (e4 & 1);
        const int mi = j < CTXL ? 4 : b;
        bf16* xs = F_xs + (size_t)r * DM;
        f32x4 y[4]; float ss = 0.f;
        { const u32x4 wa = xkeep[0], wb = xkeep[1];
          const f32x4 xv[4] = {(f32x4){bflo(wa.x), bfhi(wa.x), bflo(wa.y), bfhi(wa.y)}, (f32x4){bflo(wa.z), bfhi(wa.z), bflo(wa.w), bfhi(wa.w)}, (f32x4){bflo(wb.x), bfhi(wb.x), bflo(wb.y), bfhi(wb.y)}, (f32x4){bflo(wb.z), bfhi(wb.z), bflo(wb.w), bfhi(wb.w)}};
          const u32x4 gA = eg[0], gB = eg[1];
          const f32x4 gq[4] = {(f32x4){bflo(gA.x), bfhi(gA.x), bflo(gA.y), bfhi(gA.y)}, (f32x4){bflo(gA.z), bfhi(gA.z), bflo(gA.w), bfhi(gA.w)}, (f32x4){bflo(gB.x), bfhi(gB.x), bflo(gB.y), bfhi(gB.y)}, (f32x4){bflo(gB.z), bfhi(gB.z), bflo(gB.w), bfhi(gB.w)}};
#pragma unroll
          for (int hh = 0; hh < 4; ++hh) { const f32x4 gv = gq[hh];
            const f32x4 yy = xv[hh] + gv * ((f32x4){r2[4 * hh], r2[4 * hh + 1], r2[4 * hh + 2], r2[4 * hh + 3]} - corr);
            y[hh] = yy; ss += (yy.x * yy.x + yy.y * yy.y) + (yy.z * yy.z + yy.w * yy.w); } }
        float rstd = 1.f;
        if (last || nextn) rstd = rsqrtf(wave_sum(ss) * (1.f / DM) + EPS);
        if (last) {
            float* orow = F.out + ((size_t)b * SEQ + (j - CTXL)) * DM;
#pragma unroll
            for (int hh = 0; hh < 4; ++hh) { const int c = c0 + 4 * hh; *(f32x4*)(orow + c) = y[hh] * rstd * fg[hh]; }
        } else {
            u32x4 oa, ob; oa.x = pk2(y[0].x, y[0].y); oa.y = pk2(y[0].z, y[0].w); oa.z = pk2(y[1].x, y[1].y); oa.w = pk2(y[1].z, y[1].w);
            ob.x = pk2(y[2].x, y[2].y); ob.y = pk2(y[2].z, y[2].w); ob.z = pk2(y[3].x, y[3].y); ob.w = pk2(y[3].z, y[3].w);
            *(u32x4*)(xs + c0) = oa; *(u32x4*)(xs + c0 + 8) = ob;
        }
        if (nextn) {
            bf16* orow = F_xn + (size_t)r * DM + c0;
            const u32x4 na = en[0], nbb = en[1], ha = en[2], hb = en[3];
            const f32x4 gq[4] = {(f32x4){bflo(na.x), bfhi(na.x), bflo(na.y), bfhi(na.y)}, (f32x4){bflo(na.z), bfhi(na.z), bflo(na.w), bfhi(na.w)}, (f32x4){bflo(nbb.x), bfhi(nbb.x), bflo(nbb.y), bfhi(nbb.y)}, (f32x4){bflo(nbb.z), bfhi(nbb.z), bflo(nbb.w), bfhi(nbb.w)}};
            const f32x4 hq[4] = {(f32x4){bflo(ha.x), bfhi(ha.x), bflo(ha.y), bfhi(ha.y)}, (f32x4){bflo(ha.z), bfhi(ha.z), bflo(ha.w), bfhi(ha.w)}, (f32x4){bflo(hb.x), bfhi(hb.x), bflo(hb.y), bfhi(hb.y)}, (f32x4){bflo(hb.z), bfhi(hb.z), bflo(hb.w), bfhi(hb.w)}};
            f32x4 z[4];
#pragma unroll
            for (int hh = 0; hh < 4; ++hh) z[hh] = (y[hh] * rstd) * gq[hh] + hq[hh];
            u32x4 oa, ob; oa.x = pk2(z[0].x, z[0].y); oa.y = pk2(z[0].z, z[0].w); oa.z = pk2(z[1].x, z[1].y); oa.w = pk2(z[1].z, z[1].w);
            ob.x = pk2(z[2].x, z[2].y); ob.y = pk2(z[2].z, z[2].w); ob.z = pk2(z[3].x, z[3].y); ob.w = pk2(z[3].z, z[3].w);
            *(u32x4*)orow = oa; *(u32x4*)(orow + 8) = ob;
        }
    }
}

#define RLX_AGENT __ATOMIC_RELAXED, __HIP_MEMORY_SCOPE_AGENT
#define XB_TMO      128
#define XB_XCNT(j)  (256  + 64 * (j))
#define XB_XSUB(j)  (1280 + 64 * (j))
#define XB_XGEN(j)  (2304 + 64 * (j))
#define XB_TOP      3328
#define XB_TOPGEN   3392
#define XCD_BAR_WORDS 3456
#define XB_SPIN_CAP (1u << 18)

__device__ __forceinline__ unsigned xb_ld(unsigned* p)              { return __hip_atomic_load(p, __ATOMIC_RELAXED, __HIP_MEMORY_SCOPE_AGENT); }
__device__ __forceinline__ unsigned xb_add(unsigned* p, unsigned v) { return __hip_atomic_fetch_add(p, v, __ATOMIC_RELAXED, __HIP_MEMORY_SCOPE_AGENT); }
__device__ __forceinline__ unsigned xb_xcc_id() { return (unsigned)__builtin_amdgcn_s_getreg((3 << 11) | 20) & 0xFu; }
#define XB_SPIN(cond, bar) do { unsigned _sp = 0; while (cond) { __builtin_amdgcn_s_sleep(1); \
    if ((++_sp & 255u) == 0u) { if (xb_ld(&(bar)[XB_TMO])) break; if (_sp > XB_SPIN_CAP) { atomicAdd(&(bar)[XB_TMO], 1u); break; } } } } while (0)

struct XcdBarrier {
    unsigned* bar; unsigned x;
    volatile LAS unsigned* st;
};

__device__ __forceinline__ XcdBarrier xcd_barrier_post(unsigned* bar, volatile LAS unsigned* st) {
    XcdBarrier b; b.bar = bar; b.x = xb_xcc_id(); b.st = st;
    if (threadIdx.x == 0) (void)xb_add(&bar[XB_XCNT(b.x)], 1u);
    return b;
}
__device__ __forceinline__ void xcd_barrier_complete(unsigned* bar, unsigned x, unsigned& nloc, unsigned& nx) {
    const unsigned G = gridDim.x * gridDim.y * gridDim.z;
    unsigned sum, cnt, mine, sp = 0u;
    for (;;) {
        sum = 0u; cnt = 0u; mine = 0u;
#pragma unroll
        for (unsigned j = 0; j < 16; ++j) { const unsigned c = xb_ld(&bar[XB_XCNT(j)]); sum += c; cnt += (c > 0u) ? 1u : 0u; mine = (j == x) ? c : mine; }
        if (sum == G) break;
        __builtin_amdgcn_s_sleep(1);
        if ((++sp & 255u) == 0u) { if (xb_ld(&bar[XB_TMO])) break; if (sp > XB_SPIN_CAP) { atomicAdd(&bar[XB_TMO], 1u); break; } }
    }
    nloc = mine > 0u ? mine : 1u; nx = cnt > 0u ? cnt : 1u;
}

__device__ __forceinline__ void xcd_barrier(const XcdBarrier& b) {
    asm volatile("s_waitcnt vmcnt(0)" ::: "memory");
    __syncthreads();
    if (threadIdx.x == 0) {
        unsigned* bar = b.bar;
        __builtin_amdgcn_s_waitcnt(0);
        unsigned nloc = b.st[0], nx = b.st[1];
        if (nloc == 0u) { xcd_barrier_complete(bar, b.x, nloc, nx); b.st[0] = nloc; b.st[1] = nx; }
        const unsigned old = xb_add(&bar[XB_XSUB(b.x)], 1u);
        const unsigned gen = old / nloc;
        if (old + 1u == (gen + 1u) * nloc) {
            __builtin_amdgcn_fence(__ATOMIC_RELEASE, "agent");
            asm volatile("s_waitcnt vmcnt(0)" ::: "memory");
            const unsigned og = xb_add(&bar[XB_TOP], 1u);
            const unsigned tg = og / nx;
            if (og + 1u == (tg + 1u) * nx) xb_add(&bar[XB_TOPGEN], 1u);
            else XB_SPIN(xb_ld(&bar[XB_TOPGEN]) == tg, bar);
            __builtin_amdgcn_fence(__ATOMIC_ACQUIRE, "agent");
            xb_add(&bar[XB_XGEN(b.x)], 1u);
            asm volatile("s_waitcnt vmcnt(0)" ::: "memory");
        } else {
            XB_SPIN(xb_ld(&bar[XB_XGEN(b.x)]) == gen, bar);
            __builtin_amdgcn_fence(__ATOMIC_ACQUIRE, "agent");
            asm volatile("s_waitcnt vmcnt(0)" ::: "memory");
        }
    }
    __syncthreads();
}


#define IN(k) (lo <= (k) && (k) < hi)
#define SEAM(k) do { if (IN(k) && IN((k) + 1)) xcd_barrier(bar); } while (0)
template <int LAYER> __device__ __forceinline__ void layer_phases(Frame& F, char* shm, const int lo, const int hi, cg::grid_group& grid, const XcdBarrier& bar) {
    constexpr int P = 1 + 9 * LAYER; constexpr bool lastl = LAYER == 1;
    if (LAYER == 0) { if (IN(P + 0)) norm_phase<0>(F, LAYER, true, false, true); SEAM(P + 0); }
    if (IN(P + 1)) { if (LAYER == 0) fold_norm2(F);
        const pg8::Gemm g{F_xn, F_winT + (size_t)LAYER * DIN * DM, NR, DIN, DM}; pg8::Order S; S.init(132, DIN, gridDim.x, blockIdx.x, 0); S.kfix = F_qkvu; S.kg = LAYER == 0 ? F.in[I_EKG] : nullptr; const pg8::EpiBf16 E{F_qkvu, DIN};
        if (LAYER == 0) tables_tail(F, 0, 0);
        if (LAYER == 1) { const int fi = first_idle_wg(DIN / 256);
            if (fi >= 0 && (int)blockIdx.x >= fi && (((int)blockIdx.x >> 3) & 1) == 1) fold_items(F, 1, (octet_rank((int)blockIdx.x, 1) - octet_rank(fi, 1)) * NWAVES + F.wave, (octet_rank((int)gridDim.x, 1) - octet_rank(fi, 1)) * NWAVES, 0, DPQ / 2); }
        pg8::gemm_phase<pg8::EpiBf16, pg8::Order, true, true>(F.lds, g, S, E);
        if (LAYER == 0) tables_tail(F, 0, 1);
        if (LAYER == 0) { const int fi = first_idle_wg(DIN / 256);
            if (fi >= 0 && (int)blockIdx.x >= fi && (((int)blockIdx.x >> 3) & 1) == 1) fold_items(F, 0, (octet_rank((int)blockIdx.x, 1) - octet_rank(fi, 1)) * NWAVES + F.wave, (octet_rank((int)gridDim.x, 1) - octet_rank(fi, 1)) * NWAVES); }
        if (LAYER == 1) { const int fi = first_idle_wg(DIN / 256); if (fi >= 0 && (int)blockIdx.x >= fi && (((int)blockIdx.x >> 3) & 1) == 0) fold_items(F, 1, (octet_rank((int)blockIdx.x, 0) - octet_rank(fi, 0)) * NWAVES + F.wave, (octet_rank((int)gridDim.x, 0) - octet_rank(fi, 0)) * NWAVES, DPQ / 2, DPQ); } }
    SEAM(P + 1);
    if (IN(P + 3)) { attn_fast_phase<LAYER>(F, shm); if (LAYER == 0) pool_phase(F); }
    SEAM(P + 3);
    if (IN(P + 4)) { const pg8::Gemm g{F_mix, F_woutT + (size_t)LAYER * DM * DM, NR, DM, DM}; pg8::Order S; S.init(lastl ? 128 : 132, DM, gridDim.x, blockIdx.x, lastl ? 1 : 0);
        const pg8::EpiResid16T<LAYER == 0> E{F.in[I_X], F.in[I_CTX], F_xs, F_mod + (size_t)LAYER * 5 * MODW + 2 * DM, F_ssp};
        if (LAYER == 0) tables_tail(F, 1, 0);
        pg8::gemm_phase<pg8::EpiResid16T<LAYER == 0>, pg8::Order, true, true>(F.lds, g, S, E);
        if (LAYER == 0) tables_tail(F, 1, 1); }
    SEAM(P + 4);
    if (IN(P + 6)) { const pg8::Gemm g{F_xs, F_wqb + (size_t)LAYER * 5 * DPQ * DM, NR, DPQ, DM, (size_t)DPQ * DM * 2}; pg8::Order S; S.init(lastl ? 128 : 132, DPQ, gridDim.x, blockIdx.x, lastl ? 1 : 0);
        pg8::pq_rstd_fill((LAS float*)(F.lds + 135168), F_ssp, S);
        const pg8::EpiPQ E{F_pq, DPQ, F_pqbias + (size_t)LAYER * 5 * DPQ, (LAS float*)(F.lds + 135168)};
        if (LAYER == 0) tables_tail(F, 2, 0);
        pg8::gemm_phase<pg8::EpiPQ, pg8::Order, true, true>(F.lds, g, S, E);
        if (LAYER == 0) tables_tail(F, 2, 1); }
    SEAM(P + 6);
    if (IN(P + 7)) route_fast_phase(F, LAYER, lastl);
    if (IN(P + 7) && IN(P + 8)) { asm volatile("s_waitcnt vmcnt(0)" ::: "memory"); __builtin_amdgcn_fence(__ATOMIC_RELEASE, "workgroup"); __syncthreads(); __builtin_amdgcn_fence(__ATOMIC_ACQUIRE, "agent"); }
    if (IN(P + 8)) gather_q8_phase(F, LAYER, lastl, lastl, !lastl);
}
#undef IN
#undef SEAM

constexpr int PH_PER_LAYER = 9, N_PHASES = 1 + 2 * PH_PER_LAYER;
__global__ void __launch_bounds__(NTHR, 2) mk_fwd(Args args) {
    extern __shared__ __attribute__((aligned(16))) unsigned char lds_raw[];
    Frame F;
    F.in = args.in; F.out = args.out; F.ws = args.ws; F.lds = (LAS unsigned char*)lds_raw;
    F.tid = threadIdx.x; F.lane = F.tid & 63; F.wave = __builtin_amdgcn_readfirstlane(F.tid >> 6);
    F.gw = blockIdx.x * NWAVES + F.wave; F.ngw = gridDim.x * NWAVES; F.gtid = blockIdx.x * NTHR + F.tid; F.ngt = gridDim.x * NTHR;
    cg::grid_group grid = cg::this_grid();
    volatile LAS unsigned* bst = (volatile LAS unsigned*)(F.lds + 131072 + 512);
    if (F.tid < 2) bst[F.tid] = 0u;
    __syncthreads();
    const XcdBarrier bar = xcd_barrier_post((unsigned*)(F.ws + WS_CTL) + 4096, bst);
    const int lo = args.ph_lo, hi = args.ph_hi;
#define IN(k) (lo <= (k) && (k) < hi)
#define SEAM(k) do { if (IN(k) && IN((k) + 1)) xcd_barrier(bar); } while (0)
    if (lo < 0) grid.sync();
    if (IN(0)) prep_phase(F);
    SEAM(0);
    layer_phases<0>(F, (char*)lds_raw, lo, hi, grid, bar);
    SEAM(PH_PER_LAYER);
    layer_phases<1>(F, (char*)lds_raw, lo, hi, grid, bar);
}

extern "C" void kernel_launch(void* const* d_in, const int* in_sizes, int n_in, void* d_out, int out_size, void* d_ws, size_t ws_size, hipStream_t stream) {
    static int grid = 0;
    if (grid == 0) {
        if (n_in != N_IN || out_size != NB * SEQ * DM || ws_size < WS_END) { fprintf(stderr, "kernel_launch: unexpected problem (n_in %d out %d ws %zu)\n", n_in, out_size, ws_size); grid = -1; return; }
        int dev = 0, cus = 0, per_cu = 0;
        hipGetDevice(&dev); hipDeviceGetAttribute(&cus, hipDeviceAttributeMultiprocessorCount, dev);
        hipFuncSetAttribute((const void*)mk_fwd, hipFuncAttributeMaxDynamicSharedMemorySize, LDS_BYTES);
        hipOccupancyMaxActiveBlocksPerMultiprocessor(&per_cu, (const void*)mk_fwd, NTHR, LDS_BYTES);
        if (per_cu < 1) { fprintf(stderr, "kernel_launch: occupancy query says %d blocks per CU\n", per_cu); per_cu = 1; }
        if (per_cu > 1) per_cu = 1;
        grid = cus * per_cu;
        if ((long)grid * pg8::PQ_RL_UNITS < 132L * (DPQ / 256)) { fprintf(stderr, "kernel_launch: grid %d too small for the per-workgroup rstd table\n", grid); grid = -1; return; }
        (void)hipGetLastError();
    }
    if (grid < 0) return;
    hipMemsetAsync((char*)d_ws + WS_CTL, 0, 65536, stream);
    Args a{};
    for (int i = 0; i < N_IN; ++i) a.in[i] = (const float*)d_in[i];
    a.out = (float*)d_out; a.ws = (unsigned char*)d_ws;
#if MK_ONE_LAUNCH
    a.ph_lo = 0; a.ph_hi = N_PHASES;
    void* kargs[] = {&a};
    hipError_t e = hipLaunchCooperativeKernel((const void*)mk_fwd, dim3(grid), dim3(NTHR), kargs, LDS_BYTES, stream);
    if (e != hipSuccess) fprintf(stderr, "cooperative launch failed: %s (grid %d)\n", hipGetErrorString(e), grid);
#else
    for (int ph = 0; ph < N_PHASES; ++ph) { a.ph_lo = ph; a.ph_hi = ph + 1; hipLaunchKernelGGL(mk_fwd, dim3(grid), dim3(NTHR), LDS_BYTES, stream, a); }
#endif
}
```
